# Optimizing an MI355X kernel written in HIP

```python
import jax, jax.numpy as jnp
from jax import lax
import numpy as np

D_MODEL = 1024
BATCH = 4
SEQ = 8192
DEPTH = 1

D_MIX = D_MODEL
D_SGU = D_MIX // 2
SGU_HEADS = 8
SGU_HEAD_DIM = D_SGU // SGU_HEADS
SGU_CHUNK = 128
D_GLA = D_MIX - D_SGU
GLA_HEADS = 4
GLA_DK = D_GLA // 2
GLA_HEAD_K = GLA_DK // GLA_HEADS
GLA_HEAD_V = D_GLA // GLA_HEADS
GLA_GATE_RANK = 16
GLA_TAU = 16.0
GLA_CHUNK = 64
D_IN = 2 * D_SGU + 2 * GLA_DK + 2 * D_GLA + GLA_GATE_RANK
N_EXPERTS = 32
TOP_K = 4
D_EXPERT = D_MODEL
SWIGLU_LIMIT = 7.0
SWIGLU_ALPHA = 1.702
MOE_BLOCK = 128
EPS = 1e-6

kernel_name = "hybrid_sgu_gla_moe_block"


def rms_norm(x, g):
    xf = x.astype(jnp.float32)
    y = xf * lax.rsqrt(jnp.mean(xf * xf, axis=-1, keepdims=True) + EPS)
    return (y * g.astype(jnp.float32)).astype(x.dtype)


def spatial_gating(u, v, g_v, w_s, b_s):
    B, S, _ = u.shape
    N = S // SGU_CHUNK
    vh = rms_norm(v.reshape(B, S, SGU_HEADS, SGU_HEAD_DIM), g_v.reshape(SGU_HEADS, SGU_HEAD_DIM))
    vc = vh.reshape(B, N, SGU_CHUNK, SGU_HEADS, SGU_HEAD_DIM)
    w_causal = jnp.tril(w_s)
    sv = jnp.einsum('hts,bnshd->bnthd', w_causal, vc) + b_s.T[None, None, :, :, None]
    return (u.reshape(B, N, SGU_CHUNK, SGU_HEADS, SGU_HEAD_DIM) * sv).reshape(B, S, D_SGU)


def gated_linear_attention(q, k, v, log_a):
    B, S, H, dk = q.shape
    dv = v.shape[-1]
    N = S // GLA_CHUNK
    dt = q.dtype

    def chunk(t):
        return t.reshape(B, N, GLA_CHUNK, H, t.shape[-1]).transpose(0, 3, 1, 2, 4)

    qc, kc, vc = chunk(q) * (GLA_HEAD_K ** -0.5), chunk(k), chunk(v)
    bcum = jnp.cumsum(chunk(log_a).astype(jnp.float32), axis=3)
    blast = bcum[:, :, :, -1:, :]
    q_s = qc * jnp.exp(bcum).astype(dt)
    k_s = kc * jnp.exp(-bcum).astype(dt)
    k_dec = kc * jnp.exp(blast - bcum).astype(dt)
    scores = jnp.einsum('bhnid,bhnjd->bhnij', q_s, k_s)
    causal = jnp.tril(jnp.ones((GLA_CHUNK, GLA_CHUNK), dtype=bool))
    scores = jnp.where(causal, scores, jnp.zeros((), dt))
    intra = jnp.einsum('bhnij,bhnjv->bhniv', scores, vc)
    d_state = jnp.einsum('bhncd,bhncv->bhndv', k_dec, vc)
    decay = jnp.exp(blast[:, :, :, 0, :]).astype(d_state.dtype)

    def step(state, inp):
        dn, dsn = inp
        return dn[..., None] * state + dsn, state

    init = jnp.zeros((B, H, dk, dv), d_state.dtype)
    _, prev = lax.scan(step, init, (jnp.moveaxis(decay, 2, 0), jnp.moveaxis(d_state, 2, 0)))
    prev = jnp.moveaxis(prev, 0, 2)
    inter = jnp.einsum('bhncd,bhndv->bhncv', q_s, prev)
    o = intra + inter
    return o.transpose(0, 2, 3, 1, 4).reshape(B, S, H, dv)


def moe_ffn(xn, w_router, b_router, w_gate, b_gate, w_up, b_up, w_down, b_down):
    B, S, D = xn.shape
    T = B * S
    xt = xn.reshape(T, D)
    logits = (xt @ w_router + b_router).astype(jnp.float32)
    top_v, top_i = lax.top_k(logits, TOP_K)
    probs = jax.nn.softmax(top_v, axis=-1).astype(xn.dtype)
    TK = T * TOP_K
    flat_e = top_i.reshape(TK)
    flat_tok = jnp.repeat(jnp.arange(T, dtype=jnp.int32), TOP_K)
    flat_w = probs.reshape(TK)
    order = jnp.argsort(flat_e, stable=True)
    sorted_e = flat_e[order]
    counts = jnp.bincount(flat_e, length=N_EXPERTS)
    start = jnp.cumsum(counts) - counts
    padded = ((counts + MOE_BLOCK - 1) // MOE_BLOCK) * MOE_BLOCK
    pend = jnp.cumsum(padded)
    pstart = pend - padded
    dest = pstart[sorted_e] + (jnp.arange(TK, dtype=jnp.int32) - start[sorted_e])
    n_blocks = -(-TK // MOE_BLOCK) + N_EXPERTS
    P = n_blocks * MOE_BLOCK
    tok_buf = jnp.zeros((P,), jnp.int32).at[dest].set(flat_tok[order])
    w_buf = jnp.zeros((P,), xn.dtype).at[dest].set(flat_w[order])
    block_e = jnp.clip(jnp.searchsorted(pend, jnp.arange(n_blocks) * MOE_BLOCK, side='right'), 0, N_EXPERTS - 1)
    x_blocks = xt[tok_buf].reshape(n_blocks, MOE_BLOCK, D)

    def expert_block(args):
        xb, e = args
        g = jnp.minimum(xb @ w_gate[e] + b_gate[e], SWIGLU_LIMIT)
        u = jnp.clip(xb @ w_up[e] + b_up[e], -SWIGLU_LIMIT, SWIGLU_LIMIT)
        hdn = (u + 1.0) * (g * jax.nn.sigmoid(SWIGLU_ALPHA * g))
        return hdn @ w_down[e] + b_down[e]

    out = lax.map(expert_block, (x_blocks, block_e)).reshape(P, D)
    y = jnp.zeros((T, D), out.dtype).at[tok_buf].add(out * w_buf[:, None])
    return y.reshape(B, S, D)


def setup_inputs(seed: int = 0) -> dict:
    key = jax.random.key(seed)
    ks = jax.random.split(key, 26)
    f32 = jnp.float32
    L = DEPTH

    def nrm(k, shape, scale):
        return jax.random.normal(k, shape, f32) * scale

    def gain(k, shape):
        return 1.0 + 0.05 * jax.random.normal(k, shape, f32)

    return {
        "x": jax.random.normal(ks[0], (BATCH, SEQ, D_MODEL), f32),
        "c": jax.random.normal(ks[1], (BATCH, D_MODEL), f32),
        "w_ada": nrm(ks[2], (L, D_MODEL, 6 * D_MODEL), 0.5 * D_MODEL ** -0.5),
        "b_ada": nrm(ks[3], (L, 6 * D_MODEL), 0.02),
        "g_pre_mix": gain(ks[4], (L, D_MODEL)),
        "w_in": nrm(ks[5], (L, D_MODEL, D_IN), D_MODEL ** -0.5),
        "g_sgu_v": gain(ks[6], (L, D_SGU)),
        "w_s": nrm(ks[7], (L, SGU_HEADS, SGU_CHUNK, SGU_CHUNK), SGU_CHUNK ** -0.5),
        "b_s": gain(ks[8], (L, SGU_HEADS, SGU_CHUNK)),
        "w_gk2": nrm(ks[9], (L, GLA_GATE_RANK, GLA_DK), GLA_GATE_RANK ** -0.5),
        "b_gk": nrm(ks[10], (L, GLA_DK), 0.1),
        "g_gla_out": gain(ks[11], (L, GLA_HEAD_V)),
        "w_out": nrm(ks[12], (L, D_MIX, D_MODEL), D_MIX ** -0.5),
        "g_post_mix": gain(ks[13], (L, D_MODEL)),
        "g_pre_ffn": gain(ks[14], (L, D_MODEL)),
        "w_router": nrm(ks[15], (L, D_MODEL, N_EXPERTS), D_MODEL ** -0.5),
        "b_router": nrm(ks[16], (L, N_EXPERTS), 0.01),
        "w_gate": nrm(ks[17], (L, N_EXPERTS, D_MODEL, D_EXPERT), D_MODEL ** -0.5),
        "b_gate": nrm(ks[18], (L, N_EXPERTS, D_EXPERT), 0.01),
        "w_up": nrm(ks[19], (L, N_EXPERTS, D_MODEL, D_EXPERT), D_MODEL ** -0.5),
        "b_up": nrm(ks[20], (L, N_EXPERTS, D_EXPERT), 0.01),
        "w_down": nrm(ks[21], (L, N_EXPERTS, D_EXPERT, D_MODEL), D_EXPERT ** -0.5),
        "b_down": nrm(ks[22], (L, N_EXPERTS, D_MODEL), 0.01),
        "g_post_ffn": gain(ks[23], (L, D_MODEL)),
    }


def reference(x, c, w_ada, b_ada, g_pre_mix, w_in, g_sgu_v, w_s, b_s, w_gk2, b_gk, g_gla_out, w_out,
              g_post_mix, g_pre_ffn, w_router, b_router, w_gate, b_gate, w_up, b_up, w_down, b_down, g_post_ffn):
    B, S, _ = x.shape
    split_at = list(np.cumsum([D_SGU, D_SGU, GLA_DK, GLA_DK, D_GLA, D_GLA]))
    h = x
    for l in range(DEPTH):
        mods = jax.nn.silu(c) @ w_ada[l] + b_ada[l]
        shift1, scale1, gate1, shift2, scale2, gate2 = [m[:, None, :] for m in jnp.split(mods, 6, axis=-1)]

        n = rms_norm(h, g_pre_mix[l]) * (1.0 + scale1) + shift1
        proj = n @ w_in[l]
        u_s, v_s, q, k, v, r, g_low = jnp.split(proj, split_at, axis=-1)
        a_out = spatial_gating(jax.nn.gelu(u_s), jax.nn.gelu(v_s), g_sgu_v[l], w_s[l], b_s[l])
        log_a = jax.nn.log_sigmoid((g_low @ w_gk2[l] + b_gk[l]).astype(jnp.float32)) / GLA_TAU
        o = gated_linear_attention(q.reshape(B, S, GLA_HEADS, GLA_HEAD_K),
                                   k.reshape(B, S, GLA_HEADS, GLA_HEAD_K),
                                   v.reshape(B, S, GLA_HEADS, GLA_HEAD_V),
                                   log_a.reshape(B, S, GLA_HEADS, GLA_HEAD_K))
        o = rms_norm(o, g_gla_out[l]).reshape(B, S, D_GLA) * jax.nn.silu(r)
        mix = jnp.concatenate([a_out, o], axis=-1) @ w_out[l]
        h = h + gate1 * rms_norm(mix, g_post_mix[l])

        n2 = rms_norm(h, g_pre_ffn[l]) * (1.0 + scale2) + shift2
        f = moe_ffn(n2, w_router[l], b_router[l], w_gate[l], b_gate[l], w_up[l], b_up[l], w_down[l], b_down[l])
        h = h + gate2 * rms_norm(f, g_post_ffn[l])
    return h
```

```cpp
#include <hip/hip_runtime.h>
#include <cstdio>
#include <cstdint>

#define LAS __attribute__((address_space(3)))
typedef unsigned short bf16_t;
typedef short bf16x8 __attribute__((ext_vector_type(8)));
typedef float f32x4 __attribute__((ext_vector_type(4)));
typedef float f32x2 __attribute__((ext_vector_type(2)));
typedef unsigned u32x4 __attribute__((ext_vector_type(4)));
typedef unsigned u32x2 __attribute__((ext_vector_type(2)));

constexpr int T = 32768, D = 1024, SEQ = 8192;
constexpr int D_IN = 2576, NPROJ = 2560;
constexpr int NE = 32;
constexpr float EPS = 1e-6f;
constexpr int C_US = 0, C_VS = 512, C_Q = 1024, C_K = 1280, C_V = 1536, C_R = 2048, C_GL = 2560;
constexpr float OSCALE = 8.0f;
constexpr float W8_SCALE = 32.0f;
#define W8_SCALE_E8M0 0x7A7A7A7A

constexpr size_t MiB = 1u << 20;
constexpr size_t WS_CTL = 0, CTL_ZERO_BYTES = 1 * MiB;
constexpr int CW_TMO = 0, CW_CNT = 1024, CW_BAR = 4096;
constexpr size_t WS_MODS = 256 * 1024;
constexpr size_t WS_GLOW = 2 * MiB;
constexpr size_t WS_TOKE = 4 * MiB, WS_TOKPOS = WS_TOKE + 512 * 1024, WS_TOKP = WS_TOKE + 1024 * 1024;
constexpr size_t WS_DEC = 5 * MiB + 512 * 1024;
constexpr size_t WS_SLOT = 6 * MiB;
constexpr size_t WS_WR = 10 * MiB;
constexpr size_t WS_WIN = 11 * MiB;
constexpr size_t WS_WOUT = 16 * MiB;
constexpr size_t WS_WD = 18 * MiB;
constexpr size_t WS_W1 = 50 * MiB;
constexpr size_t WS_XN = 114 * MiB;
constexpr size_t WS_PROJ = 178 * MiB;
constexpr size_t WS_ST = 338 * MiB;
constexpr size_t WS_PREV = 402 * MiB;
constexpr size_t WS_MIX = 178 * MiB;
constexpr size_t WS_HDN = 178 * MiB;
constexpr size_t WS_OUT8 = 338 * MiB;
constexpr size_t WS_BCUM = 434 * MiB;
constexpr size_t WS_H1 = 474 * MiB;
constexpr size_t WS_END = 538 * MiB;
constexpr int MAX_TILES = 543;

constexpr int RING_BYTES = 131072;
constexpr int MISC_OFF = RING_BYTES;
constexpr int TP_OFF = MISC_OFF + 256;
constexpr int TE_OFF = TP_OFF + 512;
constexpr int TOK_OFF = TE_OFF + 1024;
constexpr int BIAS_OFF = TOK_OFF + 18 * 512;
constexpr int LDS_BYTES = 147456;
static_assert(BIAS_OFF + 2048 <= LDS_BYTES && BIAS_OFF % 16 == 0, "LDS map");

__device__ __forceinline__ unsigned f2bf(float f) { unsigned u = __builtin_bit_cast(unsigned, f); return (u + 0x7fffu + ((u >> 16) & 1u)) >> 16; }
__device__ __forceinline__ float bf2f(unsigned h) { return __builtin_bit_cast(float, h << 16); }
__device__ __forceinline__ float bflo(unsigned w) { return __builtin_bit_cast(float, w << 16); }
__device__ __forceinline__ float bfhi(unsigned w) { return __builtin_bit_cast(float, w & 0xffff0000u); }
__device__ __forceinline__ unsigned pk2(float lo, float hi) { unsigned r; asm volatile("v_cvt_pk_bf16_f32 %0, %1, %2" : "=v"(r) : "v"(lo), "v"(hi)); return r; }
__device__ __forceinline__ unsigned pk4_fp8(float a, float b, float c, float d) {
    int w = __builtin_amdgcn_cvt_pk_fp8_f32(a, b, 0, false); w = __builtin_amdgcn_cvt_pk_fp8_f32(c, d, w, true); return (unsigned)w; }
__device__ __forceinline__ float clamp448(float v) { return fminf(fmaxf(v, -448.0f), 448.0f); }
#define LDS_BARRIER() do { asm volatile("s_waitcnt lgkmcnt(0)" ::: "memory"); __builtin_amdgcn_s_barrier(); asm volatile("" ::: "memory"); } while (0)
__device__ __forceinline__ float wave_sum(float v) {
#pragma unroll
    for (int o = 1; o < 64; o <<= 1) v += __shfl_xor(v, o);
    return v;
}
__device__ __forceinline__ f32x4 mfma16(bf16x8 a, bf16x8 b, f32x4 c) { return __builtin_amdgcn_mfma_f32_16x16x32_bf16(a, b, c, 0, 0, 0); }
__device__ __forceinline__ float sigmoidf_(float x) { return __builtin_amdgcn_rcpf(1.0f + __builtin_amdgcn_exp2f(-1.4426950408889634f * x)); }
__device__ __forceinline__ float gelu_tanh(float x) { const float u = x + 0.044715f * x * x * x; return x * __builtin_amdgcn_rcpf(1.0f + __builtin_amdgcn_exp2f(-2.302208198f * u)); }
__device__ __forceinline__ float silu_(float x) { return x * sigmoidf_(x); }
__device__ __forceinline__ f32x2 rcp2(f32x2 v) { return (f32x2){__builtin_amdgcn_rcpf(v[0]), __builtin_amdgcn_rcpf(v[1])}; }
__device__ __forceinline__ f32x2 exp2_2(f32x2 v) { return (f32x2){__builtin_amdgcn_exp2f(v[0]), __builtin_amdgcn_exp2f(v[1])}; }
__device__ __forceinline__ f32x2 clamp2(f32x2 v, float lo, float hi) { return (f32x2){__builtin_amdgcn_fmed3f(v[0], lo, hi), __builtin_amdgcn_fmed3f(v[1], lo, hi)}; }
__device__ __forceinline__ f32x2 gelu_tanh2(f32x2 x) { const f32x2 u = x + (x * x) * (x * 0.044715f); return x * rcp2(exp2_2(u * -2.302208198f) + 1.0f); }
__device__ __forceinline__ f32x2 silu2(f32x2 x) { return x * rcp2(exp2_2(x * -1.4426950408889634f) + 1.0f); }

#define XB_TMO      128
#define XB_XCNT(j)  (256  + 64 * (j))
#define XB_XSUB(j)  (1280 + 64 * (j))
#define XB_XGEN(j)  (2304 + 64 * (j))
#define XB_TOP      3328
#define XB_TOPGEN   3392
#define XCD_BAR_WORDS 3456
#define XB_SPIN_CAP (1u << 20)
__device__ __forceinline__ unsigned xb_ld(unsigned* p)              { return __hip_atomic_load(p, __ATOMIC_RELAXED, __HIP_MEMORY_SCOPE_AGENT); }
__device__ __forceinline__ unsigned xb_add(unsigned* p, unsigned v) { return __hip_atomic_fetch_add(p, v, __ATOMIC_RELAXED, __HIP_MEMORY_SCOPE_AGENT); }
__device__ __forceinline__ unsigned xb_xcc_id() { return (unsigned)__builtin_amdgcn_s_getreg((3 << 11) | 20) & 0xFu; }
#define XB_SPIN(cond, bar) do { unsigned _sp = 0; while (cond) { __builtin_amdgcn_s_sleep(1); \
    if ((++_sp & 255u) == 0u) { if (xb_ld(&(bar)[XB_TMO])) break; if (_sp > XB_SPIN_CAP) { atomicAdd(&(bar)[XB_TMO], 1u); break; } } } } while (0)
struct XcdBarrier { unsigned* bar; unsigned x; volatile LAS unsigned* st; };
__device__ __forceinline__ XcdBarrier xcd_barrier_post(unsigned* bar, volatile LAS unsigned* st) {
    XcdBarrier b; b.bar = bar; b.x = xb_xcc_id(); b.st = st;
    if (threadIdx.x == 0) (void)xb_add(&bar[XB_XCNT(b.x)], 1u);
    return b;
}
__device__ __forceinline__ void xcd_barrier_complete(unsigned* bar, unsigned x, unsigned& nloc, unsigned& nx) {
    const unsigned G = gridDim.x * gridDim.y * gridDim.z;
    unsigned sum, cnt, mine, sp = 0u;
    for (;;) {
        sum = 0u; cnt = 0u; mine = 0u;
#pragma unroll
        for (unsigned j = 0; j < 16; ++j) { const unsigned c = xb_ld(&bar[XB_XCNT(j)]); sum += c; cnt += (c > 0u) ? 1u : 0u; mine = (j == x) ? c : mine; }
        if (sum == G) break;
        __builtin_amdgcn_s_sleep(1);
        if ((++sp & 255u) == 0u) { if (xb_ld(&bar[XB_TMO])) break; if (sp > XB_SPIN_CAP) { atomicAdd(&bar[XB_TMO], 1u); break; } }
    }
    nloc = mine > 0u ? mine : 1u; nx = cnt > 0u ? cnt : 1u;
}
__device__ __forceinline__ void xcd_barrier(const XcdBarrier& b) {
    asm volatile("s_waitcnt vmcnt(0)" ::: "memory");
    __syncthreads();
    if (threadIdx.x == 0) {
        unsigned* bar = b.bar;
        __builtin_amdgcn_s_waitcnt(0);
        unsigned nloc = b.st[0], nx = b.st[1];
        if (nloc == 0u) { xcd_barrier_complete(bar, b.x, nloc, nx); b.st[0] = nloc; b.st[1] = nx; }
        const unsigned old = xb_add(&bar[XB_XSUB(b.x)], 1u);
        const unsigned gen = old / nloc;
        if (old + 1u == (gen + 1u) * nloc) {
            __builtin_amdgcn_fence(__ATOMIC_RELEASE, "agent");
            asm volatile("s_waitcnt vmcnt(0)" ::: "memory");
            const unsigned og = xb_add(&bar[XB_TOP], 1u);
            const unsigned tg = og / nx;
            if (og + 1u == (tg + 1u) * nx) xb_add(&bar[XB_TOPGEN], 1u);
            else XB_SPIN(xb_ld(&bar[XB_TOPGEN]) == tg, bar);
            __builtin_amdgcn_fence(__ATOMIC_ACQUIRE, "agent");
            xb_add(&bar[XB_XGEN(b.x)], 1u);
            asm volatile("s_waitcnt vmcnt(0)" ::: "memory");
        } else {
            XB_SPIN(xb_ld(&bar[XB_XGEN(b.x)]) == gen, bar);
            __builtin_amdgcn_fence(__ATOMIC_ACQUIRE, "agent");
            asm volatile("s_waitcnt vmcnt(0)" ::: "memory");
        }
    }
    __syncthreads();
}

namespace pg8 {
constexpr int BM = 256, BK = 64, HALF = 128, HTB = HALF * BK * 2, STAGE_BYTES = 8 * HTB, NXCD = 8, WGM = 8;
template <int SH> __host__ __device__ __forceinline__ int lds_byte(int r, int cb) { const int st = (r >> 4) * 2 + (cb >> 6), rr = r & 15, ob = rr * 64 + (cb & 63); return st * 1024 + (ob ^ (((ob >> 9) & 1) << SH)); }
template <int SH> __host__ __device__ __forceinline__ void stage_rc(int b, int& R, int& CB) { const int st = b / 1024, sb = b % 1024, swz = sb ^ (((sb >> 9) & 1) << SH); R = (st >> 1) * 16 + swz / 64; CB = (st & 1) * 64 + (swz % 64); }
__host__ __device__ __forceinline__ int perm32(int rho) { const int n = rho >> 4, i = rho & 15; return 8 * (i >> 2) + 4 * n + (i & 3); }

struct Unit { int pm, pn, bt, e, prow, cnt; };
struct Gemm { const void* A; const void* Bt; int Kb; };

__device__ __forceinline__ void tile_of(int L, int nM, int nN, int nwg, int& pm, int& pn) {
    int wgid = L; { const int q = nwg / NXCD, r = nwg % NXCD, xcd = wgid % NXCD, off = wgid / NXCD; wgid = (xcd < r ? xcd * (q + 1) : r * (q + 1) + (xcd - r) * q) + off; }
    const int nig = WGM * nN, gid = wgid / nig, fm = gid * WGM, gsz = (nM - fm) < WGM ? (nM - fm) : WGM;
    pm = fm + ((wgid % nig) % gsz); pn = (wgid % nig) / gsz;
}
struct StaticOrder {
    int nM, nN, nwg, G, c, base, lim;
    __device__ void init(int M, int N, int G_, int c_) { nM = M / BM; nN = N / BM; nwg = nM * nN; G = G_; c = c_; base = 0; lim = 1 << 30; }
    __device__ __forceinline__ bool next(int i, Unit& u) const {
        if (i >= lim) return false;
        const long L = (long)(i + base) * G + c; if (L >= nwg) return false;
        tile_of((int)L, nM, nN, nwg, u.pm, u.pn); u.bt = u.pn; u.e = 0; u.prow = 0; u.cnt = 0; return true;
    }
};
struct MoeOrder {
    int nM, nN, nwg, G, c; const LAS int* tp; const LAS unsigned char* te; const LAS int* cnt;
    __device__ __forceinline__ bool next(int i, Unit& u) const {
        const long L = (long)i * G + c; if (L >= nwg) return false;
        tile_of((int)L, nM, nN, nwg, u.pm, u.pn);
        const int e = __builtin_amdgcn_readfirstlane((int)te[u.pm]);
        u.e = e; u.bt = e * nN + u.pn; u.prow = (u.pm - __builtin_amdgcn_readfirstlane(tp[e])) * BM; u.cnt = __builtin_amdgcn_readfirstlane(cnt[e]); return true;
    }
};

struct EpiProj {
    static constexpr bool PERM = true, HAS_BIAS = false;
    __device__ __forceinline__ const float* bias_src(const Unit&, int) const { return nullptr; }
    bf16_t* O;
    __device__ __forceinline__ void operator()(const f32x4 (&acc)[2][2][4][2], const Unit& u, int wr, int wc, int fr, int fq, const LAS float*) const {
        const int row0 = u.pm * BM + wr * 64 + fr, col0 = u.pn * BM + wc * 32 + 8 * fq;
        const int mode = (u.pn < 4) ? 1 : (u.pn >= 8 ? 2 : (u.pn == 4 ? 3 : 0));
#pragma unroll
        for (int ai = 0; ai < 2; ++ai)
#pragma unroll
            for (int m = 0; m < 4; ++m) { bf16_t* rowp = O + (size_t)(row0 + ai * HALF + m * 16) * NPROJ + col0;
#pragma unroll
                for (int bj = 0; bj < 2; ++bj) { f32x2 v[4];
#pragma unroll
                    for (int n = 0; n < 2; ++n) { v[2 * n] = (f32x2){acc[ai][bj][m][n][0], acc[ai][bj][m][n][1]}; v[2 * n + 1] = (f32x2){acc[ai][bj][m][n][2], acc[ai][bj][m][n][3]}; }
                    if (mode == 1) {
#pragma unroll
                        for (int i = 0; i < 4; ++i) v[i] = gelu_tanh2(v[i]);
                    } else if (mode == 2) {
#pragma unroll
                        for (int i = 0; i < 4; ++i) v[i] = silu2(v[i]);
                    } else if (mode == 3) {
#pragma unroll
                        for (int i = 0; i < 4; ++i) v[i] = v[i] * 0.125f;
                    }
                    u32x4 w; w.x = pk2(v[0][0], v[0][1]); w.y = pk2(v[1][0], v[1][1]); w.z = pk2(v[2][0], v[2][1]); w.w = pk2(v[3][0], v[3][1]);
                    *(u32x4*)(rowp + bj * HALF) = w; } }
    }
};
struct EpiPlain {
    static constexpr bool PERM = true, HAS_BIAS = false;
    __device__ __forceinline__ const float* bias_src(const Unit&, int) const { return nullptr; }
    bf16_t* O; int ldc;
    __device__ __forceinline__ void operator()(const f32x4 (&acc)[2][2][4][2], const Unit& u, int wr, int wc, int fr, int fq, const LAS float*) const {
        const int row0 = u.pm * BM + wr * 64 + fr, col0 = u.pn * BM + wc * 32 + 8 * fq;
#pragma unroll
        for (int ai = 0; ai < 2; ++ai)
#pragma unroll
            for (int m = 0; m < 4; ++m) { bf16_t* rowp = O + (size_t)(row0 + ai * HALF + m * 16) * ldc + col0;
#pragma unroll
                for (int bj = 0; bj < 2; ++bj) { const f32x4 v0 = acc[ai][bj][m][0], v1 = acc[ai][bj][m][1];
                    u32x4 w; w.x = pk2(v0[0], v0[1]); w.y = pk2(v0[2], v0[3]); w.z = pk2(v1[0], v1[1]); w.w = pk2(v1[2], v1[3]);
                    *(u32x4*)(rowp + bj * HALF) = w; } }
    }
};
struct EpiSwiglu {
    static constexpr bool PERM = true, HAS_BIAS = true;
    unsigned char* H; const float* bg; const float* bu;
    __device__ __forceinline__ const float* bias_src(const Unit& u, int j) const { return (j < 128 ? bg : bu) + (size_t)u.e * 1024 + u.pn * HALF + (j & 127); }
    __device__ __forceinline__ void operator()(const f32x4 (&acc)[2][2][4][2], const Unit& u, int wr, int wc, int fr, int fq, const LAS float* btab) const {
        const int row0 = u.pm * BM + wr * 64 + fr, hc0 = u.pn * HALF + wc * 32 + 8 * fq;
        f32x4 bgv[2], buv[2];
#pragma unroll
        for (int n = 0; n < 2; ++n) { bgv[n] = *(const LAS f32x4*)(btab + wc * 32 + 8 * fq + 4 * n); buv[n] = *(const LAS f32x4*)(btab + 128 + wc * 32 + 8 * fq + 4 * n); }
#pragma unroll
        for (int ai = 0; ai < 2; ++ai)
#pragma unroll
            for (int m = 0; m < 4; ++m) { f32x2 h[4];
#pragma unroll
                for (int n = 0; n < 2; ++n)
#pragma unroll
                    for (int q = 0; q < 2; ++q) {
                        f32x2 g = (f32x2){acc[ai][0][m][n][2 * q], acc[ai][0][m][n][2 * q + 1]} + (f32x2){bgv[n][2 * q], bgv[n][2 * q + 1]};
                        g = (f32x2){fminf(g[0], 7.0f), fminf(g[1], 7.0f)};
                        const f32x2 uu = clamp2((f32x2){acc[ai][1][m][n][2 * q], acc[ai][1][m][n][2 * q + 1]} + (f32x2){buv[n][2 * q], buv[n][2 * q + 1]}, -7.0f, 7.0f);
                        h[2 * n + q] = ((uu + 1.0f) * g) * rcp2(exp2_2(g * (-1.702f * 1.4426950408889634f)) + 1.0f); }
                *(u32x2*)(H + (size_t)(row0 + ai * HALF + m * 16) * 1024 + hc0) = (u32x2){pk4_fp8(h[0][0], h[0][1], h[1][0], h[1][1]), pk4_fp8(h[2][0], h[2][1], h[3][0], h[3][1])}; }
    }
};
struct EpiOut8 {
    static constexpr bool PERM = true, HAS_BIAS = true;
    unsigned char* O; const float* bd;
    __device__ __forceinline__ const float* bias_src(const Unit& u, int j) const { return bd + (size_t)u.e * 1024 + u.pn * BM + j; }
    __device__ __forceinline__ void operator()(const f32x4 (&acc)[2][2][4][2], const Unit& u, int wr, int wc, int fr, int fq, const LAS float* btab) const {
        const int row0 = u.pm * BM + wr * 64 + fr, col0 = u.pn * BM + wc * 32 + 8 * fq;
        f32x4 bv[2][2];
#pragma unroll
        for (int bj = 0; bj < 2; ++bj)
#pragma unroll
            for (int n = 0; n < 2; ++n) bv[bj][n] = *(const LAS f32x4*)(btab + bj * HALF + wc * 32 + 8 * fq + 4 * n);
#pragma unroll
        for (int ai = 0; ai < 2; ++ai)
#pragma unroll
            for (int m = 0; m < 4; ++m) { unsigned char* rowp = O + (size_t)(row0 + ai * HALF + m * 16) * 1024 + col0;
#pragma unroll
                for (int bj = 0; bj < 2; ++bj) { f32x2 v[4];
#pragma unroll
                    for (int n = 0; n < 2; ++n)
#pragma unroll
                        for (int q = 0; q < 2; ++q) v[2 * n + q] = clamp2(((f32x2){acc[ai][bj][m][n][2 * q], acc[ai][bj][m][n][2 * q + 1]} + (f32x2){bv[bj][n][2 * q], bv[bj][n][2 * q + 1]}) * OSCALE, -440.0f, 440.0f);
                    *(u32x2*)(rowp + bj * HALF) = (u32x2){pk4_fp8(v[0][0], v[0][1], v[1][0], v[1][1]), pk4_fp8(v[2][0], v[2][1], v[3][0], v[3][1])}; } }
    }
};

typedef int i32x4 __attribute__((ext_vector_type(4)));
typedef int i32x8 __attribute__((ext_vector_type(8)));
template <bool FP8> struct Frag;
template <> struct Frag<false> { bf16x8 k0, k1; __device__ __forceinline__ void ld(const LAS unsigned char* p0, const LAS unsigned char* p1) { k0 = *(const LAS bf16x8*)p0; k1 = *(const LAS bf16x8*)p1; } };
template <> struct Frag<true> { i32x8 v; __device__ __forceinline__ void ld(const LAS unsigned char* p0, const LAS unsigned char* p1) { v = __builtin_shufflevector(*(const LAS i32x4*)p0, *(const LAS i32x4*)p1, 0, 1, 2, 3, 4, 5, 6, 7); } };
__device__ __forceinline__ f32x4 frag_mma(const Frag<false>& b, const Frag<false>& a, f32x4 c) { c = __builtin_amdgcn_mfma_f32_16x16x32_bf16(b.k0, a.k0, c, 0, 0, 0); return __builtin_amdgcn_mfma_f32_16x16x32_bf16(b.k1, a.k1, c, 0, 0, 0); }
__device__ __forceinline__ f32x4 frag_mma(const Frag<true>& b, const Frag<true>& a, f32x4 c, int sw, int s1) {
    asm volatile("s_nop 1\n\tv_mfma_scale_f32_16x16x128_f8f6f4 %0, %1, %2, %0, %3, %4 op_sel_hi:[0,0,0]" : "+v"(c) : "v"(b.v), "v"(a.v), "v"(sw), "v"(s1)); return c; }
__device__ __forceinline__ f32x4 frag_mma(const Frag<false>& b, const Frag<false>& a, f32x4 c, int, int) { return frag_mma(b, a, c); }
template <class Epi, class Sched, bool ALIGN_EPI, bool GATHER, bool FP8>
__device__ __forceinline__ void gemm_phase(LAS unsigned char* lds, const Gemm g, const Sched& S, const Epi& E, const LAS unsigned short* tok) {
    const int tid = threadIdx.x, wid = __builtin_amdgcn_readfirstlane(tid >> 6), lane = tid & 63, wr = wid >> 2, wc = wid & 3, fr = lane & 15, fq = lane >> 4;
    constexpr int SH = FP8 ? 4 : 5;
    const int K = g.Kb, nt = K / 128;
    unsigned voffB[2]; unsigned va[2][2], vn[2][2]; int RA[2], CA[2];
#pragma unroll
    for (int i = 0; i < 2; ++i) { int R, C; stage_rc<SH>(tid * 16 + i * 8192, R, C); const int Rb = Epi::PERM ? ((R & ~31) + perm32(R & 31)) : R;
        RA[i] = R; CA[i] = C; voffB[i] = (unsigned)(Rb * K + C);
#pragma unroll
        for (int h = 0; h < 2; ++h) { va[h][i] = (unsigned)((R + h * HALF) * K + C); vn[h][i] = va[h][i]; } }
    const size_t kstep = 128;
    const size_t hstep = (size_t)HALF * K;
    const size_t tstep = 2 * hstep;
    const unsigned ldsw = (unsigned)wid * 1024u;
    const int aoff0 = FP8 ? lds_byte<SH>(wr * 64 + fr, fq * 32) : lds_byte<SH>(wr * 64 + fr, fq * 16), aoff1 = FP8 ? lds_byte<SH>(wr * 64 + fr, fq * 32 + 16) : aoff0 + 1024;
    const int boff0 = FP8 ? lds_byte<SH>(wc * 32 + fr, fq * 32) : lds_byte<SH>(wc * 32 + fr, fq * 16), boff1 = FP8 ? lds_byte<SH>(wc * 32 + fr, fq * 32 + 16) : boff0 + 1024;
#define PG8_SA(b, h) (((b) * 2 + (h)) * HTB)
#define PG8_SB(b, h) ((4 + (b) * 2 + (h)) * HTB)
#define PG8_STAGE(bufoff, gbase, voff) do { _Pragma("unroll") for (int _i = 0; _i < 2; ++_i) \
        __builtin_amdgcn_global_load_lds((const unsigned*)((const char*)(gbase) + (voff)[_i]), (LAS unsigned*)(lds + (bufoff) + ldsw + _i * 8192), 16, 0, 0); } while (0)
#define PG8_LDA(dst, b, h) do { _Pragma("unroll") for (int m = 0; m < 4; ++m) dst[m].ld(lds + PG8_SA(b, h) + aoff0 + m * 2048, lds + PG8_SA(b, h) + aoff1 + m * 2048); } while (0)
#define PG8_LDB(dst, b, h) do { _Pragma("unroll") for (int n = 0; n < 2; ++n) dst[n].ld(lds + PG8_SB(b, h) + boff0 + n * 2048, lds + PG8_SB(b, h) + boff1 + n * 2048); } while (0)
#define PG8_MMA(ai, bj, At, Bt) do { __builtin_amdgcn_s_setprio(1); _Pragma("unroll") for (int m = 0; m < 4; ++m) _Pragma("unroll") for (int n = 0; n < 2; ++n) \
        acc[ai][bj][m][n] = frag_mma(Bt[n], At[m], acc[ai][bj][m][n], sc_w, sc_1); __builtin_amdgcn_s_setprio(0); } while (0)
#define PG8_WAIT_V(n) asm volatile("s_waitcnt vmcnt(" #n ")" ::: "memory")
#define PG8_WAIT_L(n) asm volatile("s_waitcnt lgkmcnt(" #n ")" ::: "memory")
#define PG8_BAR __builtin_amdgcn_s_barrier()
#define PG8_SCHED __builtin_amdgcn_sched_barrier(0)
#define PG8_GATHER_OFFS(dst, ui_) do { _Pragma("unroll") for (int _h = 0; _h < 2; ++_h) _Pragma("unroll") for (int _i = 0; _i < 2; ++_i) \
        dst[_h][_i] = (unsigned)tok[(ui_) * 256 + _h * HALF + RA[_i]] * (unsigned)K + (unsigned)CA[_i]; } while (0)
    Unit cur, nxt; int ui = 0;
    if (!S.next(0, cur)) return;
    f32x4 acc[2][2][4][2];
#pragma unroll
    for (int a = 0; a < 2; ++a)
#pragma unroll
        for (int b = 0; b < 2; ++b)
#pragma unroll
            for (int m = 0; m < 4; ++m)
#pragma unroll
                for (int n = 0; n < 2; ++n) acc[a][b][m][n] = (f32x4){0.f, 0.f, 0.f, 0.f};
    Frag<FP8> At[4], B0[2], B1[2];
    int sc_w = W8_SCALE_E8M0, sc_1 = 0x7F7F7F7F;
    if constexpr (FP8) { asm volatile("" : "+v"(sc_w), "+v"(sc_1)); }
    const char* cA = GATHER ? (const char*)g.A : (const char*)g.A + (size_t)cur.pm * tstep;
    const char* cB = (const char*)g.Bt + (size_t)cur.bt * tstep;
    if constexpr (GATHER) { PG8_GATHER_OFFS(va, 0); }
#define PG8_BIAS_DMA(unit_, slot_) do { if constexpr (Epi::HAS_BIAS) { if (wid < 4) \
        __builtin_amdgcn_global_load_lds((const unsigned*)E.bias_src(unit_, wid * 64 + lane), (LAS unsigned*)(lds + BIAS_OFF + (slot_) * 1024 + wid * 256), 4, 0, 0); } } while (0)
    PG8_BIAS_DMA(cur, 0);
    PG8_STAGE(PG8_SB(0, 0), cB, voffB); PG8_STAGE(PG8_SB(0, 1), cB + hstep, voffB); PG8_STAGE(PG8_SA(0, 0), cA, va[0]); PG8_STAGE(PG8_SA(0, 1), cA, va[1]);
    if (wr == 1) PG8_BAR;
    PG8_WAIT_V(2); PG8_BAR;
    PG8_STAGE(PG8_SB(1, 0), cB + kstep, voffB); PG8_STAGE(PG8_SA(1, 0), cA + kstep, va[0]); PG8_STAGE(PG8_SB(1, 1), cB + hstep + kstep, voffB);
    PG8_WAIT_V(6); PG8_BAR;
    for (;;) {
        const bool has_next = S.next(ui + 1, nxt);
        const char* nA = GATHER ? (const char*)g.A : (has_next ? (const char*)g.A + (size_t)nxt.pm * tstep : cA);
        const char* nB = has_next ? (const char*)g.Bt + (size_t)nxt.bt * tstep : cB;
        if constexpr (GATHER) { if (has_next) { PG8_GATHER_OFFS(vn, ui + 1); } else {
#pragma unroll
            for (int h = 0; h < 2; ++h)
#pragma unroll
                for (int i = 0; i < 2; ++i) vn[h][i] = va[h][i]; } }
#pragma nounroll
        for (int t = 0; t < nt; t += 2) {
            const bool last = (t == nt - 2);
            const char* a1 = cA + (size_t)(t + 1) * kstep;
            const char* a2 = last ? nA : cA + (size_t)(t + 2) * kstep; const char* b2 = last ? nB : cB + (size_t)(t + 2) * kstep;
            const char* a3 = a2 + kstep; const char* b3 = b2 + kstep;
            unsigned v0[2], v1[2];
            if (last && has_next) PG8_BIAS_DMA(nxt, (ui + 1) & 1);
            if constexpr (GATHER) {
#pragma unroll
                for (int i = 0; i < 2; ++i) { v0[i] = last ? vn[0][i] : va[0][i]; v1[i] = last ? vn[1][i] : va[1][i]; }
            } else {
#pragma unroll
                for (int i = 0; i < 2; ++i) { v0[i] = va[0][i]; v1[i] = va[1][i]; }
            }
            PG8_LDB(B0, 0, 0); PG8_LDB(B1, 0, 1); PG8_SCHED; PG8_LDA(At, 0, 0); PG8_STAGE(PG8_SA(1, 1), a1, va[1]);
            PG8_WAIT_V(8); PG8_WAIT_L(0); PG8_BAR; PG8_MMA(0, 0, At, B0); PG8_MMA(0, 1, At, B1); PG8_BAR; PG8_SCHED;
            PG8_LDA(At, 0, 1); PG8_STAGE(PG8_SB(0, 0), b2, voffB); PG8_STAGE(PG8_SB(0, 1), b2 + hstep, voffB); PG8_STAGE(PG8_SA(0, 0), a2, v0);
            PG8_WAIT_V(8); PG8_WAIT_L(0); PG8_BAR; PG8_MMA(1, 0, At, B0); PG8_MMA(1, 1, At, B1); PG8_BAR; PG8_SCHED;
            PG8_LDB(B0, 1, 0); PG8_LDB(B1, 1, 1); PG8_SCHED; PG8_LDA(At, 1, 0); PG8_STAGE(PG8_SA(0, 1), a2, v1);
            PG8_WAIT_V(8); PG8_WAIT_L(0); PG8_BAR; PG8_MMA(0, 0, At, B0); PG8_MMA(0, 1, At, B1); PG8_BAR; PG8_SCHED;
            PG8_LDA(At, 1, 1); PG8_STAGE(PG8_SB(1, 0), b3, voffB); PG8_STAGE(PG8_SB(1, 1), b3 + hstep, voffB); PG8_STAGE(PG8_SA(1, 0), a3, v0);
            PG8_WAIT_V(8); PG8_WAIT_L(0); PG8_BAR; PG8_MMA(1, 0, At, B0); PG8_MMA(1, 1, At, B1); PG8_BAR; PG8_SCHED;
        }
        if constexpr (ALIGN_EPI) { if (wr == 0) PG8_BAR; }
        if constexpr (FP8) { asm volatile("s_nop 15\n\ts_nop 7"); PG8_SCHED; }
        E(acc, cur, wr, wc, fr, fq, (const LAS float*)(lds + BIAS_OFF + (ui & 1) * 1024));
        if (!has_next) break;
#pragma unroll
        for (int a = 0; a < 2; ++a)
#pragma unroll
            for (int b = 0; b < 2; ++b)
#pragma unroll
                for (int m = 0; m < 4; ++m)
#pragma unroll
                    for (int n = 0; n < 2; ++n) acc[a][b][m][n] = (f32x4){0.f, 0.f, 0.f, 0.f};
        cur = nxt; cA = nA; cB = nB; ++ui;
        if constexpr (GATHER) {
#pragma unroll
            for (int h = 0; h < 2; ++h)
#pragma unroll
                for (int i = 0; i < 2; ++i) va[h][i] = vn[h][i]; }
        if constexpr (ALIGN_EPI) { if (wr == 1) PG8_BAR; }
    }
    PG8_WAIT_V(0);
    if constexpr (!ALIGN_EPI) { if (wr == 0) PG8_BAR; }
    PG8_BAR;
#undef PG8_SA
#undef PG8_SB
#undef PG8_STAGE
#undef PG8_LDA
#undef PG8_LDB
#undef PG8_MMA
#undef PG8_WAIT_V
#undef PG8_WAIT_L
#undef PG8_BAR
#undef PG8_SCHED
#undef PG8_GATHER_OFFS
#undef PG8_BIAS_DMA
}
}

struct Args { const float* in[24]; float* out; unsigned char* ws; int ph_lo, ph_hi; };
enum { I_X = 0, I_C, I_WADA, I_BADA, I_GPRE, I_WIN, I_GSGU, I_WS, I_BS, I_WGK2, I_BGK, I_GGLA, I_WOUT, I_GPOST, I_GPFFN, I_WR, I_BR, I_WG, I_BG, I_WU, I_BU, I_WDN, I_BDN, I_GPOSTF };

template <bool FP8>
__device__ __forceinline__ void transpose_item(const float* W, int ldw, int k0, int n0, void* WT, size_t dst_row0, LAS float* scr, int lane) {
    f32x4 v[8];
#pragma unroll
    for (int q = 0; q < 8; ++q) v[q] = *(const f32x4*)(W + (size_t)(k0 + 8 * q + (lane >> 3)) * ldw + n0 + 4 * (lane & 7));
#pragma unroll
    for (int q = 0; q < 8; ++q) { LAS float* d = scr + (8 * q + (lane >> 3)) * 33 + 4 * (lane & 7); d[0] = v[q][0]; d[1] = v[q][1]; d[2] = v[q][2]; d[3] = v[q][3]; }
    asm volatile("s_waitcnt lgkmcnt(0)" ::: "memory");
    const int c = lane & 7;
#pragma unroll
    for (int j = 0; j < 4; ++j) { const int n = (lane >> 3) + 8 * j; const LAS float* s = scr + (8 * c) * 33 + n;
        if constexpr (FP8) {
            const u32x2 o = (u32x2){pk4_fp8(s[0 * 33] * W8_SCALE, s[1 * 33] * W8_SCALE, s[2 * 33] * W8_SCALE, s[3 * 33] * W8_SCALE), pk4_fp8(s[4 * 33] * W8_SCALE, s[5 * 33] * W8_SCALE, s[6 * 33] * W8_SCALE, s[7 * 33] * W8_SCALE)};
            *(u32x2*)((unsigned char*)WT + (dst_row0 + n) * 1024 + k0 + 8 * c) = o;
        } else {
            u32x4 o; o.x = pk2(s[0 * 33], s[1 * 33]); o.y = pk2(s[2 * 33], s[3 * 33]); o.z = pk2(s[4 * 33], s[5 * 33]); o.w = pk2(s[6 * 33], s[7 * 33]);
            *(u32x4*)((bf16_t*)WT + (dst_row0 + n) * 1024 + k0 + 8 * c) = o; } }
    asm volatile("s_waitcnt lgkmcnt(0)" ::: "memory");
}
__device__ __forceinline__ void p0_prologue(const Args& a, LAS unsigned char* lds, int G) {
    const int tid = threadIdx.x, lane = tid & 63, wave = __builtin_amdgcn_readfirstlane(tid >> 6);
    const int gw = blockIdx.x * 8 + wave, NGW = G * 8;
    unsigned char* ws = a.ws;
    {
        float* mods = (float*)(ws + WS_MODS);
        const float* c = a.in[I_C]; const float* wa = a.in[I_WADA]; const float* ba = a.in[I_BADA];
        LAS float* sc = (LAS float*)lds;
        LAS float* part = (LAS float*)(lds + 16384);
        if ((int)blockIdx.x < 96) { for (int i = tid; i < 4096; i += 512) sc[i] = silu_(c[i]); __syncthreads(); }
        for (int it = blockIdx.x; it < 96; it += G) {
            const int r = lane >> 4, cq = lane & 15, k0 = wave * 128;
            const float* wp = wa + (size_t)(k0 + r) * 6144 + it * 64 + 4 * cq;
            f32x4 wv[32];
#pragma unroll
            for (int i = 0; i < 32; ++i) wv[i] = __builtin_nontemporal_load((const f32x4*)(wp + (size_t)(4 * i) * 6144));
            f32x4 acc[4];
#pragma unroll
            for (int b = 0; b < 4; ++b) acc[b] = (f32x4){0.f, 0.f, 0.f, 0.f};
#pragma unroll
            for (int i = 0; i < 32; ++i)
#pragma unroll
                for (int b = 0; b < 4; ++b) acc[b] += wv[i] * sc[b * 1024 + k0 + 4 * i + r];
#pragma unroll
            for (int b = 0; b < 4; ++b)
#pragma unroll
                for (int e2 = 0; e2 < 4; ++e2) { float t = acc[b][e2]; t += __shfl_xor(t, 16); t += __shfl_xor(t, 32); acc[b][e2] = t; }
            if (lane < 16) {
#pragma unroll
                for (int b = 0; b < 4; ++b) *(LAS f32x4*)(part + (wave * 4 + b) * 64 + 4 * cq) = acc[b]; }
            __syncthreads();
            if (tid < 256) { const int b = tid >> 6, cc = tid & 63; float sv = ba[it * 64 + cc];
#pragma unroll
                for (int w = 0; w < 8; ++w) sv += part[(w * 4 + b) * 64 + cc];
                mods[b * 6144 + it * 64 + cc] = sv; }
            __syncthreads();
        }
    }
    {
        const float* wr = a.in[I_WR]; bf16_t* wh = (bf16_t*)(ws + WS_WR); bf16_t* wl = wh + 32 * 1024;
        for (int idx = blockIdx.x * 512 + tid; idx < 32768; idx += G * 512) { const int k = idx >> 5, j = idx & 31; const float w = wr[idx];
            const unsigned h = f2bf(w); wh[j * 1024 + k] = (bf16_t)h; wl[j * 1024 + k] = (bf16_t)f2bf(w - bf2f(h)); }
    }
    {
        LAS float* scr = (LAS float*)(lds + wave * 16384);
        constexpr int I_IN = 16 * 80, I_OUT = 16 * 32, I_E = 16 * 32;
        constexpr int NITEMS = I_IN + I_OUT + 3 * NE * I_E;
        bf16_t* Win = (bf16_t*)(ws + WS_WIN); bf16_t* Wout = (bf16_t*)(ws + WS_WOUT);
        (void)NITEMS;
        for (int it = gw; it < I_IN + I_OUT; it += NGW) {
            int r = it;
            if (r < I_IN) { const int kb = r / 80, nb = r % 80; transpose_item<false>(a.in[I_WIN], D_IN, 64 * kb, 32 * nb, Win, (size_t)(32 * nb), scr, lane); continue; } r -= I_IN;
            { const int kb = r / 32, nb = r % 32; transpose_item<false>(a.in[I_WOUT], 1024, 64 * kb, 32 * nb, Wout, (size_t)(32 * nb), scr, lane); }
        }
    }
}

constexpr int MOE_ITEMS = 3 * NE * 256;
__device__ __forceinline__ void moe_convert(const Args& a, LAS unsigned char* lds, int G, int first, int last) {
    (void)lds;
    const int tid = threadIdx.x, lane = tid & 63, wave = __builtin_amdgcn_readfirstlane(tid >> 6);
    const int gw = blockIdx.x * 8 + wave, NGW = G * 8;
    unsigned char* Wd = a.ws + WS_WD; unsigned char* W1 = a.ws + WS_W1;
    constexpr int I_E8 = 8 * 32;
#define MC_DECODE(it_, src_, dst_) do { int r = (it_); const int mat = r / (NE * I_E8); r -= mat * (NE * I_E8); const int e = r / I_E8; r -= e * I_E8; \
        const int nb = 8 * (r >> 6) + (r & 7), kb = (r >> 3) & 7, n0 = 32 * nb, k0 = 128 * kb; \
        const float* Wm = (mat == 0 ? a.in[I_WG] : (mat == 1 ? a.in[I_WU] : a.in[I_WDN])) + (size_t)e * 1048576; \
        const size_t drow = (mat == 2) ? (size_t)e * 1024 + n0 : (size_t)e * 2048 + (size_t)(n0 >> 7) * 256 + (size_t)mat * 128 + (size_t)(n0 & 127); \
        dst_ = (mat == 2 ? Wd : W1) + (drow + 4 * (lane & 7)) * 1024 + k0 + 16 * (lane >> 3); src_ = Wm + (size_t)(k0 + 16 * (lane >> 3)) * 1024 + n0 + 4 * (lane & 7); } while (0)
#define MC_LOAD(vv, src_) do { _Pragma("unroll") for (int q = 0; q < 16; ++q) vv[q] = __builtin_nontemporal_load((const f32x4*)((src_) + (size_t)q * 1024)); } while (0)
#define MC_PROC(vv, dst_) do { u32x4 o_[4]; \
        _Pragma("unroll") for (int g4 = 0; g4 < 4; ++g4) { unsigned D_[4]; \
            _Pragma("unroll") for (int q = 0; q < 4; ++q) { const f32x4 t_ = vv[4 * g4 + q] * W8_SCALE; D_[q] = pk4_fp8(t_[0], t_[1], t_[2], t_[3]); } \
            const unsigned pa = __builtin_amdgcn_perm(D_[1], D_[0], 0x05010400u), pb = __builtin_amdgcn_perm(D_[1], D_[0], 0x07030602u); \
            const unsigned pc = __builtin_amdgcn_perm(D_[3], D_[2], 0x05010400u), pd = __builtin_amdgcn_perm(D_[3], D_[2], 0x07030602u); \
            o_[0][g4] = __builtin_amdgcn_perm(pc, pa, 0x05040100u); o_[1][g4] = __builtin_amdgcn_perm(pc, pa, 0x07060302u); \
            o_[2][g4] = __builtin_amdgcn_perm(pd, pb, 0x05040100u); o_[3][g4] = __builtin_amdgcn_perm(pd, pb, 0x07060302u); } \
        _Pragma("unroll") for (int j = 0; j < 4; ++j) __builtin_nontemporal_store(o_[j], (u32x4*)((dst_) + (size_t)j * 1024)); } while (0)
    int it = first + gw;
    if (it < last) {
        const int nmine = (last - 1 - it) / NGW;
        const int itlast = it + nmine * NGW;
        const float* sA; unsigned char* dA; const float* sB; unsigned char* dB; f32x4 v[16], w[16];
        MC_DECODE(it, sA, dA); MC_LOAD(v, sA);
        for (; it < last; it += 2 * NGW) {
            const int itb = (it + NGW <= itlast) ? it + NGW : itlast, ita = (it + 2 * NGW <= itlast) ? it + 2 * NGW : itlast;
            MC_DECODE(itb, sB, dB); MC_LOAD(w, sB);
            MC_PROC(v, dA);
            MC_DECODE(ita, sA, dA); MC_LOAD(v, sA);
            MC_PROC(w, dB);
        }
    }
#undef MC_DECODE
#undef MC_LOAD
#undef MC_PROC
}

__device__ __forceinline__ void p1_norm(const Args& a, LAS unsigned char* lds, int G) {
    const int tid = threadIdx.x, lane = tid & 63, wave = __builtin_amdgcn_readfirstlane(tid >> 6);
    const float* x = a.in[I_X]; const float* win = a.in[I_WIN]; const float* gpre = a.in[I_GPRE];
    const float* mods = (const float*)(a.ws + WS_MODS);
    bf16_t* XN = (bf16_t*)(a.ws + WS_XN); float* glow = (float*)(a.ws + WS_GLOW);
    constexpr int NP1 = 1032;
    LAS bf16_t* NT = (LAS bf16_t*)lds; LAS float* RP = (LAS float*)(lds + 16 * NP1 * 2);
    bf16x8 wg[4];
#pragma unroll
    for (int ks = 0; ks < 4; ++ks)
#pragma unroll
        for (int e = 0; e < 8; ++e) { const int k = 128 * wave + 32 * ks + 8 * (lane >> 4) + e; wg[ks][e] = (short)f2bf(win[(size_t)k * D_IN + C_GL + (lane & 15)]); }
    for (int blk = blockIdx.x; blk < T / 128; blk += G) {
        const int b = (blk * 128) / SEQ;
        f32x4 A1[4], B1[4];
#pragma unroll
        for (int j = 0; j < 4; ++j) { const int k = 4 * lane + 256 * j; const f32x4 gv = *(const f32x4*)(gpre + k), sc = *(const f32x4*)(mods + b * 6144 + 1024 + k);
            A1[j] = gv * (sc + 1.0f); B1[j] = *(const f32x4*)(mods + b * 6144 + k); }
        f32x4 nx[4][4];
#define P1_ROWOF(q_) ((size_t)(blk * 128 + 16 * ((q_) >> 1) + 2 * wave + ((q_) & 1)))
#pragma unroll
        for (int d = 0; d < 4; ++d) { const size_t row = P1_ROWOF(d);
#pragma unroll
          for (int j = 0; j < 4; ++j) nx[d][j] = __builtin_nontemporal_load((const f32x4*)(x + row * 1024 + 4 * lane + 256 * j)); }
        for (int it0 = 0; it0 < 8; it0 += 2) {
#pragma unroll
          for (int iu = 0; iu < 2; ++iu) {
            const int it = it0 + iu;
#pragma unroll
            for (int rr = 0; rr < 2; ++rr) {
                const int r16 = 2 * wave + rr, q = 2 * it + rr, sl = 2 * iu + rr; const size_t row = P1_ROWOF(q);
                const int qn = q + 4 < 16 ? q + 4 : 15; const size_t rown = P1_ROWOF(qn);
                f32x4 v[4]; float ss = 0.f;
#pragma unroll
                for (int j = 0; j < 4; ++j) { v[j] = nx[sl][j]; ss += (v[j][0] * v[j][0] + v[j][1] * v[j][1]) + (v[j][2] * v[j][2] + v[j][3] * v[j][3]); }
#pragma unroll
                for (int j = 0; j < 4; ++j) nx[sl][j] = __builtin_nontemporal_load((const f32x4*)(x + rown * 1024 + 4 * lane + 256 * j));
                const float rstd = __builtin_amdgcn_rsqf(wave_sum(ss) * (1.0f / 1024.0f) + EPS);
#pragma unroll
                for (int j = 0; j < 4; ++j) { v[j] = v[j] * rstd * A1[j] + B1[j];
                    const u32x2 w = (u32x2){pk2(v[j][0], v[j][1]), pk2(v[j][2], v[j][3])};
                    *(u32x2*)(XN + row * 1024 + 4 * lane + 256 * j) = w; *(LAS u32x2*)(NT + r16 * NP1 + 4 * lane + 256 * j) = w; }
            }
            LDS_BARRIER();
            {
                f32x4 acc = (f32x4){0.f, 0.f, 0.f, 0.f};
#pragma unroll
                for (int ks = 0; ks < 4; ++ks) { const bf16x8 av = *(const LAS bf16x8*)(NT + (lane & 15) * NP1 + 128 * wave + 32 * ks + 8 * (lane >> 4)); acc = mfma16(av, wg[ks], acc); }
#pragma unroll
                for (int r = 0; r < 4; ++r) RP[wave * 256 + (4 * (lane >> 4) + r) * 16 + (lane & 15)] = acc[r];
            }
            LDS_BARRIER();
            if (tid < 256) { float sv = 0.f;
#pragma unroll
                for (int w = 0; w < 8; ++w) sv += RP[w * 256 + tid];
                glow[((size_t)blk * 128 + 16 * it) * 16 + tid] = sv; }
          }
        }
#undef P1_ROWOF
        LDS_BARRIER();
    }
}

__device__ __forceinline__ unsigned lo_pair(unsigned a, unsigned b) { return (a & 0xffffu) | (b << 16); }
__device__ __forceinline__ unsigned hi_pair(unsigned a, unsigned b) { return (a >> 16) | (b & 0xffff0000u); }
constexpr int VP32 = 68;
__device__ __forceinline__ void p3_sgu(const Args& a, LAS unsigned char* lds, int G) {
    const int tid = threadIdx.x, lane = tid & 63, wave = __builtin_amdgcn_readfirstlane(tid >> 6);
    const bf16_t* PROJ = (const bf16_t*)(a.ws + WS_PROJ); bf16_t* MIXA = (bf16_t*)(a.ws + WS_XN);
    const int nper = G / 8;
    const int h = blockIdx.x & 7, sub = blockIdx.x >> 3;
    if (sub >= nper) return;
    const int t = 16 * wave + (lane & 15);
    bf16x8 wf[4];
#pragma unroll
    for (int ks = 0; ks < 4; ++ks) { const float* wrow = a.in[I_WS] + ((size_t)h * 128 + t) * 128 + 32 * ks + 8 * (lane >> 4);
#pragma unroll
        for (int e2 = 0; e2 < 8; ++e2) { const int s = 32 * ks + 8 * (lane >> 4) + e2; const float w = (s <= t) ? wrow[e2] : 0.f; wf[ks][e2] = (short)f2bf(w); } }
    const float bias = a.in[I_BS][h * 128 + t];
    const int token = tid >> 2, part = tid & 3, odd = token & 1;
    float gs[16];
#pragma unroll
    for (int j = 0; j < 16; ++j) gs[j] = a.in[I_GSGU][h * 64 + part * 16 + j];
    u32x4 nr0, nr1; u32x2 nu[4];
#define SGU_LOAD(idx_) do { const int tok0_ = ((idx_) >> 6) * SEQ + ((idx_) & 63) * 128; \
        const bf16_t* src_ = PROJ + (size_t)(tok0_ + token) * NPROJ + C_VS + h * 64 + part * 16; nr0 = *(const u32x4*)src_; nr1 = *(const u32x4*)(src_ + 8); \
        _Pragma("unroll") for (int dt = 0; dt < 4; ++dt) nu[dt] = *(const u32x2*)(PROJ + (size_t)(tok0_ + t) * NPROJ + C_US + h * 64 + 16 * dt + 4 * (lane >> 4)); } while (0)
    SGU_LOAD(sub);
    int buf = 0;
    for (int idx = sub; idx < 256; idx += nper, buf ^= 1) {
        LAS unsigned* vhT = (LAS unsigned*)(lds + buf * (64 * VP32 * 4));
        const int tok0 = (idx >> 6) * SEQ + (idx & 63) * 128;
        const u32x4 r0 = nr0, r1 = nr1; u32x2 uu[4];
#pragma unroll
        for (int dt = 0; dt < 4; ++dt) uu[dt] = nu[dt];
        { const int idn = (idx + nper < 256) ? idx + nper : idx; SGU_LOAD(idn); }
        float v[16];
#pragma unroll
        for (int i = 0; i < 4; ++i) { v[2 * i] = bflo(r0[i]); v[2 * i + 1] = bfhi(r0[i]); v[8 + 2 * i] = bflo(r1[i]); v[8 + 2 * i + 1] = bfhi(r1[i]); }
        float ss = 0.f;
#pragma unroll
        for (int j = 0; j < 16; ++j) ss += v[j] * v[j];
        ss += __shfl_xor(ss, 1); ss += __shfl_xor(ss, 2);
        const float rstd = __builtin_amdgcn_rsqf(ss * (1.0f / 64.0f) + EPS);
        unsigned pw[8];
#pragma unroll
        for (int i = 0; i < 8; ++i) pw[i] = pk2(v[2 * i] * rstd * gs[2 * i], v[2 * i + 1] * rstd * gs[2 * i + 1]);
#pragma unroll
        for (int i = 0; i < 4; ++i) {
            const unsigned snd = odd ? pw[i] : pw[4 + i], own = odd ? pw[4 + i] : pw[i], rcv = (unsigned)__shfl_xor((int)snd, 4);
            const unsigned first = odd ? rcv : own, second = odd ? own : rcv;
            const int d = 16 * part + 8 * odd + 2 * i;
            vhT[d * VP32 + ((token >> 1) ^ (4 * (d >> 4)))] = lo_pair(first, second);
            vhT[(d + 1) * VP32 + ((token >> 1) ^ (4 * (d >> 4)))] = hi_pair(first, second); }
        LDS_BARRIER();
        f32x4 acc[4];
#pragma unroll
        for (int dt = 0; dt < 4; ++dt) acc[dt] = (f32x4){0.f, 0.f, 0.f, 0.f};
#pragma unroll
        for (int ks = 0; ks < 4; ++ks) if (ks <= (wave >> 1)) {
#pragma unroll
            for (int dt = 0; dt < 4; ++dt) { const bf16x8 av = *(const LAS bf16x8*)(vhT + (16 * dt + (lane & 15)) * VP32 + ((16 * ks + 4 * (lane >> 4)) ^ (4 * dt))); acc[dt] = mfma16(av, wf[ks], acc[dt]); } }
        const size_t trow = (size_t)(tok0 + t);
#pragma unroll
        for (int dt = 0; dt < 4; ++dt) { const int d = 16 * dt + 4 * (lane >> 4);
            const float o0 = bflo(uu[dt][0]) * (acc[dt][0] + bias), o1 = bfhi(uu[dt][0]) * (acc[dt][1] + bias), o2 = bflo(uu[dt][1]) * (acc[dt][2] + bias), o3 = bfhi(uu[dt][1]) * (acc[dt][3] + bias);
            *(u32x2*)(MIXA + trow * 1024 + h * 64 + d) = (u32x2){pk2(o0, o1), pk2(o2, o3)}; }
    }
#undef SGU_LOAD
}

constexpr int GP32 = 36;
constexpr int GP = 72;
constexpr int GL_WG2 = 0  , GL_WT = 4096  , GL_A = 6144  , GL_B = GL_A + 9216  , GL_VT = GL_B + 9216  ,
              GL_PM = GL_VT + 18432  , GL_RS = GL_PM + 9216  ;
__device__ __forceinline__ void gla_decay(const LAS float* wg2, LAS float* WT, const float (&bgk)[8], f32x2 g2, int lane, int wave, float (&bc)[8], float (&tot)[8]) {
    const int a8 = (lane & 7) * 8, base = lane & ~7;
    f32x2 xp[4];
#pragma unroll
    for (int e = 0; e < 4; ++e) xp[e] = (f32x2){bgk[2 * e], bgk[2 * e + 1]};
#pragma unroll
    for (int j = 0; j < 8; ++j) { const float x0 = __shfl(g2[0], base + j), x1 = __shfl(g2[1], base + j);
        const f32x4 w00 = *(const LAS f32x4*)(wg2 + (2 * j) * 64 + a8), w01 = *(const LAS f32x4*)(wg2 + (2 * j) * 64 + a8 + 4);
        const f32x4 w10 = *(const LAS f32x4*)(wg2 + (2 * j + 1) * 64 + a8), w11 = *(const LAS f32x4*)(wg2 + (2 * j + 1) * 64 + a8 + 4);
        xp[0] += (f32x2){w00[0], w00[1]} * x0; xp[1] += (f32x2){w00[2], w00[3]} * x0; xp[2] += (f32x2){w01[0], w01[1]} * x0; xp[3] += (f32x2){w01[2], w01[3]} * x0;
        xp[0] += (f32x2){w10[0], w10[1]} * x1; xp[1] += (f32x2){w10[2], w10[3]} * x1; xp[2] += (f32x2){w11[0], w11[1]} * x1; xp[3] += (f32x2){w11[2], w11[3]} * x1; }
    float la[8];
#pragma unroll
    for (int e = 0; e < 8; ++e) { const float xx = xp[e >> 1][e & 1];
        la[e] = (fminf(xx, 0.f) - 0.6931471806f * __builtin_amdgcn_logf(1.0f + __builtin_amdgcn_exp2f(-1.4426950409f * fabsf(xx)))) * (1.0f / 16.0f); }
#pragma unroll
    for (int off = 8; off < 64; off <<= 1) {
#pragma unroll
        for (int e = 0; e < 8; ++e) { const float tv = __shfl_up(la[e], off); if (lane >= off) la[e] += tv; } }
    if (lane >= 56) { *(LAS f32x4*)(WT + wave * 64 + a8) = (f32x4){la[0], la[1], la[2], la[3]}; *(LAS f32x4*)(WT + wave * 64 + a8 + 4) = (f32x4){la[4], la[5], la[6], la[7]}; }
    LDS_BARRIER();
    float off8[8];
#pragma unroll
    for (int e = 0; e < 8; ++e) { off8[e] = 0.f; tot[e] = 0.f; }
#pragma unroll
    for (int w = 0; w < 8; ++w) { const f32x4 t0 = *(const LAS f32x4*)(WT + w * 64 + a8), t1 = *(const LAS f32x4*)(WT + w * 64 + a8 + 4);
#pragma unroll
        for (int e = 0; e < 4; ++e) { tot[e] += t0[e]; tot[4 + e] += t1[e]; if (w < wave) { off8[e] += t0[e]; off8[4 + e] += t1[e]; } } }
#pragma unroll
    for (int e = 0; e < 8; ++e) bc[e] = la[e] + off8[e];
}
__device__ __forceinline__ void gla_vt_write(LAS unsigned* VT, u32x4 v0, u32x4 v1, int lane, int wave) {
    const int cl = lane >> 3, a = lane & 7, odd = cl & 1, dcol = 4 * wave + (cl >> 1);
#pragma unroll
    for (int i = 0; i < 4; ++i) {
        const unsigned snd = odd ? v0[i] : v1[i], own = odd ? v1[i] : v0[i], rcv = (unsigned)__shfl_xor((int)snd, 8);
        const unsigned first = odd ? rcv : own, second = odd ? own : rcv;
        const int v = 16 * a + 8 * odd + 2 * i;
        VT[v * GP32 + (dcol ^ (4 * a))] = lo_pair(first, second);
        VT[(v + 1) * GP32 + (dcol ^ (4 * a))] = hi_pair(first, second); }
}

__device__ __forceinline__ void p3_gla_state(const Args& a, LAS unsigned char* lds, int G) {
    const int tid = threadIdx.x, lane = tid & 63, wave = __builtin_amdgcn_readfirstlane(tid >> 6);
    const bf16_t* PROJ = (const bf16_t*)(a.ws + WS_PROJ); float* ST = (float*)(a.ws + WS_ST); float* DEC = (float*)(a.ws + WS_DEC); const float* glow = (const float*)(a.ws + WS_GLOW); float* BCUM = (float*)(a.ws + WS_BCUM);
    LAS float* wg2 = (LAS float*)(lds + GL_WG2); LAS float* WT = (LAS float*)(lds + GL_WT);
    LAS unsigned* KDT = (LAS unsigned*)(lds + GL_A); LAS unsigned* VT = (LAS unsigned*)(lds + GL_VT);
    const int c = tid >> 3, a8 = (tid & 7) * 8, v16 = (tid & 7) * 16, cl = lane >> 3, odd = cl & 1;
    int cur_h = -1; float bgk[8];
    f32x2 ng2; u32x4 nkr, nv0, nv1;
#define ST_LOAD(idx_) do { const int bh_ = (idx_) & 15, n_ = (idx_) >> 4, tok0_ = (bh_ >> 2) * SEQ + n_ * 64, h_ = bh_ & 3; \
        ng2 = *(const f32x2*)(glow + (size_t)tok0_ * 16 + 2 * tid); nkr = *(const u32x4*)(PROJ + (size_t)(tok0_ + c) * NPROJ + C_K + h_ * 64 + a8); \
        const bf16_t* vs_ = PROJ + (size_t)(tok0_ + c) * NPROJ + C_V + h_ * 128 + v16; nv0 = *(const u32x4*)vs_; nv1 = *(const u32x4*)(vs_ + 8); } while (0)
    if ((int)blockIdx.x < 2048) ST_LOAD((int)blockIdx.x);
    for (int idx = blockIdx.x; idx < 2048; idx += G) {
        const int bh = idx & 15, n = idx >> 4, h = bh & 3, su = bh * 128 + n;
        if (h != cur_h) {
            LDS_BARRIER();
            for (int i = tid; i < 1024; i += 512) wg2[i] = a.in[I_WGK2][(i >> 6) * 256 + h * 64 + (i & 63)];
#pragma unroll
            for (int e = 0; e < 8; ++e) bgk[e] = a.in[I_BGK][h * 64 + a8 + e];
            cur_h = h; LDS_BARRIER(); }
        const f32x2 g2 = ng2; const u32x4 kr = nkr, v0 = nv0, v1 = nv1;
        { const int idn = (idx + G < 2048) ? idx + G : idx; ST_LOAD(idn); }
        float bc[8], tot[8];
        gla_decay(wg2, WT, bgk, g2, lane, wave, bc, tot);
        { float* bp = BCUM + (size_t)((bh >> 2) * SEQ + n * 64 + c) * 256 + h * 64 + a8; *(f32x4*)bp = (f32x4){bc[0], bc[1], bc[2], bc[3]}; *(f32x4*)(bp + 4) = (f32x4){bc[4], bc[5], bc[6], bc[7]}; }
        {
            unsigned pw[4];
#pragma unroll
            for (int i = 0; i < 4; ++i) pw[i] = pk2(bflo(kr[i]) * __expf(tot[2 * i] - bc[2 * i]), bfhi(kr[i]) * __expf(tot[2 * i + 1] - bc[2 * i + 1]));
            const int dcol = 4 * wave + (cl >> 1);
#pragma unroll
            for (int i = 0; i < 2; ++i) {
                const unsigned snd = odd ? pw[i] : pw[2 + i], own = odd ? pw[2 + i] : pw[i], rcv = (unsigned)__shfl_xor((int)snd, 8);
                const unsigned first = odd ? rcv : own, second = odd ? own : rcv;
                const int d = a8 + 4 * odd + 2 * i;
                KDT[d * GP32 + (dcol ^ (4 * (d >> 4)))] = lo_pair(first, second);
                KDT[(d + 1) * GP32 + (dcol ^ (4 * (d >> 4)))] = hi_pair(first, second); }
            gla_vt_write(VT, v0, v1, lane, wave);
            if (tid < 8) { float* dp = DEC + (size_t)su * 64 + a8; *(f32x4*)dp = (f32x4){__expf(tot[0]), __expf(tot[1]), __expf(tot[2]), __expf(tot[3])}; *(f32x4*)(dp + 4) = (f32x4){__expf(tot[4]), __expf(tot[5]), __expf(tot[6]), __expf(tot[7])}; }
        }
        LDS_BARRIER();
        {
            f32x4 acc[4];
#pragma unroll
            for (int dt = 0; dt < 4; ++dt) acc[dt] = (f32x4){0.f, 0.f, 0.f, 0.f};
#pragma unroll
            for (int ks = 0; ks < 2; ++ks) { const int dc = 16 * ks + 4 * (lane >> 4);
                const bf16x8 bv = *(const LAS bf16x8*)(VT + (16 * wave + (lane & 15)) * GP32 + (dc ^ (4 * wave)));
#pragma unroll
                for (int dt = 0; dt < 4; ++dt) { const bf16x8 av = *(const LAS bf16x8*)(KDT + (16 * dt + (lane & 15)) * GP32 + (dc ^ (4 * dt))); acc[dt] = mfma16(av, bv, acc[dt]); } }
            float* dst = ST + ((size_t)su * 128 + 16 * wave + (lane & 15)) * 64 + 4 * (lane >> 4);
#pragma unroll
            for (int dt = 0; dt < 4; ++dt) *(f32x4*)(dst + 16 * dt) = acc[dt];
        }
    }
#undef ST_LOAD
}

__device__ __forceinline__ void p4_scan(const Args& a, int G) {
    const float* ST = (const float*)(a.ws + WS_ST); const float* DEC = (const float*)(a.ws + WS_DEC); bf16_t* PREV = (bf16_t*)(a.ws + WS_PREV);
    for (int gid = blockIdx.x * 512 + threadIdx.x; gid < 131072; gid += G * 512) {
        const int bh = gid >> 13, rem = gid & 8191;
        float s0 = 0.f;
        for (int n0 = 0; n0 < 128; n0 += 16) {
            float st[16], dc[16];
#pragma unroll
            for (int j = 0; j < 16; ++j) { const size_t su = (size_t)bh * 128 + n0 + j; st[j] = ST[su * 8192 + rem]; dc[j] = DEC[su * 64 + (rem & 63)]; }
#pragma unroll
            for (int j = 0; j < 16; ++j) { const size_t su = (size_t)bh * 128 + n0 + j; PREV[su * 8192 + rem] = (bf16_t)f2bf(s0); s0 = dc[j] * s0 + st[j]; }
        }
    }
}

__device__ __forceinline__ void p5_gla_out(const Args& a, LAS unsigned char* lds, int G) {
    const int tid = threadIdx.x, lane = tid & 63, wave = __builtin_amdgcn_readfirstlane(tid >> 6);
    const bf16_t* PROJ = (const bf16_t*)(a.ws + WS_PROJ); const bf16_t* PREV = (const bf16_t*)(a.ws + WS_PREV); bf16_t* MIXA = (bf16_t*)(a.ws + WS_XN); const float* glow = (const float*)(a.ws + WS_GLOW);
    const float* BCUM = (const float*)(a.ws + WS_BCUM);
    LAS bf16_t* QS = (LAS bf16_t*)(lds + GL_A); LAS bf16_t* KS = (LAS bf16_t*)(lds + GL_B); LAS unsigned* VT = (LAS unsigned*)(lds + GL_VT); LAS bf16_t* PM = (LAS bf16_t*)(lds + GL_PM);
    LAS float* RS = (LAS float*)(lds + GL_RS);
    const int c = tid >> 3, a8 = (tid & 7) * 8, v16 = (tid & 7) * 16;
    const int it = wave >> 1, vh = wave & 1;
    f32x4 nb0, nb1; u32x4 nqr, nkr, nv0, nv1;
#define GO_LOAD(idx_) do { const int bh_ = (idx_) & 15, n_ = (idx_) >> 4, tok0_ = (bh_ >> 2) * SEQ + n_ * 64, h_ = bh_ & 3; \
        { const float* bp_ = BCUM + (size_t)(tok0_ + c) * 256 + h_ * 64 + a8; nb0 = *(const f32x4*)bp_; nb1 = *(const f32x4*)(bp_ + 4); } \
        nqr = *(const u32x4*)(PROJ + (size_t)(tok0_ + c) * NPROJ + C_Q + h_ * 64 + a8); nkr = *(const u32x4*)(PROJ + (size_t)(tok0_ + c) * NPROJ + C_K + h_ * 64 + a8); \
        const bf16_t* vs_ = PROJ + (size_t)(tok0_ + c) * NPROJ + C_V + h_ * 128 + v16; nv0 = *(const u32x4*)vs_; nv1 = *(const u32x4*)(vs_ + 8); } while (0)
#define GO_LOAD2(idx_) do { const int bh_ = (idx_) & 15, n_ = (idx_) >> 4, tok0_ = (bh_ >> 2) * SEQ + n_ * 64, h_ = bh_ & 3, su_ = bh_ * 128 + n_; \
        _Pragma("unroll") for (int vt = 0; vt < 4; ++vt) { const int vrow_ = 16 * (4 * vh + vt) + (lane & 15); \
            _Pragma("unroll") for (int ks = 0; ks < 2; ++ks) pv[vt][ks] = *(const bf16x8*)(PREV + ((size_t)su_ * 128 + vrow_) * 64 + 32 * ks + 8 * (lane >> 4)); \
            rr[vt] = *(const u32x2*)(PROJ + (size_t)(tok0_ + 16 * it + (lane & 15)) * NPROJ + C_R + h_ * 128 + 16 * (4 * vh + vt) + 4 * (lane >> 4)); } } while (0)
    if ((int)blockIdx.x < 2048) GO_LOAD((int)blockIdx.x);
    for (int idx = blockIdx.x; idx < 2048; idx += G) {
        const int bh = idx & 15, n = idx >> 4, b = bh >> 2, h = bh & 3, tok0 = b * SEQ + n * 64;
        const f32x4 b0 = nb0, b1 = nb1; const u32x4 qr = nqr, kr = nkr, v0 = nv0, v1 = nv1; bf16x8 pv[4][2]; u32x2 rr[4];
        { const int idn = (idx + G < 2048) ? idx + G : idx; GO_LOAD(idn); }
        GO_LOAD2(idx);
        const float bc[8] = {b0[0], b0[1], b0[2], b0[3], b1[0], b1[1], b1[2], b1[3]};
        {
            u32x4 qo, ko;
#pragma unroll
            for (int i = 0; i < 4; ++i) { const float e0 = __expf(bc[2 * i]), e1 = __expf(bc[2 * i + 1]);
                qo[i] = pk2(bflo(qr[i]) * e0, bfhi(qr[i]) * e1); ko[i] = pk2(bflo(kr[i]) * __builtin_amdgcn_rcpf(e0), bfhi(kr[i]) * __builtin_amdgcn_rcpf(e1)); }
            *(LAS u32x4*)(QS + c * GP + a8) = qo; *(LAS u32x4*)(KS + c * GP + a8) = ko;
            gla_vt_write(VT, v0, v1, lane, wave);
        }
        LDS_BARRIER();
        {
#pragma unroll
            for (int q = 0; q < 2; ++q) { const int jt = 2 * (wave & 1) + q; f32x4 s = (f32x4){0.f, 0.f, 0.f, 0.f};
                if (jt <= it) {
#pragma unroll
                    for (int ks = 0; ks < 2; ++ks) { const bf16x8 av = *(const LAS bf16x8*)(KS + (16 * jt + (lane & 15)) * GP + 32 * ks + 8 * (lane >> 4));
                        const bf16x8 bv = *(const LAS bf16x8*)(QS + (16 * it + (lane & 15)) * GP + 32 * ks + 8 * (lane >> 4)); s = mfma16(av, bv, s); } }
                const int i = 16 * it + (lane & 15), j0 = 16 * jt + 4 * (lane >> 4);
                const float p0 = (j0 <= i) ? s[0] : 0.f, p1 = (j0 + 1 <= i) ? s[1] : 0.f, p2 = (j0 + 2 <= i) ? s[2] : 0.f, p3 = (j0 + 3 <= i) ? s[3] : 0.f;
                *(LAS u32x2*)(PM + i * GP + j0) = (u32x2){pk2(p0, p1), pk2(p2, p3)}; }
        }
        LDS_BARRIER();
        f32x4 acc[4];
#pragma unroll
        for (int vt = 0; vt < 4; ++vt) { acc[vt] = (f32x4){0.f, 0.f, 0.f, 0.f}; const int vrow = 16 * (4 * vh + vt) + (lane & 15), vsw = 4 * (4 * vh + vt);
#pragma unroll
            for (int ks = 0; ks < 2; ++ks) { const bf16x8 av = *(const LAS bf16x8*)(VT + vrow * GP32 + ((16 * ks + 4 * (lane >> 4)) ^ vsw));
                const bf16x8 bv = *(const LAS bf16x8*)(PM + (16 * it + (lane & 15)) * GP + 32 * ks + 8 * (lane >> 4)); acc[vt] = mfma16(av, bv, acc[vt]); }
#pragma unroll
            for (int ks = 0; ks < 2; ++ks) { const bf16x8 bv = *(const LAS bf16x8*)(QS + (16 * it + (lane & 15)) * GP + 32 * ks + 8 * (lane >> 4)); acc[vt] = mfma16(pv[vt][ks], bv, acc[vt]); } }
        float ss = 0.f;
#pragma unroll
        for (int vt = 0; vt < 4; ++vt) ss += (acc[vt][0] * acc[vt][0] + acc[vt][1] * acc[vt][1]) + (acc[vt][2] * acc[vt][2] + acc[vt][3] * acc[vt][3]);
        ss += __shfl_xor(ss, 16); ss += __shfl_xor(ss, 32);
        if (lane < 16) RS[wave * 16 + lane] = ss;
        LDS_BARRIER();
        const float tsum = RS[wave * 16 + (lane & 15)] + RS[(wave ^ 1) * 16 + (lane & 15)];
        const float rstd = __builtin_amdgcn_rsqf(tsum * (1.0f / 128.0f) + EPS);
        const size_t trow = (size_t)(tok0 + 16 * it + (lane & 15));
#pragma unroll
        for (int vt = 0; vt < 4; ++vt) { const int v = 16 * (4 * vh + vt) + 4 * (lane >> 4);
            const f32x4 gg = *(const f32x4*)(a.in[I_GGLA] + v);
            const float o0 = acc[vt][0] * rstd * gg[0] * bflo(rr[vt][0]), o1 = acc[vt][1] * rstd * gg[1] * bfhi(rr[vt][0]), o2 = acc[vt][2] * rstd * gg[2] * bflo(rr[vt][1]), o3 = acc[vt][3] * rstd * gg[3] * bfhi(rr[vt][1]);
            *(u32x2*)(MIXA + trow * 1024 + 512 + h * 128 + v) = (u32x2){pk2(o0, o1), pk2(o2, o3)}; }
    }
#undef GO_LOAD
#undef GO_LOAD2
}

constexpr int NP = 1032;
constexpr int P7_NH = 0, P7_NL = 16 * NP * 2, P7_RP = 2 * 16 * NP * 2, P7_ENT = P7_RP + 16384, P7_CNT = P7_ENT + 3 * 2048, P7_BASE = P7_CNT + 128, P7_LG = P7_BASE + 128  ;
__device__ __forceinline__ void p7_router(const Args& a, LAS unsigned char* lds, int G) {
    const int tid = threadIdx.x, lane = tid & 63, wave = __builtin_amdgcn_readfirstlane(tid >> 6);
    const float* x = a.in[I_X]; const float* mods = (const float*)(a.ws + WS_MODS);
    const bf16_t* MIX = (const bf16_t*)(a.ws + WS_MIX); unsigned char* XN2 = a.ws + WS_XN; bf16_t* H1 = (bf16_t*)(a.ws + WS_H1);
    const bf16_t* WH = (const bf16_t*)(a.ws + WS_WR); const bf16_t* WL = WH + 32 * 1024;
    LAS bf16_t* NH = (LAS bf16_t*)(lds + P7_NH); LAS bf16_t* NL = (LAS bf16_t*)(lds + P7_NL); LAS float* RP = (LAS float*)(lds + P7_RP);
    LAS int* ENT_E = (LAS int*)(lds + P7_ENT); LAS int* ENT_POS = ENT_E + 512; LAS float* ENT_P = (LAS float*)(ENT_POS + 512);
    LAS int* CNTL = (LAS int*)(lds + P7_CNT); LAS int* BASEL = (LAS int*)(lds + P7_BASE); LAS float* LG = (LAS float*)(lds + P7_LG);
    unsigned* gcnt = (unsigned*)(a.ws + WS_CTL) + CW_CNT;
    int* tok_e = (int*)(a.ws + WS_TOKE); int* tok_pos = (int*)(a.ws + WS_TOKPOS); float* tok_p = (float*)(a.ws + WS_TOKP); int* slot_tok = (int*)(a.ws + WS_SLOT);
    bf16x8 whi[4][2], wlo[4][2];
#pragma unroll
    for (int ks = 0; ks < 4; ++ks)
#pragma unroll
        for (int nt = 0; nt < 2; ++nt) { const size_t o = (size_t)(16 * nt + (lane & 15)) * 1024 + 128 * wave + 32 * ks + 8 * (lane >> 4);
            whi[ks][nt] = *(const bf16x8*)(WH + o); wlo[ks][nt] = *(const bf16x8*)(WL + o); }
    for (int blk = blockIdx.x; blk < T / 128; blk += G) {
        const int b = (blk * 128) / SEQ;
        if (tid < 32) CNTL[tid] = 0;
        f32x4 G1[4], A2[4], B2[4];
#pragma unroll
        for (int j = 0; j < 4; ++j) { const int k = 4 * lane + 256 * j;
            G1[j] = *(const f32x4*)(mods + b * 6144 + 2048 + k) * *(const f32x4*)(a.in[I_GPOST] + k);
            A2[j] = *(const f32x4*)(a.in[I_GPFFN] + k) * (*(const f32x4*)(mods + b * 6144 + 4096 + k) + 1.0f);
            B2[j] = *(const f32x4*)(mods + b * 6144 + 3072 + k); }
        LDS_BARRIER();
        u32x2 pm_[4]; f32x4 px_[4];
        { const size_t row = (size_t)(blk * 128 + 2 * wave);
#pragma unroll
          for (int j = 0; j < 4; ++j) { pm_[j] = *(const u32x2*)(MIX + row * 1024 + 4 * lane + 256 * j); px_[j] = __builtin_nontemporal_load((const f32x4*)(x + row * 1024 + 4 * lane + 256 * j)); } }
        for (int it = 0; it < 8; ++it) {
            const int r0 = blk * 128 + 16 * it;
#pragma unroll 1
            for (int rr = 0; rr < 2; ++rr) {
                const int r16 = 2 * wave + rr; const size_t row = (size_t)(r0 + r16);
                const int sn = 2 * it + rr + 1, snc = sn < 16 ? sn : 15; const size_t rown = (size_t)(blk * 128 + 16 * (snc >> 1) + 2 * wave + (snc & 1));
                f32x4 mv[4], hv[4]; float ss = 0.f;
#pragma unroll
                for (int j = 0; j < 4; ++j) { const u32x2 mm = pm_[j]; mv[j] = (f32x4){bflo(mm[0]), bfhi(mm[0]), bflo(mm[1]), bfhi(mm[1])};
                    hv[j] = px_[j]; ss += (mv[j][0] * mv[j][0] + mv[j][1] * mv[j][1]) + (mv[j][2] * mv[j][2] + mv[j][3] * mv[j][3]); }
#pragma unroll
                for (int j = 0; j < 4; ++j) { pm_[j] = *(const u32x2*)(MIX + rown * 1024 + 4 * lane + 256 * j); px_[j] = __builtin_nontemporal_load((const f32x4*)(x + rown * 1024 + 4 * lane + 256 * j)); }
                const float rstd1 = __builtin_amdgcn_rsqf(wave_sum(ss) * (1.0f / 1024.0f) + EPS);
                float ss2 = 0.f;
#pragma unroll
                for (int j = 0; j < 4; ++j) { hv[j] = hv[j] + G1[j] * mv[j] * rstd1; __builtin_nontemporal_store((u32x2){pk2(hv[j][0], hv[j][1]), pk2(hv[j][2], hv[j][3])}, (u32x2*)(H1 + row * 1024 + 4 * lane + 256 * j));
                    ss2 += (hv[j][0] * hv[j][0] + hv[j][1] * hv[j][1]) + (hv[j][2] * hv[j][2] + hv[j][3] * hv[j][3]); }
                const float rstd2 = __builtin_amdgcn_rsqf(wave_sum(ss2) * (1.0f / 1024.0f) + EPS);
#pragma unroll
                for (int j = 0; j < 4; ++j) { const f32x4 nv = hv[j] * rstd2 * A2[j] + B2[j];
                    const u32x2 hw = (u32x2){pk2(nv[0], nv[1]), pk2(nv[2], nv[3])};
                    const u32x2 lw = (u32x2){pk2(nv[0] - bflo(hw[0]), nv[1] - bfhi(hw[0])), pk2(nv[2] - bflo(hw[1]), nv[3] - bfhi(hw[1]))};
                    *(unsigned*)(XN2 + row * 1024 + 4 * lane + 256 * j) = pk4_fp8(nv[0], nv[1], nv[2], nv[3]);
                    *(LAS u32x2*)(NH + r16 * NP + 4 * lane + 256 * j) = hw; *(LAS u32x2*)(NL + r16 * NP + 4 * lane + 256 * j) = lw; }
            }
            LDS_BARRIER();
            {
                f32x4 acc[2] = {(f32x4){0.f, 0.f, 0.f, 0.f}, (f32x4){0.f, 0.f, 0.f, 0.f}};
#pragma unroll
                for (int ks = 0; ks < 4; ++ks) { const int o = (lane & 15) * NP + 128 * wave + 32 * ks + 8 * (lane >> 4);
                    const bf16x8 ah = *(const LAS bf16x8*)(NH + o), al = *(const LAS bf16x8*)(NL + o);
#pragma unroll
                    for (int nt = 0; nt < 2; ++nt) { acc[nt] = mfma16(ah, whi[ks][nt], acc[nt]); acc[nt] = mfma16(al, whi[ks][nt], acc[nt]); acc[nt] = mfma16(ah, wlo[ks][nt], acc[nt]); } }
#pragma unroll
                for (int nt = 0; nt < 2; ++nt)
#pragma unroll
                    for (int r = 0; r < 4; ++r) RP[wave * 512 + (4 * (lane >> 4) + r) * 32 + 16 * nt + (lane & 15)] = acc[nt][r];
            }
            LDS_BARRIER();
            {
                const int r16 = tid >> 5, e = tid & 31;
                float lg = a.in[I_BR][e];
#pragma unroll
                for (int w = 0; w < 8; ++w) lg += RP[w * 512 + r16 * 32 + e];
                LG[(16 * it + r16) * 33 + e] = lg;
            }
        }
        LDS_BARRIER();
        if (tid < 128) {
            float lg[32];
#pragma unroll
            for (int e = 0; e < 32; ++e) lg[e] = LG[tid * 33 + e];
            float tv[4]; int ti[4];
#pragma unroll
            for (int k = 0; k < 4; ++k) { float bv = -INFINITY; int bi = 0;
#pragma unroll
                for (int e = 0; e < 32; ++e) { bool ok = lg[e] > bv;
#pragma unroll
                    for (int q = 0; q < k; ++q) ok = ok && (e != ti[q]);
                    bv = ok ? lg[e] : bv; bi = ok ? e : bi; }
                tv[k] = bv; ti[k] = bi; }
            const float e1 = __expf(tv[1] - tv[0]), e2 = __expf(tv[2] - tv[0]), e3 = __expf(tv[3] - tv[0]);
            const float inv = 1.0f / (1.0f + e1 + e2 + e3);
            const float pr[4] = {inv, e1 * inv, e2 * inv, e3 * inv};
#pragma unroll
            for (int k = 0; k < 4; ++k) { const int pos = __hip_atomic_fetch_add(CNTL + ti[k], 1, __ATOMIC_RELAXED, __HIP_MEMORY_SCOPE_WORKGROUP); ENT_E[tid * 4 + k] = ti[k]; ENT_POS[tid * 4 + k] = pos; ENT_P[tid * 4 + k] = pr[k]; }
        }
        LDS_BARRIER();
        if (tid < 32) BASEL[tid] = (int)atomicAdd(gcnt + tid, (unsigned)CNTL[tid]);
        LDS_BARRIER();
        { const int e = ENT_E[tid], pos = BASEL[e] + ENT_POS[tid], token = blk * 128 + (tid >> 2);
            tok_e[(size_t)token * 4 + (tid & 3)] = e; tok_pos[(size_t)token * 4 + (tid & 3)] = pos; tok_p[(size_t)token * 4 + (tid & 3)] = ENT_P[tid];
            slot_tok[(size_t)e * T + pos] = token; }
        LDS_BARRIER();
    }
}

__device__ __forceinline__ int moe_tables(const Args& a, LAS unsigned char* lds) {
    LAS int* tp = (LAS int*)(lds + TP_OFF); LAS int* cn = tp + 40; LAS unsigned char* te = (LAS unsigned char*)(lds + TE_OFF);
    const unsigned* gcnt = (const unsigned*)(a.ws + WS_CTL) + CW_CNT;
    if (threadIdx.x == 0) { int s = 0; for (int e = 0; e < NE; ++e) { const int c = (int)gcnt[e]; tp[e] = s; cn[e] = c; s += (c + 255) >> 8; } tp[NE] = s; }
    __syncthreads();
    const int nM = tp[NE];
    for (int e = threadIdx.x >> 4; e < NE; e += 32) for (int p = tp[e] + (threadIdx.x & 15); p < tp[e + 1]; p += 16) te[p] = (unsigned char)e;
    __syncthreads();
    return nM;
}

__device__ __forceinline__ void p10_final(const Args& a, LAS unsigned char* lds, int G) {
    const int tid = threadIdx.x, lane = tid & 63, wave = __builtin_amdgcn_readfirstlane(tid >> 6);
    (void)moe_tables(a, lds);
    const LAS int* tp = (const LAS int*)(lds + TP_OFF);
    const float* mods = (const float*)(a.ws + WS_MODS); const unsigned char* OUT8 = a.ws + WS_OUT8; float* out = a.out; const bf16_t* H1 = (const bf16_t*)(a.ws + WS_H1);
    const int* tok_e = (const int*)(a.ws + WS_TOKE); const int* tok_pos = (const int*)(a.ws + WS_TOKPOS); const float* tok_p = (const float*)(a.ws + WS_TOKP);
    for (int rg = blockIdx.x * 8 + wave; rg < T / 16; rg += G * 8) {
        const int b = (rg * 16) / SEQ;
        f32x4 G2[4];
#pragma unroll
        for (int j = 0; j < 4; ++j) { const int k = 4 * lane + 256 * j; G2[j] = *(const f32x4*)(mods + b * 6144 + 5120 + k) * *(const f32x4*)(a.in[I_GPOSTF] + k); }
        const size_t mb = (size_t)rg * 64 + lane;
        const int me = tok_e[mb], mslot = tp[me] * 256 + tok_pos[mb]; const float mpr = tok_p[mb] * (1.0f / OSCALE);
        constexpr int P10D = 2;
        int nw[P10D][4][4]; u32x2 nh[P10D][4];
#define P10_LOADROW(d_, i_) do { const size_t m_ = (size_t)rg * 16 + (i_); \
            _Pragma("unroll") for (int k = 0; k < 4; ++k) { const size_t slot = (size_t)__builtin_amdgcn_readlane(mslot, 4 * (i_) + k); \
                _Pragma("unroll") for (int j = 0; j < 4; ++j) nw[d_][k][j] = *(const int*)(OUT8 + slot * 1024 + 4 * lane + 256 * j); } \
            _Pragma("unroll") for (int j = 0; j < 4; ++j) nh[d_][j] = __builtin_nontemporal_load((const u32x2*)(H1 + m_ * 1024 + 4 * lane + 256 * j)); } while (0)
#pragma unroll
        for (int d = 0; d < P10D; ++d) P10_LOADROW(d, d);
        for (int i0 = 0; i0 < 16; i0 += P10D) {
#pragma unroll
          for (int d = 0; d < P10D; ++d) {
            const int i = i0 + d; const size_t m = (size_t)rg * 16 + i;
            int cw[4][4]; u32x2 ch[4];
#pragma unroll
            for (int k = 0; k < 4; ++k)
#pragma unroll
                for (int j = 0; j < 4; ++j) cw[k][j] = nw[d][k][j];
#pragma unroll
            for (int j = 0; j < 4; ++j) ch[j] = nh[d][j];
            const int in_ = i + P10D < 16 ? i + P10D : 15;
            P10_LOADROW(d, in_);
            f32x4 f[4];
#pragma unroll
            for (int j = 0; j < 4; ++j) f[j] = (f32x4){0.f, 0.f, 0.f, 0.f};
#pragma unroll
            for (int k = 0; k < 4; ++k) {
                const float pk = __builtin_bit_cast(float, __builtin_amdgcn_readlane(__builtin_bit_cast(int, mpr), 4 * i + k));
#pragma unroll
                for (int j = 0; j < 4; ++j) { const int w = cw[k][j];
                    const f32x2 lo = __builtin_amdgcn_cvt_pk_f32_fp8(w, false), hi = __builtin_amdgcn_cvt_pk_f32_fp8(w, true);
                    f[j] += (f32x4){lo[0], lo[1], hi[0], hi[1]} * pk; }
            }
            float ss = 0.f;
#pragma unroll
            for (int j = 0; j < 4; ++j) ss += (f[j][0] * f[j][0] + f[j][1] * f[j][1]) + (f[j][2] * f[j][2] + f[j][3] * f[j][3]);
            const float rstd = __builtin_amdgcn_rsqf(wave_sum(ss) * (1.0f / 1024.0f) + EPS);
#pragma unroll
            for (int j = 0; j < 4; ++j) __builtin_nontemporal_store((f32x4){bflo(ch[j][0]), bfhi(ch[j][0]), bflo(ch[j][1]), bfhi(ch[j][1])} + G2[j] * f[j] * rstd, (f32x4*)(out + m * 1024 + 4 * lane + 256 * j));
          }
        }
#undef P10_LOADROW
    }
}

constexpr int N_PHASES = 11;
__global__ void __launch_bounds__(512, 2) mk_fwd(Args args) {
    extern __shared__ __attribute__((aligned(16))) unsigned char lds_raw[];
    LAS unsigned char* lds = (LAS unsigned char*)lds_raw;
    volatile LAS unsigned* MISC = (volatile LAS unsigned*)(lds + MISC_OFF);
    const int tid = threadIdx.x, G = gridDim.x;
    if (tid < 64) MISC[tid] = 0u;
    __syncthreads();
    unsigned* ctl = (unsigned*)(args.ws + WS_CTL);
    const int lo = args.ph_lo, hi = args.ph_hi;
    XcdBarrier bar; bar.bar = ctl + CW_BAR; bar.x = 0; bar.st = MISC + 8;
    if (hi - lo > 1) bar = xcd_barrier_post(ctl + CW_BAR, MISC + 8);
#define IN(k) (lo <= (k) && (k) < hi)
#define SEAM(k) do { if (IN((k) + 1)) xcd_barrier(bar); } while (0)
    const LAS unsigned short* TOK = (const LAS unsigned short*)(lds + TOK_OFF);
    if (IN(0)) { p0_prologue(args, lds, G); SEAM(0); }
    if (IN(1)) { p1_norm(args, lds, G); SEAM(1); }
    if (IN(2)) {
        pg8::Gemm g{args.ws + WS_XN, args.ws + WS_WIN, 2048}; pg8::StaticOrder S; S.init(T, NPROJ, G, (int)blockIdx.x);
        pg8::EpiProj E{(bf16_t*)(args.ws + WS_PROJ)};
        const int grp = (((int)blockIdx.x >> 3) * 6) >> 5, nun = (S.nwg + G - 1) / G, cut = grp < nun ? grp : nun;
        if (cut > 0) { S.base = 0; S.lim = cut; pg8::gemm_phase<pg8::EpiProj, pg8::StaticOrder, true, false, false>(lds, g, S, E, TOK); }
        __syncthreads(); moe_convert(args, lds, G, 0, MOE_ITEMS); __syncthreads();
        if (cut < nun) { S.base = cut; S.lim = nun - cut; pg8::gemm_phase<pg8::EpiProj, pg8::StaticOrder, true, false, false>(lds, g, S, E, TOK); }
        SEAM(2);
    }
    if (IN(3)) { p3_sgu(args, lds, G); __syncthreads(); p3_gla_state(args, lds, G); SEAM(3); }
    if (IN(4)) { p4_scan(args, G); SEAM(4); }
    if (IN(5)) { p5_gla_out(args, lds, G); SEAM(5); }
    if (IN(6)) {
        pg8::Gemm g{args.ws + WS_XN, args.ws + WS_WOUT, 2048}; pg8::StaticOrder S; S.init(T, 1024, G, (int)blockIdx.x);
        pg8::EpiPlain E{(bf16_t*)(args.ws + WS_MIX), 1024};
        pg8::gemm_phase<pg8::EpiPlain, pg8::StaticOrder, true, false, false>(lds, g, S, E, TOK);
        SEAM(6);
    }
    if (IN(7)) { p7_router(args, lds, G); SEAM(7); }
    if (IN(8)) {
        const int nM = moe_tables(args, lds);
        pg8::MoeOrder S; S.nM = nM; S.nN = 8; S.nwg = nM * 8; S.G = G; S.c = (int)blockIdx.x;
        S.tp = (const LAS int*)(lds + TP_OFF); S.cnt = S.tp + 40; S.te = (const LAS unsigned char*)(lds + TE_OFF);
        {
            LAS unsigned short* tokw = (LAS unsigned short*)(lds + TOK_OFF); const int* slot_tok = (const int*)(args.ws + WS_SLOT);
            pg8::Unit u;
            for (int i = 0; i < 18 && S.next(i, u); ++i) if (tid < 256) { const int p = u.prow + tid; tokw[i * 256 + tid] = (unsigned short)(p < u.cnt ? slot_tok[(size_t)u.e * T + p] : 0); }
            __syncthreads();
        }
        pg8::Gemm g{args.ws + WS_XN, args.ws + WS_W1, 1024};
        pg8::EpiSwiglu E{args.ws + WS_HDN, args.in[I_BG], args.in[I_BU]};
        pg8::gemm_phase<pg8::EpiSwiglu, pg8::MoeOrder, true, true, true>(lds, g, S, E, TOK);
        SEAM(8);
    }
    if (IN(9)) {
        const int nM = moe_tables(args, lds);
        pg8::MoeOrder S; S.nM = nM; S.nN = 4; S.nwg = nM * 4; S.G = G; S.c = (int)blockIdx.x;
        S.tp = (const LAS int*)(lds + TP_OFF); S.cnt = S.tp + 40; S.te = (const LAS unsigned char*)(lds + TE_OFF);
        pg8::Gemm g{args.ws + WS_HDN, args.ws + WS_WD, 1024};
        pg8::EpiOut8 E{args.ws + WS_OUT8, args.in[I_BDN]};
        pg8::gemm_phase<pg8::EpiOut8, pg8::MoeOrder, true, false, true>(lds, g, S, E, TOK);
        SEAM(9);
    }
    if (IN(10)) { p10_final(args, lds, G); }
#undef IN
#undef SEAM
}

#ifndef MK_SPLIT
#define MK_SPLIT 0
#endif
extern "C" void kernel_launch(void* const* d_in, const int* in_sizes, int n_in, void* d_out, int out_size, void* d_ws, size_t ws_size, hipStream_t stream) {
    static int grid = 0;
    if (grid == 0) {
        if (n_in != 24 || out_size != T * D || ws_size < WS_END) { fprintf(stderr, "kernel_launch: unexpected problem (n_in %d, out %d, ws %zu)\n", n_in, out_size, ws_size); grid = -1; return; }
        int dev = 0, cus = 0, per_cu = 0;
        if (hipGetDevice(&dev) != hipSuccess || hipDeviceGetAttribute(&cus, hipDeviceAttributeMultiprocessorCount, dev) != hipSuccess) { grid = -1; return; }
        if (hipFuncSetAttribute((const void*)mk_fwd, hipFuncAttributeMaxDynamicSharedMemorySize, LDS_BYTES) != hipSuccess) { grid = -1; return; }
        if (hipOccupancyMaxActiveBlocksPerMultiprocessor(&per_cu, (const void*)mk_fwd, 512, LDS_BYTES) != hipSuccess || per_cu < 1) { fprintf(stderr, "kernel_launch: occupancy query says %d\n", per_cu); (void)hipGetLastError(); grid = -1; return; }
        grid = cus;
    }
    if (grid < 0) return;
    (void)hipMemsetAsync((char*)d_ws + WS_CTL, 0, CTL_ZERO_BYTES, stream);
    Args a{};
    for (int i = 0; i < 24; ++i) a.in[i] = (const float*)d_in[i];
    a.out = (float*)d_out; a.ws = (unsigned char*)d_ws;
#if MK_SPLIT
    for (int p = 0; p < N_PHASES; ++p) { a.ph_lo = p; a.ph_hi = p + 1; hipLaunchKernelGGL(mk_fwd, dim3(grid), dim3(512), LDS_BYTES, stream, a); }
#else
    a.ph_lo = 0; a.ph_hi = N_PHASES;
    hipLaunchKernelGGL(mk_fwd, dim3(grid), dim3(512), LDS_BYTES, stream, a);
#endif
}
```

```cpp
#include <hip/hip_runtime.h>
#include <cstdio>
#include <cstdint>

#define LAS __attribute__((address_space(3)))
typedef unsigned short bf16_t;
typedef short bf16x8 __attribute__((ext_vector_type(8)));
typedef float f32x4 __attribute__((ext_vector_type(4)));
typedef float f32x2 __attribute__((ext_vector_type(2)));
typedef unsigned u32x4 __attribute__((ext_vector_type(4)));
typedef unsigned u32x2 __attribute__((ext_vector_type(2)));

constexpr int T = 32768, D = 1024, SEQ = 8192;
constexpr int D_IN = 2576, NPROJ = 2560;
constexpr int NE = 32;
constexpr float EPS = 1e-6f;
constexpr int C_US = 0, C_VS = 512, C_Q = 1024, C_K = 1280, C_V = 1536, C_R = 2048, C_GL = 2560;
constexpr float OSCALE = 8.0f;
constexpr float W8_SCALE = 32.0f;
#define W8_SCALE_E8M0 0x7A7A7A7A

constexpr size_t MiB = 1u << 20;
constexpr size_t WS_CTL = 0, CTL_ZERO_BYTES = 1 * MiB;
constexpr int CW_TMO = 0, CW_CNT = 1024, CW_BAR = 4096;
constexpr size_t WS_MODS = 256 * 1024;
constexpr size_t WS_GLOW = 2 * MiB;
constexpr size_t WS_TOKE = 4 * MiB, WS_TOKPOS = WS_TOKE + 512 * 1024, WS_TOKP = WS_TOKE + 1024 * 1024;
constexpr size_t WS_DEC = 5 * MiB + 512 * 1024;
constexpr size_t WS_SLOT = 6 * MiB;
constexpr size_t WS_WR = 10 * MiB;
constexpr size_t WS_WIN = 11 * MiB;
constexpr size_t WS_WOUT = 16 * MiB;
constexpr size_t WS_WD = 18 * MiB;
constexpr size_t WS_W1 = 50 * MiB;
constexpr size_t WS_XN = 114 * MiB;
constexpr size_t WS_PROJ = 178 * MiB;
constexpr size_t WS_ST = 338 * MiB;
constexpr size_t WS_PREV = 402 * MiB;
constexpr size_t WS_MIX = 178 * MiB;
constexpr size_t WS_HDN = 178 * MiB;
constexpr size_t WS_OUT8 = 338 * MiB;
constexpr size_t WS_BCUM = 434 * MiB;
constexpr size_t WS_H1 = 474 * MiB;
constexpr size_t WS_END = 538 * MiB;
constexpr int MAX_TILES = 543;

constexpr int RING_BYTES = 131072;
constexpr int MISC_OFF = RING_BYTES;
constexpr int TP_OFF = MISC_OFF + 256;
constexpr int TE_OFF = TP_OFF + 512;
constexpr int TOK_OFF = TE_OFF + 1024;
constexpr int BIAS_OFF = TOK_OFF + 18 * 512;
constexpr int LDS_BYTES = 147456;
static_assert(BIAS_OFF + 2048 <= LDS_BYTES && BIAS_OFF % 16 == 0, "LDS map");

__device__ __forceinline__ unsigned f2bf(float f) { unsigned u = __builtin_bit_cast(unsigned, f); return (u + 0x7fffu + ((u >> 16) & 1u)) >> 16; }
__device__ __forceinline__ float bf2f(unsigned h) { return __builtin_bit_cast(float, h << 16); }
__device__ __forceinline__ float bflo(unsigned w) { return __builtin_bit_cast(float, w << 16); }
__device__ __forceinline__ float bfhi(unsigned w) { return __builtin_bit_cast(float, w & 0xffff0000u); }
__device__ __forceinline__ unsigned pk2(float lo, float hi) { unsigned r; asm volatile("v_cvt_pk_bf16_f32 %0, %1, %2" : "=v"(r) : "v"(lo), "v"(hi)); return r; }
__device__ __forceinline__ unsigned pk4_fp8(float a, float b, float c, float d) {
    int w = __builtin_amdgcn_cvt_pk_fp8_f32(a, b, 0, false); w = __builtin_amdgcn_cvt_pk_fp8_f32(c, d, w, true); return (unsigned)w; }
__device__ __forceinline__ float clamp448(float v) { return fminf(fmaxf(v, -448.0f), 448.0f); }
#define LDS_BARRIER() do { asm volatile("s_waitcnt lgkmcnt(0)" ::: "memory"); __builtin_amdgcn_s_barrier(); asm volatile("" ::: "memory"); } while (0)
__device__ __forceinline__ float wave_sum(float v) {
#pragma unroll
    for (int o = 1; o < 64; o <<= 1) v += __shfl_xor(v, o);
    return v;
}
__device__ __forceinline__ f32x4 mfma16(bf16x8 a, bf16x8 b, f32x4 c) { return __builtin_amdgcn_mfma_f32_16x16x32_bf16(a, b, c, 0, 0, 0); }
__device__ __forceinline__ float sigmoidf_(float x) { return __builtin_amdgcn_rcpf(1.0f + __builtin_amdgcn_exp2f(-1.4426950408889634f * x)); }
__device__ __forceinline__ float gelu_tanh(float x) { const float u = x + 0.044715f * x * x * x; return x * __builtin_amdgcn_rcpf(1.0f + __builtin_amdgcn_exp2f(-2.302208198f * u)); }
__device__ __forceinline__ float silu_(float x) { return x * sigmoidf_(x); }
__device__ __forceinline__ f32x2 rcp2(f32x2 v) { return (f32x2){__builtin_amdgcn_rcpf(v[0]), __builtin_amdgcn_rcpf(v[1])}; }
__device__ __forceinline__ f32x2 exp2_2(f32x2 v) { return (f32x2){__builtin_amdgcn_exp2f(v[0]), __builtin_amdgcn_exp2f(v[1])}; }
__device__ __forceinline__ f32x2 clamp2(f32x2 v, float lo, float hi) { return (f32x2){__builtin_amdgcn_fmed3f(v[0], lo, hi), __builtin_amdgcn_fmed3f(v[1], lo, hi)}; }
__device__ __forceinline__ f32x2 gelu_tanh2(f32x2 x) { const f32x2 u = x + (x * x) * (x * 0.044715f); return x * rcp2(exp2_2(u * -2.302208198f) + 1.0f); }
__device__ __forceinline__ f32x2 silu2(f32x2 x) { return x * rcp2(exp2_2(x * -1.4426950408889634f) + 1.0f); }

#define XB_TMO      128
#define XB_XCNT(j)  (256  + 64 * (j))
#define XB_XSUB(j)  (1280 + 64 * (j))
#define XB_XGEN(j)  (2304 + 64 * (j))
#define XB_TOP      3328
#define XB_TOPGEN   3392
#define XCD_BAR_WORDS 3456
#define XB_SPIN_CAP (1u << 20)
__device__ __forceinline__ unsigned xb_ld(unsigned* p)              { return __hip_atomic_load(p, __ATOMIC_RELAXED, __HIP_MEMORY_SCOPE_AGENT); }
__device__ __forceinline__ unsigned xb_add(unsigned* p, unsigned v) { return __hip_atomic_fetch_add(p, v, __ATOMIC_RELAXED, __HIP_MEMORY_SCOPE_AGENT); }
__device__ __forceinline__ unsigned xb_xcc_id() { return (unsigned)__builtin_amdgcn_s_getreg((3 << 11) | 20) & 0xFu; }
#define XB_SPIN(cond, bar) do { unsigned _sp = 0; while (cond) { __builtin_amdgcn_s_sleep(1); \
    if ((++_sp & 255u) == 0u) { if (xb_ld(&(bar)[XB_TMO])) break; if (_sp > XB_SPIN_CAP) { atomicAdd(&(bar)[XB_TMO], 1u); break; } } } } while (0)
struct XcdBarrier { unsigned* bar; unsigned x; volatile LAS unsigned* st; };
__device__ __forceinline__ XcdBarrier xcd_barrier_post(unsigned* bar, volatile LAS unsigned* st) {
    XcdBarrier b; b.bar = bar; b.x = xb_xcc_id(); b.st = st;
    if (threadIdx.x == 0) (void)xb_add(&bar[XB_XCNT(b.x)], 1u);
    return b;
}
__device__ __forceinline__ void xcd_barrier_complete(unsigned* bar, unsigned x, unsigned& nloc, unsigned& nx) {
    const unsigned G = gridDim.x * gridDim.y * gridDim.z;
    unsigned sum, cnt, mine, sp = 0u;
    for (;;) {
        sum = 0u; cnt = 0u; mine = 0u;
#pragma unroll
        for (unsigned j = 0; j < 16; ++j) { const unsigned c = xb_ld(&bar[XB_XCNT(j)]); sum += c; cnt += (c > 0u) ? 1u : 0u; mine = (j == x) ? c : mine; }
        if (sum == G) break;
        __builtin_amdgcn_s_sleep(1);
        if ((++sp & 255u) == 0u) { if (xb_ld(&bar[XB_TMO])) break; if (sp > XB_SPIN_CAP) { atomicAdd(&bar[XB_TMO], 1u); break; } }
    }
    nloc = mine > 0u ? mine : 1u; nx = cnt > 0u ? cnt : 1u;
}
__device__ __forceinline__ void xcd_barrier(const XcdBarrier& b) {
    asm volatile("s_waitcnt vmcnt(0)" ::: "memory");
    __syncthreads();
    if (threadIdx.x == 0) {
        unsigned* bar = b.bar;
        __builtin_amdgcn_s_waitcnt(0);
        unsigned nloc = b.st[0], nx = b.st[1];
        if (nloc == 0u) { xcd_barrier_complete(bar, b.x, nloc, nx); b.st[0] = nloc; b.st[1] = nx; }
        const unsigned old = xb_add(&bar[XB_XSUB(b.x)], 1u);
        const unsigned gen = old / nloc;
        if (old + 1u == (gen + 1u) * nloc) {
            __builtin_amdgcn_fence(__ATOMIC_RELEASE, "agent");
            asm volatile("s_waitcnt vmcnt(0)" ::: "memory");
            const unsigned og = xb_add(&bar[XB_TOP], 1u);
            const unsigned tg = og / nx;
            if (og + 1u == (tg + 1u) * nx) xb_add(&bar[XB_TOPGEN], 1u);
            else XB_SPIN(xb_ld(&bar[XB_TOPGEN]) == tg, bar);
            __builtin_amdgcn_fence(__ATOMIC_ACQUIRE, "agent");
            xb_add(&bar[XB_XGEN(b.x)], 1u);
            asm volatile("s_waitcnt vmcnt(0)" ::: "memory");
        } else {
            XB_SPIN(xb_ld(&bar[XB_XGEN(b.x)]) == gen, bar);
            __builtin_amdgcn_fence(__ATOMIC_ACQUIRE, "agent");
            asm volatile("s_waitcnt vmcnt(0)" ::: "memory");
        }
    }
    __syncthreads();
}

namespace pg8 {
constexpr int BM = 256, BK = 64, HALF = 128, HTB = HALF * BK * 2, STAGE_BYTES = 8 * HTB, NXCD = 8, WGM = 8;
template <int SH> __host__ __device__ __forceinline__ int lds_byte(int r, int cb) { const int st = (r >> 4) * 2 + (cb >> 6), rr = r & 15, ob = rr * 64 + (cb & 63); return st * 1024 + (ob ^ (((ob >> 9) & 1) << SH)); }
template <int SH> __host__ __device__ __forceinline__ void stage_rc(int b, int& R, int& CB) { const int st = b / 1024, sb = b % 1024, swz = sb ^ (((sb >> 9) & 1) << SH); R = (st >> 1) * 16 + swz / 64; CB = (st & 1) * 64 + (swz % 64); }
__host__ __device__ __forceinline__ int perm32(int rho) { const int n = rho >> 4, i = rho & 15; return 8 * (i >> 2) + 4 * n + (i & 3); }

struct Unit { int pm, pn, bt, e, prow, cnt, half; };
struct Gemm { const void* A; const void* Bt; int Kb; };

__device__ __forceinline__ void tile_of(int L, int nM, int nN, int nwg, int& pm, int& pn) {
    int wgid = L; { const int q = nwg / NXCD, r = nwg % NXCD, xcd = wgid % NXCD, off = wgid / NXCD; wgid = (xcd < r ? xcd * (q + 1) : r * (q + 1) + (xcd - r) * q) + off; }
    const int nig = WGM * nN, gid = wgid / nig, fm = gid * WGM, gsz = (nM - fm) < WGM ? (nM - fm) : WGM;
    pm = fm + ((wgid % nig) % gsz); pn = (wgid % nig) / gsz;
}
struct StaticOrder {
    int nM, nN, nwg, G, c, base, lim;
    __device__ void init(int M, int N, int G_, int c_) { nM = M / BM; nN = N / BM; nwg = nM * nN; G = G_; c = c_; base = 0; lim = 1 << 30; }
    __device__ __forceinline__ bool next(int i, Unit& u) const {
        if (i >= lim) return false;
        const long L = (long)(i + base) * G + c; if (L >= nwg) return false;
        tile_of((int)L, nM, nN, nwg, u.pm, u.pn); u.bt = u.pn; u.e = 0; u.prow = 0; u.cnt = 0; u.half = -1; return true;
    }
};
struct MoeOrder {
    int nM, nN, nwg, G, c; const LAS int* tp; const LAS unsigned char* te; const LAS int* cnt;
    __device__ __forceinline__ bool next(int i, Unit& u) const {
        const int Rf = nwg / G, Lo = nwg - Rf * G; const bool split = (Lo > 0) && (2 * Lo <= G);
        long L; u.half = -1;
        if (i < Rf) L = (long)i * G + c;
        else if (i == Rf && !split) { if (c >= Lo) return false; L = (long)Rf * G + c; }
        else if (i == Rf) { if (c >= 2 * Lo) return false; L = (long)Rf * G + (c >> 1); u.half = c & 1; }
        else return false;
        tile_of((int)L, nM, nN, nwg, u.pm, u.pn);
        const int e = __builtin_amdgcn_readfirstlane((int)te[u.pm]);
        u.e = e; u.bt = e * nN + u.pn; u.prow = (u.pm - __builtin_amdgcn_readfirstlane(tp[e])) * BM; u.cnt = __builtin_amdgcn_readfirstlane(cnt[e]); return true;
    }
};

struct EpiProj {
    static constexpr bool PERM = true, HAS_BIAS = false;
    __device__ __forceinline__ const float* bias_src(const Unit&, int) const { return nullptr; }
    bf16_t* O;
    __device__ __forceinline__ void operator()(const f32x4 (&acc)[2][2][4][2], const Unit& u, int wr, int wc, int fr, int fq, const LAS float*) const {
        const int row0 = u.pm * BM + wr * 64 + fr, col0 = u.pn * BM + wc * 32 + 8 * fq;
        const int mode = (u.pn < 4) ? 1 : (u.pn >= 8 ? 2 : (u.pn == 4 ? 3 : 0));
#pragma unroll
        for (int ai = 0; ai < 2; ++ai)
#pragma unroll
            for (int m = 0; m < 4; ++m) { bf16_t* rowp = O + (size_t)(row0 + ai * HALF + m * 16) * NPROJ + col0;
#pragma unroll
                for (int bj = 0; bj < 2; ++bj) { f32x2 v[4];
#pragma unroll
                    for (int n = 0; n < 2; ++n) { v[2 * n] = (f32x2){acc[ai][bj][m][n][0], acc[ai][bj][m][n][1]}; v[2 * n + 1] = (f32x2){acc[ai][bj][m][n][2], acc[ai][bj][m][n][3]}; }
                    if (mode == 1) {
#pragma unroll
                        for (int i = 0; i < 4; ++i) v[i] = gelu_tanh2(v[i]);
                    } else if (mode == 2) {
#pragma unroll
                        for (int i = 0; i < 4; ++i) v[i] = silu2(v[i]);
                    } else if (mode == 3) {
#pragma unroll
                        for (int i = 0; i < 4; ++i) v[i] = v[i] * 0.125f;
                    }
                    u32x4 w; w.x = pk2(v[0][0], v[0][1]); w.y = pk2(v[1][0], v[1][1]); w.z = pk2(v[2][0], v[2][1]); w.w = pk2(v[3][0], v[3][1]);
                    *(u32x4*)(rowp + bj * HALF) = w; } }
    }
};
struct EpiPlain {
    static constexpr bool PERM = true, HAS_BIAS = false;
    __device__ __forceinline__ const float* bias_src(const Unit&, int) const { return nullptr; }
    bf16_t* O; int ldc;
    __device__ __forceinline__ void operator()(const f32x4 (&acc)[2][2][4][2], const Unit& u, int wr, int wc, int fr, int fq, const LAS float*) const {
        const int row0 = u.pm * BM + wr * 64 + fr, col0 = u.pn * BM + wc * 32 + 8 * fq;
#pragma unroll
        for (int ai = 0; ai < 2; ++ai)
#pragma unroll
            for (int m = 0; m < 4; ++m) { bf16_t* rowp = O + (size_t)(row0 + ai * HALF + m * 16) * ldc + col0;
#pragma unroll
                for (int bj = 0; bj < 2; ++bj) { const f32x4 v0 = acc[ai][bj][m][0], v1 = acc[ai][bj][m][1];
                    u32x4 w; w.x = pk2(v0[0], v0[1]); w.y = pk2(v0[2], v0[3]); w.z = pk2(v1[0], v1[1]); w.w = pk2(v1[2], v1[3]);
                    *(u32x4*)(rowp + bj * HALF) = w; } }
    }
};
struct EpiSwiglu {
    static constexpr bool PERM = true, HAS_BIAS = true;
    unsigned char* H; const float* bg; const float* bu;
    __device__ __forceinline__ const float* bias_src(const Unit& u, int j) const { return (j < 128 ? bg : bu) + (size_t)u.e * 1024 + u.pn * HALF + (j & 127); }
    __device__ __forceinline__ void operator()(const f32x4 (&acc)[2][2][4][2], const Unit& u, int wr, int wc, int fr, int fq, const LAS float* btab) const {
        const int row0 = u.pm * BM + (u.half > 0 ? HALF : 0) + wr * 64 + fr, hc0 = u.pn * HALF + wc * 32 + 8 * fq;
        f32x4 bgv[2], buv[2];
#pragma unroll
        for (int n = 0; n < 2; ++n) { bgv[n] = *(const LAS f32x4*)(btab + wc * 32 + 8 * fq + 4 * n); buv[n] = *(const LAS f32x4*)(btab + 128 + wc * 32 + 8 * fq + 4 * n); }
#pragma unroll
        for (int ai = 0; ai < 2; ++ai) if (ai == 0 || u.half < 0)
#pragma unroll
            for (int m = 0; m < 4; ++m) { f32x2 h[4];
#pragma unroll
                for (int n = 0; n < 2; ++n)
#pragma unroll
                    for (int q = 0; q < 2; ++q) {
                        f32x2 g = (f32x2){acc[ai][0][m][n][2 * q], acc[ai][0][m][n][2 * q + 1]} + (f32x2){bgv[n][2 * q], bgv[n][2 * q + 1]};
                        g = (f32x2){fminf(g[0], 7.0f), fminf(g[1], 7.0f)};
                        const f32x2 uu = clamp2((f32x2){acc[ai][1][m][n][2 * q], acc[ai][1][m][n][2 * q + 1]} + (f32x2){buv[n][2 * q], buv[n][2 * q + 1]}, -7.0f, 7.0f);
                        h[2 * n + q] = ((uu + 1.0f) * g) * rcp2(exp2_2(g * (-1.702f * 1.4426950408889634f)) + 1.0f); }
                *(u32x2*)(H + (size_t)(row0 + ai * HALF + m * 16) * 1024 + hc0) = (u32x2){pk4_fp8(h[0][0], h[0][1], h[1][0], h[1][1]), pk4_fp8(h[2][0], h[2][1], h[3][0], h[3][1])}; }
    }
};
struct EpiOut8 {
    static constexpr bool PERM = true, HAS_BIAS = true;
    unsigned char* O; const float* bd;
    __device__ __forceinline__ const float* bias_src(const Unit& u, int j) const { return bd + (size_t)u.e * 1024 + u.pn * BM + j; }
    __device__ __forceinline__ void operator()(const f32x4 (&acc)[2][2][4][2], const Unit& u, int wr, int wc, int fr, int fq, const LAS float* btab) const {
        const int row0 = u.pm * BM + (u.half > 0 ? HALF : 0) + wr * 64 + fr, col0 = u.pn * BM + wc * 32 + 8 * fq;
        f32x4 bv[2][2];
#pragma unroll
        for (int bj = 0; bj < 2; ++bj)
#pragma unroll
            for (int n = 0; n < 2; ++n) bv[bj][n] = *(const LAS f32x4*)(btab + bj * HALF + wc * 32 + 8 * fq + 4 * n);
#pragma unroll
        for (int ai = 0; ai < 2; ++ai) if (ai == 0 || u.half < 0)
#pragma unroll
            for (int m = 0; m < 4; ++m) { unsigned char* rowp = O + (size_t)(row0 + ai * HALF + m * 16) * 1024 + col0;
#pragma unroll
                for (int bj = 0; bj < 2; ++bj) { f32x2 v[4];
#pragma unroll
                    for (int n = 0; n < 2; ++n)
#pragma unroll
                        for (int q = 0; q < 2; ++q) v[2 * n + q] = clamp2(((f32x2){acc[ai][bj][m][n][2 * q], acc[ai][bj][m][n][2 * q + 1]} + (f32x2){bv[bj][n][2 * q], bv[bj][n][2 * q + 1]}) * OSCALE, -440.0f, 440.0f);
                    *(u32x2*)(rowp + bj * HALF) = (u32x2){pk4_fp8(v[0][0], v[0][1], v[1][0], v[1][1]), pk4_fp8(v[2][0], v[2][1], v[3][0], v[3][1])}; } }
    }
};

typedef int i32x4 __attribute__((ext_vector_type(4)));
typedef int i32x8 __attribute__((ext_vector_type(8)));
template <bool FP8> struct Frag;
template <> struct Frag<false> { bf16x8 k0, k1; __device__ __forceinline__ void ld(const LAS unsigned char* p0, const LAS unsigned char* p1) { k0 = *(const LAS bf16x8*)p0; k1 = *(const LAS bf16x8*)p1; } };
template <> struct Frag<true> { i32x8 v; __device__ __forceinline__ void ld(const LAS unsigned char* p0, const LAS unsigned char* p1) { v = __builtin_shufflevector(*(const LAS i32x4*)p0, *(const LAS i32x4*)p1, 0, 1, 2, 3, 4, 5, 6, 7); } };
__device__ __forceinline__ f32x4 frag_mma(const Frag<false>& b, const Frag<false>& a, f32x4 c) { c = __builtin_amdgcn_mfma_f32_16x16x32_bf16(b.k0, a.k0, c, 0, 0, 0); return __builtin_amdgcn_mfma_f32_16x16x32_bf16(b.k1, a.k1, c, 0, 0, 0); }
__device__ __forceinline__ f32x4 frag_mma(const Frag<true>& b, const Frag<true>& a, f32x4 c, int sw, int s1) {
    asm volatile("s_nop 1\n\tv_mfma_scale_f32_16x16x128_f8f6f4 %0, %1, %2, %0, %3, %4 op_sel_hi:[0,0,0]" : "+v"(c) : "v"(b.v), "v"(a.v), "v"(sw), "v"(s1)); return c; }
__device__ __forceinline__ f32x4 frag_mma(const Frag<false>& b, const Frag<false>& a, f32x4 c, int, int) { return frag_mma(b, a, c); }
template <class Epi, class Sched, bool ALIGN_EPI, bool GATHER, bool FP8>
__device__ __forceinline__ void gemm_phase(LAS unsigned char* lds, const Gemm g, const Sched& S, const Epi& E, const LAS unsigned short* tok) {
    const int tid = threadIdx.x, wid = __builtin_amdgcn_readfirstlane(tid >> 6), lane = tid & 63, wr = wid >> 2, wc = wid & 3, fr = lane & 15, fq = lane >> 4;
    constexpr int SH = FP8 ? 4 : 5;
    const int K = g.Kb, nt = K / 128;
    unsigned voffB[2]; unsigned va[2][2], vn[2][2]; int RA[2], CA[2];
#pragma unroll
    for (int i = 0; i < 2; ++i) { int R, C; stage_rc<SH>(tid * 16 + i * 8192, R, C); const int Rb = Epi::PERM ? ((R & ~31) + perm32(R & 31)) : R;
        RA[i] = R; CA[i] = C; voffB[i] = (unsigned)(Rb * K + C);
#pragma unroll
        for (int h = 0; h < 2; ++h) { va[h][i] = (unsigned)((R + h * HALF) * K + C); vn[h][i] = va[h][i]; } }
    unsigned vplain[2][2];
#pragma unroll
    for (int h = 0; h < 2; ++h)
#pragma unroll
        for (int i = 0; i < 2; ++i) vplain[h][i] = va[h][i];
    const size_t kstep = 128;
    const size_t hstep = (size_t)HALF * K;
    const size_t tstep = 2 * hstep;
    const unsigned ldsw = (unsigned)wid * 1024u;
    const int aoff0 = FP8 ? lds_byte<SH>(wr * 64 + fr, fq * 32) : lds_byte<SH>(wr * 64 + fr, fq * 16), aoff1 = FP8 ? lds_byte<SH>(wr * 64 + fr, fq * 32 + 16) : aoff0 + 1024;
    const int boff0 = FP8 ? lds_byte<SH>(wc * 32 + fr, fq * 32) : lds_byte<SH>(wc * 32 + fr, fq * 16), boff1 = FP8 ? lds_byte<SH>(wc * 32 + fr, fq * 32 + 16) : boff0 + 1024;
#define PG8_SA(b, h) (((b) * 2 + (h)) * HTB)
#define PG8_SB(b, h) ((4 + (b) * 2 + (h)) * HTB)
#define PG8_STAGE(bufoff, gbase, voff) do { _Pragma("unroll") for (int _i = 0; _i < 2; ++_i) \
        __builtin_amdgcn_global_load_lds((const unsigned*)((const char*)(gbase) + (voff)[_i]), (LAS unsigned*)(lds + (bufoff) + ldsw + _i * 8192), 16, 0, 0); } while (0)
#define PG8_LDA(dst, b, h) do { _Pragma("unroll") for (int m = 0; m < 4; ++m) dst[m].ld(lds + PG8_SA(b, h) + aoff0 + m * 2048, lds + PG8_SA(b, h) + aoff1 + m * 2048); } while (0)
#define PG8_LDB(dst, b, h) do { _Pragma("unroll") for (int n = 0; n < 2; ++n) dst[n].ld(lds + PG8_SB(b, h) + boff0 + n * 2048, lds + PG8_SB(b, h) + boff1 + n * 2048); } while (0)
#define PG8_MMA(ai, bj, At, Bt) do { __builtin_amdgcn_s_setprio(1); _Pragma("unroll") for (int m = 0; m < 4; ++m) _Pragma("unroll") for (int n = 0; n < 2; ++n) \
        acc[ai][bj][m][n] = frag_mma(Bt[n], At[m], acc[ai][bj][m][n], sc_w, sc_1); __builtin_amdgcn_s_setprio(0); } while (0)
#define PG8_WAIT_V(n) asm volatile("s_waitcnt vmcnt(" #n ")" ::: "memory")
#define PG8_WAIT_L(n) asm volatile("s_waitcnt lgkmcnt(" #n ")" ::: "memory")
#define PG8_BAR __builtin_amdgcn_s_barrier()
#define PG8_SCHED __builtin_amdgcn_sched_barrier(0)
#define PG8_GATHER_OFFS(dst, ui_, half_) do { _Pragma("unroll") for (int _h = 0; _h < 2; ++_h) _Pragma("unroll") for (int _i = 0; _i < 2; ++_i) \
        dst[_h][_i] = (unsigned)tok[(ui_) * 256 + ((half_) >= 0 ? (half_) * HALF : _h * HALF) + RA[_i]] * (unsigned)K + (unsigned)CA[_i]; } while (0)
#define PG8_PLAIN_OFFS(dst, half_) do { _Pragma("unroll") for (int _i = 0; _i < 2; ++_i) { dst[0][_i] = vplain[0][_i]; dst[1][_i] = (half_) >= 0 ? vplain[0][_i] : vplain[1][_i]; } } while (0)
    Unit cur, nxt; int ui = 0;
    if (!S.next(0, cur)) return;
    f32x4 acc[2][2][4][2];
#pragma unroll
    for (int a = 0; a < 2; ++a)
#pragma unroll
        for (int b = 0; b < 2; ++b)
#pragma unroll
            for (int m = 0; m < 4; ++m)
#pragma unroll
                for (int n = 0; n < 2; ++n) acc[a][b][m][n] = (f32x4){0.f, 0.f, 0.f, 0.f};
    Frag<FP8> At[4], B0[2], B1[2];
    int sc_w = W8_SCALE_E8M0, sc_1 = 0x7F7F7F7F;
    if constexpr (FP8) { asm volatile("" : "+v"(sc_w), "+v"(sc_1)); }
    const char* cA = GATHER ? (const char*)g.A : (const char*)g.A + (size_t)cur.pm * tstep + (cur.half > 0 ? hstep : 0);
    const char* cB = (const char*)g.Bt + (size_t)cur.bt * tstep;
    if constexpr (GATHER) { PG8_GATHER_OFFS(va, 0, cur.half); } else { PG8_PLAIN_OFFS(va, cur.half); }
#define PG8_BIAS_DMA(unit_, slot_) do { if constexpr (Epi::HAS_BIAS) { if (wid < 4) \
        __builtin_amdgcn_global_load_lds((const unsigned*)E.bias_src(unit_, wid * 64 + lane), (LAS unsigned*)(lds + BIAS_OFF + (slot_) * 1024 + wid * 256), 4, 0, 0); } } while (0)
    PG8_BIAS_DMA(cur, 0);
    PG8_STAGE(PG8_SB(0, 0), cB, voffB); PG8_STAGE(PG8_SB(0, 1), cB + hstep, voffB); PG8_STAGE(PG8_SA(0, 0), cA, va[0]); PG8_STAGE(PG8_SA(0, 1), cA, va[1]);
    if (wr == 1) PG8_BAR;
    PG8_WAIT_V(2); PG8_BAR;
    PG8_STAGE(PG8_SB(1, 0), cB + kstep, voffB); PG8_STAGE(PG8_SA(1, 0), cA + kstep, va[0]); PG8_STAGE(PG8_SB(1, 1), cB + hstep + kstep, voffB);
    PG8_WAIT_V(6); PG8_BAR;
    for (;;) {
        const bool has_next = S.next(ui + 1, nxt);
        const char* nA = GATHER ? (const char*)g.A : (has_next ? (const char*)g.A + (size_t)nxt.pm * tstep + (nxt.half > 0 ? hstep : 0) : cA);
        const char* nB = has_next ? (const char*)g.Bt + (size_t)nxt.bt * tstep : cB;
        if (has_next) { if constexpr (GATHER) { PG8_GATHER_OFFS(vn, ui + 1, nxt.half); } else { PG8_PLAIN_OFFS(vn, nxt.half); } }
        else {
#pragma unroll
            for (int h = 0; h < 2; ++h)
#pragma unroll
                for (int i = 0; i < 2; ++i) vn[h][i] = va[h][i]; }
        const bool full = cur.half < 0;
#pragma nounroll
        for (int t = 0; t < nt; t += 2) {
            const bool last = (t == nt - 2);
            const char* a1 = cA + (size_t)(t + 1) * kstep;
            const char* a2 = last ? nA : cA + (size_t)(t + 2) * kstep; const char* b2 = last ? nB : cB + (size_t)(t + 2) * kstep;
            const char* a3 = a2 + kstep; const char* b3 = b2 + kstep;
            unsigned v0[2], v1[2];
            if (last && has_next) PG8_BIAS_DMA(nxt, (ui + 1) & 1);
#pragma unroll
            for (int i = 0; i < 2; ++i) { v0[i] = last ? vn[0][i] : va[0][i]; v1[i] = last ? vn[1][i] : va[1][i]; }
            PG8_LDB(B0, 0, 0); PG8_LDB(B1, 0, 1); PG8_SCHED; PG8_LDA(At, 0, 0); PG8_STAGE(PG8_SA(1, 1), a1, va[1]);
            PG8_WAIT_V(8); PG8_WAIT_L(0); PG8_BAR; PG8_MMA(0, 0, At, B0); PG8_MMA(0, 1, At, B1); PG8_BAR; PG8_SCHED;
            PG8_LDA(At, 0, 1); PG8_STAGE(PG8_SB(0, 0), b2, voffB); PG8_STAGE(PG8_SB(0, 1), b2 + hstep, voffB); PG8_STAGE(PG8_SA(0, 0), a2, v0);
            PG8_WAIT_V(8); PG8_WAIT_L(0); PG8_BAR; if (full) { PG8_MMA(1, 0, At, B0); PG8_MMA(1, 1, At, B1); } PG8_BAR; PG8_SCHED;
            PG8_LDB(B0, 1, 0); PG8_LDB(B1, 1, 1); PG8_SCHED; PG8_LDA(At, 1, 0); PG8_STAGE(PG8_SA(0, 1), a2, v1);
            PG8_WAIT_V(8); PG8_WAIT_L(0); PG8_BAR; PG8_MMA(0, 0, At, B0); PG8_MMA(0, 1, At, B1); PG8_BAR; PG8_SCHED;
            PG8_LDA(At, 1, 1); PG8_STAGE(PG8_SB(1, 0), b3, voffB); PG8_STAGE(PG8_SB(1, 1), b3 + hstep, voffB); PG8_STAGE(PG8_SA(1, 0), a3, v0);
            PG8_WAIT_V(8); PG8_WAIT_L(0); PG8_BAR; if (full) { PG8_MMA(1, 0, At, B0); PG8_MMA(1, 1, At, B1); } PG8_BAR; PG8_SCHED;
        }
        if constexpr (ALIGN_EPI) { if (wr == 0) PG8_BAR; }
        if constexpr (FP8) { asm volatile("s_nop 15\n\ts_nop 7"); PG8_SCHED; }
        E(acc, cur, wr, wc, fr, fq, (const LAS float*)(lds + BIAS_OFF + (ui & 1) * 1024));
        if (!has_next) break;
#pragma unroll
        for (int a = 0; a < 2; ++a)
#pragma unroll
            for (int b = 0; b < 2; ++b)
#pragma unroll
                for (int m = 0; m < 4; ++m)
#pragma unroll
                    for (int n = 0; n < 2; ++n) acc[a][b][m][n] = (f32x4){0.f, 0.f, 0.f, 0.f};
        cur = nxt; cA = nA; cB = nB; ++ui;
#pragma unroll
        for (int h = 0; h < 2; ++h)
#pragma unroll
            for (int i = 0; i < 2; ++i) va[h][i] = vn[h][i];
        if constexpr (ALIGN_EPI) { if (wr == 1) PG8_BAR; }
    }
    PG8_WAIT_V(0);
    if constexpr (!ALIGN_EPI) { if (wr == 0) PG8_BAR; }
    PG8_BAR;
#undef PG8_SA
#undef PG8_SB
#undef PG8_STAGE
#undef PG8_LDA
#undef PG8_LDB
#undef PG8_MMA
#undef PG8_WAIT_V
#undef PG8_WAIT_L
#undef PG8_BAR
#undef PG8_SCHED
#undef PG8_GATHER_OFFS
#undef PG8_PLAIN_OFFS
#undef PG8_BIAS_DMA
}
}

struct Args { const float* in[24]; float* out; unsigned char* ws; int ph_lo, ph_hi; };
enum { I_X = 0, I_C, I_WADA, I_BADA, I_GPRE, I_WIN, I_GSGU, I_WS, I_BS, I_WGK2, I_BGK, I_GGLA, I_WOUT, I_GPOST, I_GPFFN, I_WR, I_BR, I_WG, I_BG, I_WU, I_BU, I_WDN, I_BDN, I_GPOSTF };

template <bool FP8>
__device__ __forceinline__ void transpose_item(const float* W, int ldw, int k0, int n0, void* WT, size_t dst_row0, LAS float* scr, int lane) {
    f32x4 v[8];
#pragma unroll
    for (int q = 0; q < 8; ++q) v[q] = *(const f32x4*)(W + (size_t)(k0 + 8 * q + (lane >> 3)) * ldw + n0 + 4 * (lane & 7));
#pragma unroll
    for (int q = 0; q < 8; ++q) { LAS float* d = scr + (8 * q + (lane >> 3)) * 33 + 4 * (lane & 7); d[0] = v[q][0]; d[1] = v[q][1]; d[2] = v[q][2]; d[3] = v[q][3]; }
    asm volatile("s_waitcnt lgkmcnt(0)" ::: "memory");
    const int c = lane & 7;
#pragma unroll
    for (int j = 0; j < 4; ++j) { const int n = (lane >> 3) + 8 * j; const LAS float* s = scr + (8 * c) * 33 + n;
        if constexpr (FP8) {
            const u32x2 o = (u32x2){pk4_fp8(s[0 * 33] * W8_SCALE, s[1 * 33] * W8_SCALE, s[2 * 33] * W8_SCALE, s[3 * 33] * W8_SCALE), pk4_fp8(s[4 * 33] * W8_SCALE, s[5 * 33] * W8_SCALE, s[6 * 33] * W8_SCALE, s[7 * 33] * W8_SCALE)};
            *(u32x2*)((unsigned char*)WT + (dst_row0 + n) * 1024 + k0 + 8 * c) = o;
        } else {
            u32x4 o; o.x = pk2(s[0 * 33], s[1 * 33]); o.y = pk2(s[2 * 33], s[3 * 33]); o.z = pk2(s[4 * 33], s[5 * 33]); o.w = pk2(s[6 * 33], s[7 * 33]);
            *(u32x4*)((bf16_t*)WT + (dst_row0 + n) * 1024 + k0 + 8 * c) = o; } }
    asm volatile("s_waitcnt lgkmcnt(0)" ::: "memory");
}
__device__ __forceinline__ void p0_prologue(const Args& a, LAS unsigned char* lds, int G) {
    const int tid = threadIdx.x, lane = tid & 63, wave = __builtin_amdgcn_readfirstlane(tid >> 6);
    const int gw = blockIdx.x * 8 + wave, NGW = G * 8;
    unsigned char* ws = a.ws;
    {
        float* mods = (float*)(ws + WS_MODS);
        const float* c = a.in[I_C]; const float* wa = a.in[I_WADA]; const float* ba = a.in[I_BADA];
        LAS float* sc = (LAS float*)lds;
        LAS float* part = (LAS float*)(lds + 16384);
        if ((int)blockIdx.x < 96) { for (int i = tid; i < 4096; i += 512) sc[i] = silu_(c[i]); __syncthreads(); }
        for (int it = blockIdx.x; it < 96; it += G) {
            const int r = lane >> 4, cq = lane & 15, k0 = wave * 128;
            const float* wp = wa + (size_t)(k0 + r) * 6144 + it * 64 + 4 * cq;
            f32x4 wv[32];
#pragma unroll
            for (int i = 0; i < 32; ++i) wv[i] = __builtin_nontemporal_load((const f32x4*)(wp + (size_t)(4 * i) * 6144));
            f32x4 acc[4];
#pragma unroll
            for (int b = 0; b < 4; ++b) acc[b] = (f32x4){0.f, 0.f, 0.f, 0.f};
#pragma unroll
            for (int i = 0; i < 32; ++i)
#pragma unroll
                for (int b = 0; b < 4; ++b) acc[b] += wv[i] * sc[b * 1024 + k0 + 4 * i + r];
#pragma unroll
            for (int b = 0; b < 4; ++b)
#pragma unroll
                for (int e2 = 0; e2 < 4; ++e2) { float t = acc[b][e2]; t += __shfl_xor(t, 16); t += __shfl_xor(t, 32); acc[b][e2] = t; }
            if (lane < 16) {
#pragma unroll
                for (int b = 0; b < 4; ++b) *(LAS f32x4*)(part + (wave * 4 + b) * 64 + 4 * cq) = acc[b]; }
            __syncthreads();
            if (tid < 256) { const int b = tid >> 6, cc = tid & 63; float sv = ba[it * 64 + cc];
#pragma unroll
                for (int w = 0; w < 8; ++w) sv += part[(w * 4 + b) * 64 + cc];
                mods[b * 6144 + it * 64 + cc] = sv; }
            __syncthreads();
        }
    }
    {
        const float* wr = a.in[I_WR]; bf16_t* wh = (bf16_t*)(ws + WS_WR); bf16_t* wl = wh + 32 * 1024;
        for (int idx = blockIdx.x * 512 + tid; idx < 32768; idx += G * 512) { const int k = idx >> 5, j = idx & 31; const float w = wr[idx];
            const unsigned h = f2bf(w); wh[j * 1024 + k] = (bf16_t)h; wl[j * 1024 + k] = (bf16_t)f2bf(w - bf2f(h)); }
    }
    {
        LAS float* scr = (LAS float*)(lds + wave * 16384);
        constexpr int I_IN = 16 * 80, I_OUT = 16 * 32, I_E = 16 * 32;
        constexpr int NITEMS = I_IN + I_OUT + 3 * NE * I_E;
        bf16_t* Win = (bf16_t*)(ws + WS_WIN); bf16_t* Wout = (bf16_t*)(ws + WS_WOUT);
        (void)NITEMS;
        for (int it = gw; it < I_IN + I_OUT; it += NGW) {
            int r = it;
            if (r < I_IN) { const int kb = r / 80, nb = r % 80; transpose_item<false>(a.in[I_WIN], D_IN, 64 * kb, 32 * nb, Win, (size_t)(32 * nb), scr, lane); continue; } r -= I_IN;
            { const int kb = r / 32, nb = r % 32; transpose_item<false>(a.in[I_WOUT], 1024, 64 * kb, 32 * nb, Wout, (size_t)(32 * nb), scr, lane); }
        }
    }
}

constexpr int MOE_ITEMS = 3 * NE * 256;
__device__ __forceinline__ void moe_convert(const Args& a, LAS unsigned char* lds, int G, int first, int last) {
    (void)lds;
    const int tid = threadIdx.x, lane = tid & 63, wave = __builtin_amdgcn_readfirstlane(tid >> 6);
    const int gw = blockIdx.x * 8 + wave, NGW = G * 8;
    unsigned char* Wd = a.ws + WS_WD; unsigned char* W1 = a.ws + WS_W1;
    constexpr int I_E8 = 8 * 32;
#define MC_DECODE(it_, src_, dst_) do { int r = (it_); const int mat = r / (NE * I_E8); r -= mat * (NE * I_E8); const int e = r / I_E8; r -= e * I_E8; \
        const int nb = 8 * (r >> 6) + (r & 7), kb = (r >> 3) & 7, n0 = 32 * nb, k0 = 128 * kb; \
        const float* Wm = (mat == 0 ? a.in[I_WG] : (mat == 1 ? a.in[I_WU] : a.in[I_WDN])) + (size_t)e * 1048576; \
        const size_t drow = (mat == 2) ? (size_t)e * 1024 + n0 : (size_t)e * 2048 + (size_t)(n0 >> 7) * 256 + (size_t)mat * 128 + (size_t)(n0 & 127); \
        dst_ = (mat == 2 ? Wd : W1) + (drow + 4 * (lane & 7)) * 1024 + k0 + 16 * (lane >> 3); src_ = Wm + (size_t)(k0 + 16 * (lane >> 3)) * 1024 + n0 + 4 * (lane & 7); } while (0)
#define MC_LOAD(vv, src_) do { _Pragma("unroll") for (int q = 0; q < 16; ++q) vv[q] = __builtin_nontemporal_load((const f32x4*)((src_) + (size_t)q * 1024)); } while (0)
#define MC_PROC(vv, dst_) do { u32x4 o_[4]; \
        _Pragma("unroll") for (int g4 = 0; g4 < 4; ++g4) { unsigned D_[4]; \
            _Pragma("unroll") for (int q = 0; q < 4; ++q) { const f32x4 t_ = vv[4 * g4 + q] * W8_SCALE; D_[q] = pk4_fp8(t_[0], t_[1], t_[2], t_[3]); } \
            const unsigned pa = __builtin_amdgcn_perm(D_[1], D_[0], 0x05010400u), pb = __builtin_amdgcn_perm(D_[1], D_[0], 0x07030602u); \
            const unsigned pc = __builtin_amdgcn_perm(D_[3], D_[2], 0x05010400u), pd = __builtin_amdgcn_perm(D_[3], D_[2], 0x07030602u); \
            o_[0][g4] = __builtin_amdgcn_perm(pc, pa, 0x05040100u); o_[1][g4] = __builtin_amdgcn_perm(pc, pa, 0x07060302u); \
            o_[2][g4] = __builtin_amdgcn_perm(pd, pb, 0x05040100u); o_[3][g4] = __builtin_amdgcn_perm(pd, pb, 0x07060302u); } \
        _Pragma("unroll") for (int j = 0; j < 4; ++j) __builtin_nontemporal_store(o_[j], (u32x4*)((dst_) + (size_t)j * 1024)); } while (0)
    int it = first + gw;
    if (it < last) {
        const int nmine = (last - 1 - it) / NGW;
        const int itlast = it + nmine * NGW;
        const float* sA; unsigned char* dA; const float* sB; unsigned char* dB; f32x4 v[16], w[16];
        MC_DECODE(it, sA, dA); MC_LOAD(v, sA);
        for (; it < last; it += 2 * NGW) {
            const int itb = (it + NGW <= itlast) ? it + NGW : itlast, ita = (it + 2 * NGW <= itlast) ? it + 2 * NGW : itlast;
            MC_DECODE(itb, sB, dB); MC_LOAD(w, sB);
            MC_PROC(v, dA);
            MC_DECODE(ita, sA, dA); MC_LOAD(v, sA);
            MC_PROC(w, dB);
        }
    }
#undef MC_DECODE
#undef MC_LOAD
#undef MC_PROC
}

__device__ __forceinline__ void p1_norm(const Args& a, LAS unsigned char* lds, int G) {
    const int tid = threadIdx.x, lane = tid & 63, wave = __builtin_amdgcn_readfirstlane(tid >> 6);
    const float* x = a.in[I_X]; const float* win = a.in[I_WIN]; const float* gpre = a.in[I_GPRE];
    const float* mods = (const float*)(a.ws + WS_MODS);
    bf16_t* XN = (bf16_t*)(a.ws + WS_XN); float* glow = (float*)(a.ws + WS_GLOW);
    constexpr int NP1 = 1032;
    LAS bf16_t* NT = (LAS bf16_t*)lds; LAS float* RP = (LAS float*)(lds + 16 * NP1 * 2);
    bf16x8 wg[4];
#pragma unroll
    for (int ks = 0; ks < 4; ++ks)
#pragma unroll
        for (int e = 0; e < 8; ++e) { const int k = 128 * wave + 32 * ks + 8 * (lane >> 4) + e; wg[ks][e] = (short)f2bf(win[(size_t)k * D_IN + C_GL + (lane & 15)]); }
    for (int blk = blockIdx.x; blk < T / 128; blk += G) {
        const int b = (blk * 128) / SEQ;
        f32x4 A1[4], B1[4];
#pragma unroll
        for (int j = 0; j < 4; ++j) { const int k = 4 * lane + 256 * j; const f32x4 gv = *(const f32x4*)(gpre + k), sc = *(const f32x4*)(mods + b * 6144 + 1024 + k);
            A1[j] = gv * (sc + 1.0f); B1[j] = *(const f32x4*)(mods + b * 6144 + k); }
        f32x4 nx[4][4];
#define P1_ROWOF(q_) ((size_t)(blk * 128 + 16 * ((q_) >> 1) + 2 * wave + ((q_) & 1)))
#pragma unroll
        for (int d = 0; d < 4; ++d) { const size_t row = P1_ROWOF(d);
#pragma unroll
          for (int j = 0; j < 4; ++j) nx[d][j] = __builtin_nontemporal_load((const f32x4*)(x + row * 1024 + 4 * lane + 256 * j)); }
        for (int it0 = 0; it0 < 8; it0 += 2) {
#pragma unroll
          for (int iu = 0; iu < 2; ++iu) {
            const int it = it0 + iu;
#pragma unroll
            for (int rr = 0; rr < 2; ++rr) {
                const int r16 = 2 * wave + rr, q = 2 * it + rr, sl = 2 * iu + rr; const size_t row = P1_ROWOF(q);
                const int qn = q + 4 < 16 ? q + 4 : 15; const size_t rown = P1_ROWOF(qn);
                f32x4 v[4]; float ss = 0.f;
#pragma unroll
                for (int j = 0; j < 4; ++j) { v[j] = nx[sl][j]; ss += (v[j][0] * v[j][0] + v[j][1] * v[j][1]) + (v[j][2] * v[j][2] + v[j][3] * v[j][3]); }
#pragma unroll
                for (int j = 0; j < 4; ++j) nx[sl][j] = __builtin_nontemporal_load((const f32x4*)(x + rown * 1024 + 4 * lane + 256 * j));
                const float rstd = __builtin_amdgcn_rsqf(wave_sum(ss) * (1.0f / 1024.0f) + EPS);
#pragma unroll
                for (int j = 0; j < 4; ++j) { v[j] = v[j] * rstd * A1[j] + B1[j];
                    const u32x2 w = (u32x2){pk2(v[j][0], v[j][1]), pk2(v[j][2], v[j][3])};
                    *(u32x2*)(XN + row * 1024 + 4 * lane + 256 * j) = w; *(LAS u32x2*)(NT + r16 * NP1 + 4 * lane + 256 * j) = w; }
            }
            LDS_BARRIER();
            {
                f32x4 acc = (f32x4){0.f, 0.f, 0.f, 0.f};
#pragma unroll
                for (int ks = 0; ks < 4; ++ks) { const bf16x8 av = *(const LAS bf16x8*)(NT + (lane & 15) * NP1 + 128 * wave + 32 * ks + 8 * (lane >> 4)); acc = mfma16(av, wg[ks], acc); }
#pragma unroll
                for (int r = 0; r < 4; ++r) RP[wave * 256 + (4 * (lane >> 4) + r) * 16 + (lane & 15)] = acc[r];
            }
            LDS_BARRIER();
            if (tid < 256) { float sv = 0.f;
#pragma unroll
                for (int w = 0; w < 8; ++w) sv += RP[w * 256 + tid];
                glow[((size_t)blk * 128 + 16 * it) * 16 + tid] = sv; }
          }
        }
#undef P1_ROWOF
        LDS_BARRIER();
    }
}

__device__ __forceinline__ unsigned lo_pair(unsigned a, unsigned b) { return (a & 0xffffu) | (b << 16); }
__device__ __forceinline__ unsigned hi_pair(unsigned a, unsigned b) { return (a >> 16) | (b & 0xffff0000u); }
constexpr int VP32 = 68;
__device__ __forceinline__ void p3_sgu(const Args& a, LAS unsigned char* lds, int G) {
    const int tid = threadIdx.x, lane = tid & 63, wave = __builtin_amdgcn_readfirstlane(tid >> 6);
    const bf16_t* PROJ = (const bf16_t*)(a.ws + WS_PROJ); bf16_t* MIXA = (bf16_t*)(a.ws + WS_XN);
    const int nper = G / 8;
    const int h = blockIdx.x & 7, sub = blockIdx.x >> 3;
    if (sub >= nper) return;
    const int t = 16 * wave + (lane & 15);
    bf16x8 wf[4];
#pragma unroll
    for (int ks = 0; ks < 4; ++ks) { const float* wrow = a.in[I_WS] + ((size_t)h * 128 + t) * 128 + 32 * ks + 8 * (lane >> 4);
#pragma unroll
        for (int e2 = 0; e2 < 8; ++e2) { const int s = 32 * ks + 8 * (lane >> 4) + e2; const float w = (s <= t) ? wrow[e2] : 0.f; wf[ks][e2] = (short)f2bf(w); } }
    const float bias = a.in[I_BS][h * 128 + t];
    const int token = tid >> 2, part = tid & 3, odd = token & 1;
    float gs[16];
#pragma unroll
    for (int j = 0; j < 16; ++j) gs[j] = a.in[I_GSGU][h * 64 + part * 16 + j];
    u32x4 nr0, nr1; u32x2 nu[4];
#define SGU_LOAD(idx_) do { const int tok0_ = ((idx_) >> 6) * SEQ + ((idx_) & 63) * 128; \
        const bf16_t* src_ = PROJ + (size_t)(tok0_ + token) * NPROJ + C_VS + h * 64 + part * 16; nr0 = *(const u32x4*)src_; nr1 = *(const u32x4*)(src_ + 8); \
        _Pragma("unroll") for (int dt = 0; dt < 4; ++dt) nu[dt] = *(const u32x2*)(PROJ + (size_t)(tok0_ + t) * NPROJ + C_US + h * 64 + 16 * dt + 4 * (lane >> 4)); } while (0)
    SGU_LOAD(sub);
    int buf = 0;
    for (int idx = sub; idx < 256; idx += nper, buf ^= 1) {
        LAS unsigned* vhT = (LAS unsigned*)(lds + buf * (64 * VP32 * 4));
        const int tok0 = (idx >> 6) * SEQ + (idx & 63) * 128;
        const u32x4 r0 = nr0, r1 = nr1; u32x2 uu[4];
#pragma unroll
        for (int dt = 0; dt < 4; ++dt) uu[dt] = nu[dt];
        { const int idn = (idx + nper < 256) ? idx + nper : idx; SGU_LOAD(idn); }
        float v[16];
#pragma unroll
        for (int i = 0; i < 4; ++i) { v[2 * i] = bflo(r0[i]); v[2 * i + 1] = bfhi(r0[i]); v[8 + 2 * i] = bflo(r1[i]); v[8 + 2 * i + 1] = bfhi(r1[i]); }
        float ss = 0.f;
#pragma unroll
        for (int j = 0; j < 16; ++j) ss += v[j] * v[j];
        ss += __shfl_xor(ss, 1); ss += __shfl_xor(ss, 2);
        const float rstd = __builtin_amdgcn_rsqf(ss * (1.0f / 64.0f) + EPS);
        unsigned pw[8];
#pragma unroll
        for (int i = 0; i < 8; ++i) pw[i] = pk2(v[2 * i] * rstd * gs[2 * i], v[2 * i + 1] * rstd * gs[2 * i + 1]);
#pragma unroll
        for (int i = 0; i < 4; ++i) {
            const unsigned snd = odd ? pw[i] : pw[4 + i], own = odd ? pw[4 + i] : pw[i], rcv = (unsigned)__shfl_xor((int)snd, 4);
            const unsigned first = odd ? rcv : own, second = odd ? own : rcv;
            const int d = 16 * part + 8 * odd + 2 * i;
            vhT[d * VP32 + ((token >> 1) ^ (4 * (d >> 4)))] = lo_pair(first, second);
            vhT[(d + 1) * VP32 + ((token >> 1) ^ (4 * (d >> 4)))] = hi_pair(first, second); }
        LDS_BARRIER();
        f32x4 acc[4];
#pragma unroll
        for (int dt = 0; dt < 4; ++dt) acc[dt] = (f32x4){0.f, 0.f, 0.f, 0.f};
#pragma unroll
        for (int ks = 0; ks < 4; ++ks) if (ks <= (wave >> 1)) {
#pragma unroll
            for (int dt = 0; dt < 4; ++dt) { const bf16x8 av = *(const LAS bf16x8*)(vhT + (16 * dt + (lane & 15)) * VP32 + ((16 * ks + 4 * (lane >> 4)) ^ (4 * dt))); acc[dt] = mfma16(av, wf[ks], acc[dt]); } }
        const size_t trow = (size_t)(tok0 + t);
#pragma unroll
        for (int dt = 0; dt < 4; ++dt) { const int d = 16 * dt + 4 * (lane >> 4);
            const float o0 = bflo(uu[dt][0]) * (acc[dt][0] + bias), o1 = bfhi(uu[dt][0]) * (acc[dt][1] + bias), o2 = bflo(uu[dt][1]) * (acc[dt][2] + bias), o3 = bfhi(uu[dt][1]) * (acc[dt][3] + bias);
            *(u32x2*)(MIXA + trow * 1024 + h * 64 + d) = (u32x2){pk2(o0, o1), pk2(o2, o3)}; }
    }
#undef SGU_LOAD
}

constexpr int GP32 = 36;
constexpr int GP = 72;
constexpr int GL_WG2 = 0  , GL_WT = 4096  , GL_A = 6144  , GL_B = GL_A + 9216  , GL_VT = GL_B + 9216  ,
              GL_PM = GL_VT + 18432  , GL_RS = GL_PM + 9216  ;
__device__ __forceinline__ void gla_decay(const LAS float* wg2, LAS float* WT, const float (&bgk)[8], f32x2 g2, int lane, int wave, float (&bc)[8], float (&tot)[8]) {
    const int a8 = (lane & 7) * 8, base = lane & ~7;
    f32x2 xp[4];
#pragma unroll
    for (int e = 0; e < 4; ++e) xp[e] = (f32x2){bgk[2 * e], bgk[2 * e + 1]};
#pragma unroll
    for (int j = 0; j < 8; ++j) { const float x0 = __shfl(g2[0], base + j), x1 = __shfl(g2[1], base + j);
        const f32x4 w00 = *(const LAS f32x4*)(wg2 + (2 * j) * 64 + a8), w01 = *(const LAS f32x4*)(wg2 + (2 * j) * 64 + a8 + 4);
        const f32x4 w10 = *(const LAS f32x4*)(wg2 + (2 * j + 1) * 64 + a8), w11 = *(const LAS f32x4*)(wg2 + (2 * j + 1) * 64 + a8 + 4);
        xp[0] += (f32x2){w00[0], w00[1]} * x0; xp[1] += (f32x2){w00[2], w00[3]} * x0; xp[2] += (f32x2){w01[0], w01[1]} * x0; xp[3] += (f32x2){w01[2], w01[3]} * x0;
        xp[0] += (f32x2){w10[0], w10[1]} * x1; xp[1] += (f32x2){w10[2], w10[3]} * x1; xp[2] += (f32x2){w11[0], w11[1]} * x1; xp[3] += (f32x2){w11[2], w11[3]} * x1; }
    float la[8];
#pragma unroll
    for (int e = 0; e < 8; ++e) { const float xx = xp[e >> 1][e & 1];
        la[e] = (fminf(xx, 0.f) - 0.6931471806f * __builtin_amdgcn_logf(1.0f + __builtin_amdgcn_exp2f(-1.4426950409f * fabsf(xx)))) * (1.0f / 16.0f); }
#pragma unroll
    for (int off = 8; off < 64; off <<= 1) {
#pragma unroll
        for (int e = 0; e < 8; ++e) { const float tv = __shfl_up(la[e], off); if (lane >= off) la[e] += tv; } }
    if (lane >= 56) { *(LAS f32x4*)(WT + wave * 64 + a8) = (f32x4){la[0], la[1], la[2], la[3]}; *(LAS f32x4*)(WT + wave * 64 + a8 + 4) = (f32x4){la[4], la[5], la[6], la[7]}; }
    LDS_BARRIER();
    float off8[8];
#pragma unroll
    for (int e = 0; e < 8; ++e) { off8[e] = 0.f; tot[e] = 0.f; }
#pragma unroll
    for (int w = 0; w < 8; ++w) { const f32x4 t0 = *(const LAS f32x4*)(WT + w * 64 + a8), t1 = *(const LAS f32x4*)(WT + w * 64 + a8 + 4);
#pragma unroll
        for (int e = 0; e < 4; ++e) { tot[e] += t0[e]; tot[4 + e] += t1[e]; if (w < wave) { off8[e] += t0[e]; off8[4 + e] += t1[e]; } } }
#pragma unroll
    for (int e = 0; e < 8; ++e) bc[e] = la[e] + off8[e];
}
__device__ __forceinline__ void gla_vt_write(LAS unsigned* VT, u32x4 v0, u32x4 v1, int lane, int wave) {
    const int cl = lane >> 3, a = lane & 7, odd = cl & 1, dcol = 4 * wave + (cl >> 1);
#pragma unroll
    for (int i = 0; i < 4; ++i) {
        const unsigned snd = odd ? v0[i] : v1[i], own = odd ? v1[i] : v0[i], rcv = (unsigned)__shfl_xor((int)snd, 8);
        const unsigned first = odd ? rcv : own, second = odd ? own : rcv;
        const int v = 16 * a + 8 * odd + 2 * i;
        VT[v * GP32 + (dcol ^ (4 * a))] = lo_pair(first, second);
        VT[(v + 1) * GP32 + (dcol ^ (4 * a))] = hi_pair(first, second); }
}

__device__ __forceinline__ void p3_gla_state(const Args& a, LAS unsigned char* lds, int G) {
    const int tid = threadIdx.x, lane = tid & 63, wave = __builtin_amdgcn_readfirstlane(tid >> 6);
    const bf16_t* PROJ = (const bf16_t*)(a.ws + WS_PROJ); float* ST = (float*)(a.ws + WS_ST); float* DEC = (float*)(a.ws + WS_DEC); const float* glow = (const float*)(a.ws + WS_GLOW); float* BCUM = (float*)(a.ws + WS_BCUM);
    LAS float* wg2 = (LAS float*)(lds + GL_WG2); LAS float* WT = (LAS float*)(lds + GL_WT);
    LAS unsigned* KDT = (LAS unsigned*)(lds + GL_A); LAS unsigned* VT = (LAS unsigned*)(lds + GL_VT);
    const int c = tid >> 3, a8 = (tid & 7) * 8, v16 = (tid & 7) * 16, cl = lane >> 3, odd = cl & 1;
    int cur_h = -1; float bgk[8];
    f32x2 ng2; u32x4 nkr, nv0, nv1;
#define ST_LOAD(idx_) do { const int bh_ = (idx_) & 15, n_ = (idx_) >> 4, tok0_ = (bh_ >> 2) * SEQ + n_ * 64, h_ = bh_ & 3; \
        ng2 = *(const f32x2*)(glow + (size_t)tok0_ * 16 + 2 * tid); nkr = *(const u32x4*)(PROJ + (size_t)(tok0_ + c) * NPROJ + C_K + h_ * 64 + a8); \
        const bf16_t* vs_ = PROJ + (size_t)(tok0_ + c) * NPROJ + C_V + h_ * 128 + v16; nv0 = *(const u32x4*)vs_; nv1 = *(const u32x4*)(vs_ + 8); } while (0)
    if ((int)blockIdx.x < 2048) ST_LOAD((int)blockIdx.x);
    for (int idx = blockIdx.x; idx < 2048; idx += G) {
        const int bh = idx & 15, n = idx >> 4, h = bh & 3, su = bh * 128 + n;
        if (h != cur_h) {
            LDS_BARRIER();
            for (int i = tid; i < 1024; i += 512) wg2[i] = a.in[I_WGK2][(i >> 6) * 256 + h * 64 + (i & 63)];
#pragma unroll
            for (int e = 0; e < 8; ++e) bgk[e] = a.in[I_BGK][h * 64 + a8 + e];
            cur_h = h; LDS_BARRIER(); }
        const f32x2 g2 = ng2; const u32x4 kr = nkr, v0 = nv0, v1 = nv1;
        { const int idn = (idx + G < 2048) ? idx + G : idx; ST_LOAD(idn); }
        float bc[8], tot[8];
        gla_decay(wg2, WT, bgk, g2, lane, wave, bc, tot);
        { float* bp = BCUM + (size_t)((bh >> 2) * SEQ + n * 64 + c) * 256 + h * 64 + a8; *(f32x4*)bp = (f32x4){bc[0], bc[1], bc[2], bc[3]}; *(f32x4*)(bp + 4) = (f32x4){bc[4], bc[5], bc[6], bc[7]}; }
        {
            unsigned pw[4];
#pragma unroll
            for (int i = 0; i < 4; ++i) pw[i] = pk2(bflo(kr[i]) * __expf(tot[2 * i] - bc[2 * i]), bfhi(kr[i]) * __expf(tot[2 * i + 1] - bc[2 * i + 1]));
            const int dcol = 4 * wave + (cl >> 1);
#pragma unroll
            for (int i = 0; i < 2; ++i) {
                const unsigned snd = odd ? pw[i] : pw[2 + i], own = odd ? pw[2 + i] : pw[i], rcv = (unsigned)__shfl_xor((int)snd, 8);
                const unsigned first = odd ? rcv : own, second = odd ? own : rcv;
                const int d = a8 + 4 * odd + 2 * i;
                KDT[d * GP32 + (dcol ^ (4 * (d >> 4)))] = lo_pair(first, second);
                KDT[(d + 1) * GP32 + (dcol ^ (4 * (d >> 4)))] = hi_pair(first, second); }
            gla_vt_write(VT, v0, v1, lane, wave);
            if (tid < 8) { float* dp = DEC + (size_t)su * 64 + a8; *(f32x4*)dp = (f32x4){__expf(tot[0]), __expf(tot[1]), __expf(tot[2]), __expf(tot[3])}; *(f32x4*)(dp + 4) = (f32x4){__expf(tot[4]), __expf(tot[5]), __expf(tot[6]), __expf(tot[7])}; }
        }
        LDS_BARRIER();
        {
            f32x4 acc[4];
#pragma unroll
            for (int dt = 0; dt < 4; ++dt) acc[dt] = (f32x4){0.f, 0.f, 0.f, 0.f};
#pragma unroll
            for (int ks = 0; ks < 2; ++ks) { const int dc = 16 * ks + 4 * (lane >> 4);
                const bf16x8 bv = *(const LAS bf16x8*)(VT + (16 * wave + (lane & 15)) * GP32 + (dc ^ (4 * wave)));
#pragma unroll
                for (int dt = 0; dt < 4; ++dt) { const bf16x8 av = *(const LAS bf16x8*)(KDT + (16 * dt + (lane & 15)) * GP32 + (dc ^ (4 * dt))); acc[dt] = mfma16(av, bv, acc[dt]); } }
            float* dst = ST + ((size_t)su * 128 + 16 * wave + (lane & 15)) * 64 + 4 * (lane >> 4);
#pragma unroll
            for (int dt = 0; dt < 4; ++dt) *(f32x4*)(dst + 16 * dt) = acc[dt];
        }
    }
#undef ST_LOAD
}

__device__ __forceinline__ void p4_scan(const Args& a, int G) {
    const float* ST = (const float*)(a.ws + WS_ST); const float* DEC = (const float*)(a.ws + WS_DEC); bf16_t* PREV = (bf16_t*)(a.ws + WS_PREV);
    for (int gid = blockIdx.x * 512 + threadIdx.x; gid < 131072; gid += G * 512) {
        const int bh = gid >> 13, rem = gid & 8191;
        float s0 = 0.f;
        for (int n0 = 0; n0 < 128; n0 += 16) {
            float st[16], dc[16];
#pragma unroll
            for (int j = 0; j < 16; ++j) { const size_t su = (size_t)bh * 128 + n0 + j; st[j] = ST[su * 8192 + rem]; dc[j] = DEC[su * 64 + (rem & 63)]; }
#pragma unroll
            for (int j = 0; j < 16; ++j) { const size_t su = (size_t)bh * 128 + n0 + j; PREV[su * 8192 + rem] = (bf16_t)f2bf(s0); s0 = dc[j] * s0 + st[j]; }
        }
    }
}

__device__ __forceinline__ void p5_gla_out(const Args& a, LAS unsigned char* lds, int G) {
    const int tid = threadIdx.x, lane = tid & 63, wave = __builtin_amdgcn_readfirstlane(tid >> 6);
    const bf16_t* PROJ = (const bf16_t*)(a.ws + WS_PROJ); const bf16_t* PREV = (const bf16_t*)(a.ws + WS_PREV); bf16_t* MIXA = (bf16_t*)(a.ws + WS_XN); const float* glow = (const float*)(a.ws + WS_GLOW);
    const float* BCUM = (const float*)(a.ws + WS_BCUM);
    LAS bf16_t* QS = (LAS bf16_t*)(lds + GL_A); LAS bf16_t* KS = (LAS bf16_t*)(lds + GL_B); LAS unsigned* VT = (LAS unsigned*)(lds + GL_VT); LAS bf16_t* PM = (LAS bf16_t*)(lds + GL_PM);
    LAS float* RS = (LAS float*)(lds + GL_RS);
    const int c = tid >> 3, a8 = (tid & 7) * 8, v16 = (tid & 7) * 16;
    const int it = wave >> 1, vh = wave & 1;
    f32x4 nb0, nb1; u32x4 nqr, nkr, nv0, nv1;
#define GO_LOAD(idx_) do { const int bh_ = (idx_) & 15, n_ = (idx_) >> 4, tok0_ = (bh_ >> 2) * SEQ + n_ * 64, h_ = bh_ & 3; \
        { const float* bp_ = BCUM + (size_t)(tok0_ + c) * 256 + h_ * 64 + a8; nb0 = *(const f32x4*)bp_; nb1 = *(const f32x4*)(bp_ + 4); } \
        nqr = *(const u32x4*)(PROJ + (size_t)(tok0_ + c) * NPROJ + C_Q + h_ * 64 + a8); nkr = *(const u32x4*)(PROJ + (size_t)(tok0_ + c) * NPROJ + C_K + h_ * 64 + a8); \
        const bf16_t* vs_ = PROJ + (size_t)(tok0_ + c) * NPROJ + C_V + h_ * 128 + v16; nv0 = *(const u32x4*)vs_; nv1 = *(const u32x4*)(vs_ + 8); } while (0)
#define GO_LOAD2(idx_) do { const int bh_ = (idx_) & 15, n_ = (idx_) >> 4, tok0_ = (bh_ >> 2) * SEQ + n_ * 64, h_ = bh_ & 3, su_ = bh_ * 128 + n_; \
        _Pragma("unroll") for (int vt = 0; vt < 4; ++vt) { const int vrow_ = 16 * (4 * vh + vt) + (lane & 15); \
            _Pragma("unroll") for (int ks = 0; ks < 2; ++ks) pv[vt][ks] = *(const bf16x8*)(PREV + ((size_t)su_ * 128 + vrow_) * 64 + 32 * ks + 8 * (lane >> 4)); \
            rr[vt] = *(const u32x2*)(PROJ + (size_t)(tok0_ + 16 * it + (lane & 15)) * NPROJ + C_R + h_ * 128 + 16 * (4 * vh + vt) + 4 * (lane >> 4)); } } while (0)
    if ((int)blockIdx.x < 2048) GO_LOAD((int)blockIdx.x);
    for (int idx = blockIdx.x; idx < 2048; idx += G) {
        const int bh = idx & 15, n = idx >> 4, b = bh >> 2, h = bh & 3, tok0 = b * SEQ + n * 64;
        const f32x4 b0 = nb0, b1 = nb1; const u32x4 qr = nqr, kr = nkr, v0 = nv0, v1 = nv1; bf16x8 pv[4][2]; u32x2 rr[4];
        { const int idn = (idx + G < 2048) ? idx + G : idx; GO_LOAD(idn); }
        GO_LOAD2(idx);
        const float bc[8] = {b0[0], b0[1], b0[2], b0[3], b1[0], b1[1], b1[2], b1[3]};
        {
            u32x4 qo, ko;
#pragma unroll
            for (int i = 0; i < 4; ++i) { const float e0 = __expf(bc[2 * i]), e1 = __expf(bc[2 * i + 1]);
                qo[i] = pk2(bflo(qr[i]) * e0, bfhi(qr[i]) * e1); ko[i] = pk2(bflo(kr[i]) * __builtin_amdgcn_rcpf(e0), bfhi(kr[i]) * __builtin_amdgcn_rcpf(e1)); }
            *(LAS u32x4*)(QS + c * GP + a8) = qo; *(LAS u32x4*)(KS + c * GP + a8) = ko;
            gla_vt_write(VT, v0, v1, lane, wave);
        }
        LDS_BARRIER();
        {
#pragma unroll
            for (int q = 0; q < 2; ++q) { const int jt = 2 * (wave & 1) + q; f32x4 s = (f32x4){0.f, 0.f, 0.f, 0.f};
                if (jt <= it) {
#pragma unroll
                    for (int ks = 0; ks < 2; ++ks) { const bf16x8 av = *(const LAS bf16x8*)(KS + (16 * jt + (lane & 15)) * GP + 32 * ks + 8 * (lane >> 4));
                        const bf16x8 bv = *(const LAS bf16x8*)(QS + (16 * it + (lane & 15)) * GP + 32 * ks + 8 * (lane >> 4)); s = mfma16(av, bv, s); } }
                const int i = 16 * it + (lane & 15), j0 = 16 * jt + 4 * (lane >> 4);
                const float p0 = (j0 <= i) ? s[0] : 0.f, p1 = (j0 + 1 <= i) ? s[1] : 0.f, p2 = (j0 + 2 <= i) ? s[2] : 0.f, p3 = (j0 + 3 <= i) ? s[3] : 0.f;
                *(LAS u32x2*)(PM + i * GP + j0) = (u32x2){pk2(p0, p1), pk2(p2, p3)}; }
        }
        LDS_BARRIER();
        f32x4 acc[4];
#pragma unroll
        for (int vt = 0; vt < 4; ++vt) { acc[vt] = (f32x4){0.f, 0.f, 0.f, 0.f}; const int vrow = 16 * (4 * vh + vt) + (lane & 15), vsw = 4 * (4 * vh + vt);
#pragma unroll
            for (int ks = 0; ks < 2; ++ks) { const bf16x8 av = *(const LAS bf16x8*)(VT + vrow * GP32 + ((16 * ks + 4 * (lane >> 4)) ^ vsw));
                const bf16x8 bv = *(const LAS bf16x8*)(PM + (16 * it + (lane & 15)) * GP + 32 * ks + 8 * (lane >> 4)); acc[vt] = mfma16(av, bv, acc[vt]); }
#pragma unroll
            for (int ks = 0; ks < 2; ++ks) { const bf16x8 bv = *(const LAS bf16x8*)(QS + (16 * it + (lane & 15)) * GP + 32 * ks + 8 * (lane >> 4)); acc[vt] = mfma16(pv[vt][ks], bv, acc[vt]); } }
        float ss = 0.f;
#pragma unroll
        for (int vt = 0; vt < 4; ++vt) ss += (acc[vt][0] * acc[vt][0] + acc[vt][1] * acc[vt][1]) + (acc[vt][2] * acc[vt][2] + acc[vt][3] * acc[vt][3]);
        ss += __shfl_xor(ss, 16); ss += __shfl_xor(ss, 32);
        if (lane < 16) RS[wave * 16 + lane] = ss;
        LDS_BARRIER();
        const float tsum = RS[wave * 16 + (lane & 15)] + RS[(wave ^ 1) * 16 + (lane & 15)];
        const float rstd = __builtin_amdgcn_rsqf(tsum * (1.0f / 128.0f) + EPS);
        const size_t trow = (size_t)(tok0 + 16 * it + (lane & 15));
#pragma unroll
        for (int vt = 0; vt < 4; ++vt) { const int v = 16 * (4 * vh + vt) + 4 * (lane >> 4);
            const f32x4 gg = *(const f32x4*)(a.in[I_GGLA] + v);
            const float o0 = acc[vt][0] * rstd * gg[0] * bflo(rr[vt][0]), o1 = acc[vt][1] * rstd * gg[1] * bfhi(rr[vt][0]), o2 = acc[vt][2] * rstd * gg[2] * bflo(rr[vt][1]), o3 = acc[vt][3] * rstd * gg[3] * bfhi(rr[vt][1]);
            *(u32x2*)(MIXA + trow * 1024 + 512 + h * 128 + v) = (u32x2){pk2(o0, o1), pk2(o2, o3)}; }
    }
#undef GO_LOAD
#undef GO_LOAD2
}

constexpr int NP = 1032;
constexpr int P7_NH = 0, P7_NL = 16 * NP * 2, P7_RP = 2 * 16 * NP * 2, P7_ENT = P7_RP + 16384, P7_CNT = P7_ENT + 3 * 2048, P7_BASE = P7_CNT + 128, P7_LG = P7_BASE + 128  ;
__device__ __forceinline__ void p7_router(const Args& a, LAS unsigned char* lds, int G) {
    const int tid = threadIdx.x, lane = tid & 63, wave = __builtin_amdgcn_readfirstlane(tid >> 6);
    const float* x = a.in[I_X]; const float* mods = (const float*)(a.ws + WS_MODS);
    const bf16_t* MIX = (const bf16_t*)(a.ws + WS_MIX); unsigned char* XN2 = a.ws + WS_XN; bf16_t* H1 = (bf16_t*)(a.ws + WS_H1);
    const bf16_t* WH = (const bf16_t*)(a.ws + WS_WR); const bf16_t* WL = WH + 32 * 1024;
    LAS bf16_t* NH = (LAS bf16_t*)(lds + P7_NH); LAS bf16_t* NL = (LAS bf16_t*)(lds + P7_NL); LAS float* RP = (LAS float*)(lds + P7_RP);
    LAS int* ENT_E = (LAS int*)(lds + P7_ENT); LAS int* ENT_POS = ENT_E + 512; LAS float* ENT_P = (LAS float*)(ENT_POS + 512);
    LAS int* CNTL = (LAS int*)(lds + P7_CNT); LAS int* BASEL = (LAS int*)(lds + P7_BASE); LAS float* LG = (LAS float*)(lds + P7_LG);
    unsigned* gcnt = (unsigned*)(a.ws + WS_CTL) + CW_CNT;
    int* tok_e = (int*)(a.ws + WS_TOKE); int* tok_pos = (int*)(a.ws + WS_TOKPOS); float* tok_p = (float*)(a.ws + WS_TOKP); int* slot_tok = (int*)(a.ws + WS_SLOT);
    bf16x8 whi[4][2], wlo[4][2];
#pragma unroll
    for (int ks = 0; ks < 4; ++ks)
#pragma unroll
        for (int nt = 0; nt < 2; ++nt) { const size_t o = (size_t)(16 * nt + (lane & 15)) * 1024 + 128 * wave + 32 * ks + 8 * (lane >> 4);
            whi[ks][nt] = *(const bf16x8*)(WH + o); wlo[ks][nt] = *(const bf16x8*)(WL + o); }
    for (int blk = blockIdx.x; blk < T / 128; blk += G) {
        const int b = (blk * 128) / SEQ;
        if (tid < 32) CNTL[tid] = 0;
        f32x4 G1[4], A2[4], B2[4];
#pragma unroll
        for (int j = 0; j < 4; ++j) { const int k = 4 * lane + 256 * j;
            G1[j] = *(const f32x4*)(mods + b * 6144 + 2048 + k) * *(const f32x4*)(a.in[I_GPOST] + k);
            A2[j] = *(const f32x4*)(a.in[I_GPFFN] + k) * (*(const f32x4*)(mods + b * 6144 + 4096 + k) + 1.0f);
            B2[j] = *(const f32x4*)(mods + b * 6144 + 3072 + k); }
        LDS_BARRIER();
        u32x2 pm_[4]; f32x4 px_[4];
        { const size_t row = (size_t)(blk * 128 + 2 * wave);
#pragma unroll
          for (int j = 0; j < 4; ++j) { pm_[j] = *(const u32x2*)(MIX + row * 1024 + 4 * lane + 256 * j); px_[j] = __builtin_nontemporal_load((const f32x4*)(x + row * 1024 + 4 * lane + 256 * j)); } }
        for (int it = 0; it < 8; ++it) {
            const int r0 = blk * 128 + 16 * it;
#pragma unroll 1
            for (int rr = 0; rr < 2; ++rr) {
                const int r16 = 2 * wave + rr; const size_t row = (size_t)(r0 + r16);
                const int sn = 2 * it + rr + 1, snc = sn < 16 ? sn : 15; const size_t rown = (size_t)(blk * 128 + 16 * (snc >> 1) + 2 * wave + (snc & 1));
                f32x4 mv[4], hv[4]; float ss = 0.f;
#pragma unroll
                for (int j = 0; j < 4; ++j) { const u32x2 mm = pm_[j]; mv[j] = (f32x4){bflo(mm[0]), bfhi(mm[0]), bflo(mm[1]), bfhi(mm[1])};
                    hv[j] = px_[j]; ss += (mv[j][0] * mv[j][0] + mv[j][1] * mv[j][1]) + (mv[j][2] * mv[j][2] + mv[j][3] * mv[j][3]); }
#pragma unroll
                for (int j = 0; j < 4; ++j) { pm_[j] = *(const u32x2*)(MIX + rown * 1024 + 4 * lane + 256 * j); px_[j] = __builtin_nontemporal_load((const f32x4*)(x + rown * 1024 + 4 * lane + 256 * j)); }
                const float rstd1 = __builtin_amdgcn_rsqf(wave_sum(ss) * (1.0f / 1024.0f) + EPS);
                float ss2 = 0.f;
#pragma unroll
                for (int j = 0; j < 4; ++j) { hv[j] = hv[j] + G1[j] * mv[j] * rstd1; __builtin_nontemporal_store((u32x2){pk2(hv[j][0], hv[j][1]), pk2(hv[j][2], hv[j][3])}, (u32x2*)(H1 + row * 1024 + 4 * lane + 256 * j));
                    ss2 += (hv[j][0] * hv[j][0] + hv[j][1] * hv[j][1]) + (hv[j][2] * hv[j][2] + hv[j][3] * hv[j][3]); }
                const float rstd2 = __builtin_amdgcn_rsqf(wave_sum(ss2) * (1.0f / 1024.0f) + EPS);
#pragma unroll
                for (int j = 0; j < 4; ++j) { const f32x4 nv = hv[j] * rstd2 * A2[j] + B2[j];
                    const u32x2 hw = (u32x2){pk2(nv[0], nv[1]), pk2(nv[2], nv[3])};
                    const u32x2 lw = (u32x2){pk2(nv[0] - bflo(hw[0]), nv[1] - bfhi(hw[0])), pk2(nv[2] - bflo(hw[1]), nv[3] - bfhi(hw[1]))};
                    *(unsigned*)(XN2 + row * 1024 + 4 * lane + 256 * j) = pk4_fp8(nv[0], nv[1], nv[2], nv[3]);
                    *(LAS u32x2*)(NH + r16 * NP + 4 * lane + 256 * j) = hw; *(LAS u32x2*)(NL + r16 * NP + 4 * lane + 256 * j) = lw; }
            }
            LDS_BARRIER();
            {
                f32x4 acc[2] = {(f32x4){0.f, 0.f, 0.f, 0.f}, (f32x4){0.f, 0.f, 0.f, 0.f}};
#pragma unroll
                for (int ks = 0; ks < 4; ++ks) { const int o = (lane & 15) * NP + 128 * wave + 32 * ks + 8 * (lane >> 4);
                    const bf16x8 ah = *(const LAS bf16x8*)(NH + o), al = *(const LAS bf16x8*)(NL + o);
#pragma unroll
                    for (int nt = 0; nt < 2; ++nt) { acc[nt] = mfma16(ah, whi[ks][nt], acc[nt]); acc[nt] = mfma16(al, whi[ks][nt], acc[nt]); acc[nt] = mfma16(ah, wlo[ks][nt], acc[nt]); } }
#pragma unroll
                for (int nt = 0; nt < 2; ++nt)
#pragma unroll
                    for (int r = 0; r < 4; ++r) RP[wave * 512 + (4 * (lane >> 4) + r) * 32 + 16 * nt + (lane & 15)] = acc[nt][r];
            }
            LDS_BARRIER();
            {
                const int r16 = tid >> 5, e = tid & 31;
                float lg = a.in[I_BR][e];
#pragma unroll
                for (int w = 0; w < 8; ++w) lg += RP[w * 512 + r16 * 32 + e];
                LG[(16 * it + r16) * 33 + e] = lg;
            }
        }
        LDS_BARRIER();
        if (tid < 128) {
            float lg[32];
#pragma unroll
            for (int e = 0; e < 32; ++e) lg[e] = LG[tid * 33 + e];
            float tv[4]; int ti[4];
#pragma unroll
            for (int k = 0; k < 4; ++k) { float bv = -INFINITY; int bi = 0;
#pragma unroll
                for (int e = 0; e < 32; ++e) { bool ok = lg[e] > bv;
#pragma unroll
                    for (int q = 0; q < k; ++q) ok = ok && (e != ti[q]);
                    bv = ok ? lg[e] : bv; bi = ok ? e : bi; }
                tv[k] = bv; ti[k] = bi; }
            const float e1 = __expf(tv[1] - tv[0]), e2 = __expf(tv[2] - tv[0]), e3 = __expf(tv[3] - tv[0]);
            const float inv = 1.0f / (1.0f + e1 + e2 + e3);
            const float pr[4] = {inv, e1 * inv, e2 * inv, e3 * inv};
#pragma unroll
            for (int k = 0; k < 4; ++k) { const int pos = __hip_atomic_fetch_add(CNTL + ti[k], 1, __ATOMIC_RELAXED, __HIP_MEMORY_SCOPE_WORKGROUP); ENT_E[tid * 4 + k] = ti[k]; ENT_POS[tid * 4 + k] = pos; ENT_P[tid * 4 + k] = pr[k]; }
        }
        LDS_BARRIER();
        if (tid < 32) BASEL[tid] = (int)atomicAdd(gcnt + tid, (unsigned)CNTL[tid]);
        LDS_BARRIER();
        { const int e = ENT_E[tid], pos = BASEL[e] + ENT_POS[tid], token = blk * 128 + (tid >> 2);
            tok_e[(size_t)token * 4 + (tid & 3)] = e; tok_pos[(size_t)token * 4 + (tid & 3)] = pos; tok_p[(size_t)token * 4 + (tid & 3)] = ENT_P[tid];
            slot_tok[(size_t)e * T + pos] = token; }
        LDS_BARRIER();
    }
}

__device__ __forceinline__ int moe_tables(const Args& a, LAS unsigned char* lds) {
    LAS int* tp = (LAS int*)(lds + TP_OFF); LAS int* cn = tp + 40; LAS unsigned char* te = (LAS unsigned char*)(lds + TE_OFF);
    const unsigned* gcnt = (const unsigned*)(a.ws + WS_CTL) + CW_CNT;
    if (threadIdx.x == 0) { int s = 0; for (int e = 0; e < NE; ++e) { const int c = (int)gcnt[e]; tp[e] = s; cn[e] = c; s += (c + 255) >> 8; } tp[NE] = s; }
    __syncthreads();
    const int nM = tp[NE];
    for (int e = threadIdx.x >> 4; e < NE; e += 32) for (int p = tp[e] + (threadIdx.x & 15); p < tp[e + 1]; p += 16) te[p] = (unsigned char)e;
    __syncthreads();
    return nM;
}

__device__ __forceinline__ void p10_final(const Args& a, LAS unsigned char* lds, int G) {
    const int tid = threadIdx.x, lane = tid & 63, wave = __builtin_amdgcn_readfirstlane(tid >> 6);
    (void)moe_tables(a, lds);
    const LAS int* tp = (const LAS int*)(lds + TP_OFF);
    const float* mods = (const float*)(a.ws + WS_MODS); const unsigned char* OUT8 = a.ws + WS_OUT8; float* out = a.out; const bf16_t* H1 = (const bf16_t*)(a.ws + WS_H1);
    const int* tok_e = (const int*)(a.ws + WS_TOKE); const int* tok_pos = (const int*)(a.ws + WS_TOKPOS); const float* tok_p = (const float*)(a.ws + WS_TOKP);
    for (int rg = blockIdx.x * 8 + wave; rg < T / 16; rg += G * 8) {
        const int b = (rg * 16) / SEQ;
        f32x4 G2[4];
#pragma unroll
        for (int j = 0; j < 4; ++j) { const int k = 4 * lane + 256 * j; G2[j] = *(const f32x4*)(mods + b * 6144 + 5120 + k) * *(const f32x4*)(a.in[I_GPOSTF] + k); }
        const size_t mb = (size_t)rg * 64 + lane;
        const int me = tok_e[mb], mslot = tp[me] * 256 + tok_pos[mb]; const float mpr = tok_p[mb] * (1.0f / OSCALE);
        constexpr int P10D = 2;
        int nw[P10D][4][4]; u32x2 nh[P10D][4];
#define P10_LOADROW(d_, i_) do { const size_t m_ = (size_t)rg * 16 + (i_); \
            _Pragma("unroll") for (int k = 0; k < 4; ++k) { const size_t slot = (size_t)__builtin_amdgcn_readlane(mslot, 4 * (i_) + k); \
                _Pragma("unroll") for (int j = 0; j < 4; ++j) nw[d_][k][j] = *(const int*)(OUT8 + slot * 1024 + 4 * lane + 256 * j); } \
            _Pragma("unroll") for (int j = 0; j < 4; ++j) nh[d_][j] = __builtin_nontemporal_load((const u32x2*)(H1 + m_ * 1024 + 4 * lane + 256 * j)); } while (0)
#pragma unroll
        for (int d = 0; d < P10D; ++d) P10_LOADROW(d, d);
        for (int i0 = 0; i0 < 16; i0 += P10D) {
#pragma unroll
          for (int d = 0; d < P10D; ++d) {
            const int i = i0 + d; const size_t m = (size_t)rg * 16 + i;
            int cw[4][4]; u32x2 ch[4];
#pragma unroll
            for (int k = 0; k < 4; ++k)
#pragma unroll
                for (int j = 0; j < 4; ++j) cw[k][j] = nw[d][k][j];
#pragma unroll
            for (int j = 0; j < 4; ++j) ch[j] = nh[d][j];
            const int in_ = i + P10D < 16 ? i + P10D : 15;
            P10_LOADROW(d, in_);
            f32x4 f[4];
#pragma unroll
            for (int j = 0; j < 4; ++j) f[j] = (f32x4){0.f, 0.f, 0.f, 0.f};
#pragma unroll
            for (int k = 0; k < 4; ++k) {
                const float pk = __builtin_bit_cast(float, __builtin_amdgcn_readlane(__builtin_bit_cast(int, mpr), 4 * i + k));
#pragma unroll
                for (int j = 0; j < 4; ++j) { const int w = cw[k][j];
                    const f32x2 lo = __builtin_amdgcn_cvt_pk_f32_fp8(w, false), hi = __builtin_amdgcn_cvt_pk_f32_fp8(w, true);
                    f[j] += (f32x4){lo[0], lo[1], hi[0], hi[1]} * pk; }
            }
            float ss = 0.f;
#pragma unroll
            for (int j = 0; j < 4; ++j) ss += (f[j][0] * f[j][0] + f[j][1] * f[j][1]) + (f[j][2] * f[j][2] + f[j][3] * f[j][3]);
            const float rstd = __builtin_amdgcn_rsqf(wave_sum(ss) * (1.0f / 1024.0f) + EPS);
#pragma unroll
            for (int j = 0; j < 4; ++j) __builtin_nontemporal_store((f32x4){bflo(ch[j][0]), bfhi(ch[j][0]), bflo(ch[j][1]), bfhi(ch[j][1])} + G2[j] * f[j] * rstd, (f32x4*)(out + m * 1024 + 4 * lane + 256 * j));
          }
        }
#undef P10_LOADROW
    }
}

constexpr int N_PHASES = 11;
__global__ void __launch_bounds__(512, 2) mk_fwd(Args args) {
    extern __shared__ __attribute__((aligned(16))) unsigned char lds_raw[];
    LAS unsigned char* lds = (LAS unsigned char*)lds_raw;
    volatile LAS unsigned* MISC = (volatile LAS unsigned*)(lds + MISC_OFF);
    const int tid = threadIdx.x, G = gridDim.x;
    if (tid < 64) MISC[tid] = 0u;
    __syncthreads();
    unsigned* ctl = (unsigned*)(args.ws + WS_CTL);
    const int lo = args.ph_lo, hi = args.ph_hi;
    XcdBarrier bar; bar.bar = ctl + CW_BAR; bar.x = 0; bar.st = MISC + 8;
    if (hi - lo > 1) bar = xcd_barrier_post(ctl + CW_BAR, MISC + 8);
#define IN(k) (lo <= (k) && (k) < hi)
#define SEAM(k) do { if (IN((k) + 1)) xcd_barrier(bar); } while (0)
    const LAS unsigned short* TOK = (const LAS unsigned short*)(lds + TOK_OFF);
    if (IN(0)) { p0_prologue(args, lds, G); SEAM(0); }
    if (IN(1)) { p1_norm(args, lds, G); SEAM(1); }
    if (IN(2)) {
        pg8::Gemm g{args.ws + WS_XN, args.ws + WS_WIN, 2048}; pg8::StaticOrder S; S.init(T, NPROJ, G, (int)blockIdx.x);
        pg8::EpiProj E{(bf16_t*)(args.ws + WS_PROJ)};
        const int grp = (((int)blockIdx.x >> 3) * 6) >> 5, nun = (S.nwg + G - 1) / G, cut = grp < nun ? grp : nun;
        if (cut > 0) { S.base = 0; S.lim = cut; pg8::gemm_phase<pg8::EpiProj, pg8::StaticOrder, true, false, false>(lds, g, S, E, TOK); }
        __syncthreads(); moe_convert(args, lds, G, 0, MOE_ITEMS); __syncthreads();
        if (cut < nun) { S.base = cut; S.lim = nun - cut; pg8::gemm_phase<pg8::EpiProj, pg8::StaticOrder, true, false, false>(lds, g, S, E, TOK); }
        SEAM(2);
    }
    if (IN(3)) { p3_sgu(args, lds, G); __syncthreads(); p3_gla_state(args, lds, G); SEAM(3); }
    if (IN(4)) { p4_scan(args, G); SEAM(4); }
    if (IN(5)) { p5_gla_out(args, lds, G); SEAM(5); }
    if (IN(6)) {
        pg8::Gemm g{args.ws + WS_XN, args.ws + WS_WOUT, 2048}; pg8::StaticOrder S; S.init(T, 1024, G, (int)blockIdx.x);
        pg8::EpiPlain E{(bf16_t*)(args.ws + WS_MIX), 1024};
        pg8::gemm_phase<pg8::EpiPlain, pg8::StaticOrder, true, false, false>(lds, g, S, E, TOK);
        SEAM(6);
    }
    if (IN(7)) { p7_router(args, lds, G); SEAM(7); }
    if (IN(8)) {
        const int nM = moe_tables(args, lds);
        pg8::MoeOrder S; S.nM = nM; S.nN = 8; S.nwg = nM * 8; S.G = G; S.c = (int)blockIdx.x;
        S.tp = (const LAS int*)(lds + TP_OFF); S.cnt = S.tp + 40; S.te = (const LAS unsigned char*)(lds + TE_OFF);
        {
            LAS unsigned short* tokw = (LAS unsigned short*)(lds + TOK_OFF); const int* slot_tok = (const int*)(args.ws + WS_SLOT);
            pg8::Unit u;
            for (int i = 0; i < 18 && S.next(i, u); ++i) if (tid < 256) { const int p = u.prow + tid; tokw[i * 256 + tid] = (unsigned short)(p < u.cnt ? slot_tok[(size_t)u.e * T + p] : 0); }
            __syncthreads();
        }
        pg8::Gemm g{args.ws + WS_XN, args.ws + WS_W1, 1024};
        pg8::EpiSwiglu E{args.ws + WS_HDN, args.in[I_BG], args.in[I_BU]};
        pg8::gemm_phase<pg8::EpiSwiglu, pg8::MoeOrder, true, true, true>(lds, g, S, E, TOK);
        SEAM(8);
    }
    if (IN(9)) {
        const int nM = moe_tables(args, lds);
        pg8::MoeOrder S; S.nM = nM; S.nN = 4; S.nwg = nM * 4; S.G = G; S.c = (int)blockIdx.x;
        S.tp = (const LAS int*)(lds + TP_OFF); S.cnt = S.tp + 40; S.te = (const LAS unsigned char*)(lds + TE_OFF);
        pg8::Gemm g{args.ws + WS_HDN, args.ws + WS_WD, 1024};
        pg8::EpiOut8 E{args.ws + WS_OUT8, args.in[I_BDN]};
        pg8::gemm_phase<pg8::EpiOut8, pg8::MoeOrder, true, false, true>(lds, g, S, E, TOK);
        SEAM(9);
    }
    if (IN(10)) { p10_final(args, lds, G); }
#undef IN
#undef SEAM
}

#ifndef MK_SPLIT
#define MK_SPLIT 0
#endif
extern "C" void kernel_launch(void* const* d_in, const int* in_sizes, int n_in, void* d_out, int out_size, void* d_ws, size_t ws_size, hipStream_t stream) {
    static int grid = 0;
    if (grid == 0) {
        if (n_in != 24 || out_size != T * D || ws_size < WS_END) { fprintf(stderr, "kernel_launch: unexpected problem (n_in %d, out %d, ws %zu)\n", n_in, out_size, ws_size); grid = -1; return; }
        int dev = 0, cus = 0, per_cu = 0;
        if (hipGetDevice(&dev) != hipSuccess || hipDeviceGetAttribute(&cus, hipDeviceAttributeMultiprocessorCount, dev) != hipSuccess) { grid = -1; return; }
        if (hipFuncSetAttribute((const void*)mk_fwd, hipFuncAttributeMaxDynamicSharedMemorySize, LDS_BYTES) != hipSuccess) { grid = -1; return; }
        if (hipOccupancyMaxActiveBlocksPerMultiprocessor(&per_cu, (const void*)mk_fwd, 512, LDS_BYTES) != hipSuccess || per_cu < 1) { fprintf(stderr, "kernel_launch: occupancy query says %d\n", per_cu); (void)hipGetLastError(); grid = -1; return; }
        grid = cus;
    }
    if (grid < 0) return;
    (void)hipMemsetAsync((char*)d_ws + WS_CTL, 0, CTL_ZERO_BYTES, stream);
    Args a{};
    for (int i = 0; i < 24; ++i) a.in[i] = (const float*)d_in[i];
    a.out = (float*)d_out; a.ws = (unsigned char*)d_ws;
#if MK_SPLIT
    for (int p = 0; p < N_PHASES; ++p) { a.ph_lo = p; a.ph_hi = p + 1; hipLaunchKernelGGL(mk_fwd, dim3(grid), dim3(512), LDS_BYTES, stream, a); }
#else
    a.ph_lo = 0; a.ph_hi = N_PHASES;
    hipLaunchKernelGGL(mk_fwd, dim3(grid), dim3(512), LDS_BYTES, stream, a);
#endif
}
```

```cpp
#include <hip/hip_runtime.h>
#include <cstdio>
#include <cstdint>

#define LAS __attribute__((address_space(3)))
typedef unsigned short bf16_t;
typedef short bf16x8 __attribute__((ext_vector_type(8)));
typedef float f32x4 __attribute__((ext_vector_type(4)));
typedef float f32x2 __attribute__((ext_vector_type(2)));
typedef unsigned u32x4 __attribute__((ext_vector_type(4)));
typedef unsigned u32x2 __attribute__((ext_vector_type(2)));

constexpr int T = 32768, D = 1024, SEQ = 8192;
constexpr int D_IN = 2576, NPROJ = 2560;
constexpr int NE = 32;
constexpr float EPS = 1e-6f;
constexpr int C_US = 0, C_VS = 512, C_Q = 1024, C_K = 1280, C_V = 1536, C_R = 2048, C_GL = 2560;
constexpr float OSCALE = 8.0f;
constexpr float W8_SCALE = 32.0f;
#define W8_SCALE_E8M0 0x7A7A7A7A

constexpr size_t MiB = 1u << 20;
constexpr size_t WS_CTL = 0, CTL_ZERO_BYTES = 1 * MiB;
constexpr int CW_TMO = 0, CW_CNT = 1024, CW_BAR = 4096;
constexpr size_t WS_MODS = 256 * 1024;
constexpr size_t WS_GLOW = 2 * MiB;
constexpr size_t WS_TOKE = 4 * MiB, WS_TOKPOS = WS_TOKE + 512 * 1024, WS_TOKP = WS_TOKE + 1024 * 1024;
constexpr size_t WS_DEC = 5 * MiB + 512 * 1024;
constexpr size_t WS_SLOT = 6 * MiB;
constexpr size_t WS_WR = 10 * MiB;
constexpr size_t WS_WIN = 11 * MiB;
constexpr size_t WS_WOUT = 16 * MiB;
constexpr size_t WS_WD = 18 * MiB;
constexpr size_t WS_W1 = 50 * MiB;
constexpr size_t WS_XN = 114 * MiB;
constexpr size_t WS_PROJ = 178 * MiB;
constexpr size_t WS_ST = 338 * MiB;
constexpr size_t WS_PREV = 402 * MiB;
constexpr size_t WS_MIX = 178 * MiB;
constexpr size_t WS_HDN = 178 * MiB;
constexpr size_t WS_OUT8 = 338 * MiB;
constexpr size_t WS_BCUM = 434 * MiB;
constexpr size_t WS_H1 = 474 * MiB;
constexpr size_t WS_END = 538 * MiB;
constexpr int MAX_TILES = 543;

constexpr int RING_BYTES = 131072;
constexpr int MISC_OFF = RING_BYTES;
constexpr int TP_OFF = MISC_OFF + 256;
constexpr int TE_OFF = TP_OFF + 512;
constexpr int TOK_OFF = TE_OFF + 1024;
constexpr int BIAS_OFF = TOK_OFF + 18 * 512;
constexpr int LDS_BYTES = 147456;
static_assert(BIAS_OFF + 2048 <= LDS_BYTES && BIAS_OFF % 16 == 0, "LDS map");

__device__ __forceinline__ unsigned f2bf(float f) { unsigned u = __builtin_bit_cast(unsigned, f); return (u + 0x7fffu + ((u >> 16) & 1u)) >> 16; }
__device__ __forceinline__ float bf2f(unsigned h) { return __builtin_bit_cast(float, h << 16); }
__device__ __forceinline__ float bflo(unsigned w) { return __builtin_bit_cast(float, w << 16); }
__device__ __forceinline__ float bfhi(unsigned w) { return __builtin_bit_cast(float, w & 0xffff0000u); }
typedef __bf16 bf16x2_t __attribute__((ext_vector_type(2)));
__device__ __forceinline__ unsigned pk2(float lo, float hi) { const f32x2 v = {lo, hi}; return __builtin_bit_cast(unsigned, __builtin_convertvector(v, bf16x2_t)); }
__device__ __forceinline__ unsigned pk4_fp8(float a, float b, float c, float d) {
    int w = __builtin_amdgcn_cvt_pk_fp8_f32(a, b, 0, false); w = __builtin_amdgcn_cvt_pk_fp8_f32(c, d, w, true); return (unsigned)w; }
__device__ __forceinline__ float clamp448(float v) { return fminf(fmaxf(v, -448.0f), 448.0f); }
#define LDS_BARRIER() do { asm volatile("s_waitcnt lgkmcnt(0)" ::: "memory"); __builtin_amdgcn_s_barrier(); asm volatile("" ::: "memory"); } while (0)
__device__ __forceinline__ float wave_sum(float v) {
#pragma unroll
    for (int o = 1; o < 64; o <<= 1) v += __shfl_xor(v, o);
    return v;
}
__device__ __forceinline__ f32x4 mfma16(bf16x8 a, bf16x8 b, f32x4 c) { return __builtin_amdgcn_mfma_f32_16x16x32_bf16(a, b, c, 0, 0, 0); }
__device__ __forceinline__ float sigmoidf_(float x) { return __builtin_amdgcn_rcpf(1.0f + __builtin_amdgcn_exp2f(-1.4426950408889634f * x)); }
__device__ __forceinline__ float gelu_tanh(float x) { const float u = x + 0.044715f * x * x * x; return x * __builtin_amdgcn_rcpf(1.0f + __builtin_amdgcn_exp2f(-2.302208198f * u)); }
__device__ __forceinline__ float silu_(float x) { return x * sigmoidf_(x); }
__device__ __forceinline__ f32x2 rcp2(f32x2 v) { return (f32x2){__builtin_amdgcn_rcpf(v[0]), __builtin_amdgcn_rcpf(v[1])}; }
__device__ __forceinline__ f32x2 exp2_2(f32x2 v) { return (f32x2){__builtin_amdgcn_exp2f(v[0]), __builtin_amdgcn_exp2f(v[1])}; }
__device__ __forceinline__ f32x2 clamp2(f32x2 v, float lo, float hi) { return (f32x2){__builtin_amdgcn_fmed3f(v[0], lo, hi), __builtin_amdgcn_fmed3f(v[1], lo, hi)}; }
__device__ __forceinline__ f32x2 gelu_tanh2(f32x2 x) { const f32x2 u = x + (x * x) * (x * 0.044715f); return x * rcp2(exp2_2(u * -2.302208198f) + 1.0f); }
__device__ __forceinline__ f32x2 silu2(f32x2 x) { return x * rcp2(exp2_2(x * -1.4426950408889634f) + 1.0f); }

#define XB_TMO      128
#define XB_XCNT(j)  (256  + 64 * (j))
#define XB_XSUB(j)  (1280 + 64 * (j))
#define XB_XGEN(j)  (2304 + 64 * (j))
#define XB_TOP      3328
#define XB_TOPGEN   3392
#define XCD_BAR_WORDS 3456
#define XB_SPIN_CAP (1u << 20)
__device__ __forceinline__ unsigned xb_ld(unsigned* p)              { return __hip_atomic_load(p, __ATOMIC_RELAXED, __HIP_MEMORY_SCOPE_AGENT); }
__device__ __forceinline__ unsigned xb_add(unsigned* p, unsigned v) { return __hip_atomic_fetch_add(p, v, __ATOMIC_RELAXED, __HIP_MEMORY_SCOPE_AGENT); }
__device__ __forceinline__ unsigned xb_xcc_id() { return (unsigned)__builtin_amdgcn_s_getreg((3 << 11) | 20) & 0xFu; }
#define XB_SPIN(cond, bar) do { unsigned _sp = 0; while (cond) { __builtin_amdgcn_s_sleep(1); \
    if ((++_sp & 255u) == 0u) { if (xb_ld(&(bar)[XB_TMO])) break; if (_sp > XB_SPIN_CAP) { atomicAdd(&(bar)[XB_TMO], 1u); break; } } } } while (0)
struct XcdBarrier { unsigned* bar; unsigned x; volatile LAS unsigned* st; };
__device__ __forceinline__ XcdBarrier xcd_barrier_post(unsigned* bar, volatile LAS unsigned* st) {
    XcdBarrier b; b.bar = bar; b.x = xb_xcc_id(); b.st = st;
    if (threadIdx.x == 0) (void)xb_add(&bar[XB_XCNT(b.x)], 1u);
    return b;
}
__device__ __forceinline__ void xcd_barrier_complete(unsigned* bar, unsigned x, unsigned& nloc, unsigned& nx) {
    const unsigned G = gridDim.x * gridDim.y * gridDim.z;
    unsigned sum, cnt, mine, sp = 0u;
    for (;;) {
        sum = 0u; cnt = 0u; mine = 0u;
#pragma unroll
        for (unsigned j = 0; j < 16; ++j) { const unsigned c = xb_ld(&bar[XB_XCNT(j)]); sum += c; cnt += (c > 0u) ? 1u : 0u; mine = (j == x) ? c : mine; }
        if (sum == G) break;
        __builtin_amdgcn_s_sleep(1);
        if ((++sp & 255u) == 0u) { if (xb_ld(&bar[XB_TMO])) break; if (sp > XB_SPIN_CAP) { atomicAdd(&bar[XB_TMO], 1u); break; } }
    }
    nloc = mine > 0u ? mine : 1u; nx = cnt > 0u ? cnt : 1u;
}
__device__ __forceinline__ void xcd_barrier(const XcdBarrier& b) {
    asm volatile("s_waitcnt vmcnt(0)" ::: "memory");
    __syncthreads();
    if (threadIdx.x == 0) {
        unsigned* bar = b.bar;
        __builtin_amdgcn_s_waitcnt(0);
        unsigned nloc = b.st[0], nx = b.st[1];
        if (nloc == 0u) { xcd_barrier_complete(bar, b.x, nloc, nx); b.st[0] = nloc; b.st[1] = nx; }
        const unsigned old = xb_add(&bar[XB_XSUB(b.x)], 1u);
        const unsigned gen = old / nloc;
        if (old + 1u == (gen + 1u) * nloc) {
            __builtin_amdgcn_fence(__ATOMIC_RELEASE, "agent");
            asm volatile("s_waitcnt vmcnt(0)" ::: "memory");
            const unsigned og = xb_add(&bar[XB_TOP], 1u);
            const unsigned tg = og / nx;
            if (og + 1u == (tg + 1u) * nx) xb_add(&bar[XB_TOPGEN], 1u);
            else XB_SPIN(xb_ld(&bar[XB_TOPGEN]) == tg, bar);
            __builtin_amdgcn_fence(__ATOMIC_ACQUIRE, "agent");
            xb_add(&bar[XB_XGEN(b.x)], 1u);
            asm volatile("s_waitcnt vmcnt(0)" ::: "memory");
        } else {
            XB_SPIN(xb_ld(&bar[XB_XGEN(b.x)]) == gen, bar);
            __builtin_amdgcn_fence(__ATOMIC_ACQUIRE, "agent");
            asm volatile("s_waitcnt vmcnt(0)" ::: "memory");
        }
    }
    __syncthreads();
}

namespace pg8 {
constexpr int BM = 256, BK = 64, HALF = 128, HTB = HALF * BK * 2, STAGE_BYTES = 8 * HTB, NXCD = 8, WGM = 8;
template <int SH> __host__ __device__ __forceinline__ int lds_byte(int r, int cb) { const int st = (r >> 4) * 2 + (cb >> 6), rr = r & 15, ob = rr * 64 + (cb & 63); return st * 1024 + (ob ^ (((ob >> 9) & 1) << SH)); }
template <int SH> __host__ __device__ __forceinline__ void stage_rc(int b, int& R, int& CB) { const int st = b / 1024, sb = b % 1024, swz = sb ^ (((sb >> 9) & 1) << SH); R = (st >> 1) * 16 + swz / 64; CB = (st & 1) * 64 + (swz % 64); }
__host__ __device__ __forceinline__ int perm32(int rho) { const int n = rho >> 4, i = rho & 15; return 8 * (i >> 2) + 4 * n + (i & 3); }

struct Unit { int pm, pn, bt, e, prow, cnt, half; };
struct Gemm { const void* A; const void* Bt; int Kb; };

__device__ __forceinline__ void tile_of(int L, int nM, int nN, int nwg, int& pm, int& pn) {
    int wgid = L; { const int q = nwg / NXCD, r = nwg % NXCD, xcd = wgid % NXCD, off = wgid / NXCD; wgid = (xcd < r ? xcd * (q + 1) : r * (q + 1) + (xcd - r) * q) + off; }
    const int nig = WGM * nN, gid = wgid / nig, fm = gid * WGM, gsz = (nM - fm) < WGM ? (nM - fm) : WGM;
    pm = fm + ((wgid % nig) % gsz); pn = (wgid % nig) / gsz;
}
struct StaticOrder {
    int nM, nN, nwg, G, c, base, lim;
    __device__ void init(int M, int N, int G_, int c_) { nM = M / BM; nN = N / BM; nwg = nM * nN; G = G_; c = c_; base = 0; lim = 1 << 30; }
    __device__ __forceinline__ bool next(int i, Unit& u) const {
        if (i >= lim) return false;
        const long L = (long)(i + base) * G + c; if (L >= nwg) return false;
        tile_of((int)L, nM, nN, nwg, u.pm, u.pn); u.bt = u.pn; u.e = 0; u.prow = 0; u.cnt = 0; u.half = -1; return true;
    }
};
struct MoeOrder {
    int nM, nN, nwg, G, c; const LAS int* tp; const LAS unsigned char* te; const LAS int* cnt;
    __device__ __forceinline__ bool next(int i, Unit& u) const {
        const int Rf = nwg / G, Lo = nwg - Rf * G; const bool split = (Lo > 0) && (2 * Lo <= G);
        long L; u.half = -1;
        if (i < Rf) L = (long)i * G + c;
        else if (i == Rf && !split) { if (c >= Lo) return false; L = (long)Rf * G + c; }
        else if (i == Rf) { if (c >= 2 * Lo) return false; L = (long)Rf * G + (c >> 1); u.half = c & 1; }
        else return false;
        tile_of((int)L, nM, nN, nwg, u.pm, u.pn);
        const int e = __builtin_amdgcn_readfirstlane((int)te[u.pm]);
        u.e = e; u.bt = e * nN + u.pn; u.prow = (u.pm - __builtin_amdgcn_readfirstlane(tp[e])) * BM; u.cnt = __builtin_amdgcn_readfirstlane(cnt[e]); return true;
    }
};

struct EpiProj {
    static constexpr bool PERM = true, HAS_BIAS = false;
    __device__ __forceinline__ const float* bias_src(const Unit&, int) const { return nullptr; }
    bf16_t* O;
    __device__ __forceinline__ void operator()(const f32x4 (&acc)[2][2][4][2], const Unit& u, int wr, int wc, int fr, int fq, const LAS float*) const {
        const int row0 = u.pm * BM + wr * 64 + fr, col0 = u.pn * BM + wc * 32 + 8 * fq;
        const int mode = (u.pn < 4) ? 1 : (u.pn >= 8 ? 2 : (u.pn == 4 ? 3 : 0));
#pragma unroll
        for (int ai = 0; ai < 2; ++ai)
#pragma unroll
            for (int m = 0; m < 4; ++m) { bf16_t* rowp = O + (size_t)(row0 + ai * HALF + m * 16) * NPROJ + col0;
#pragma unroll
                for (int bj = 0; bj < 2; ++bj) { f32x2 v[4];
#pragma unroll
                    for (int n = 0; n < 2; ++n) { v[2 * n] = (f32x2){acc[ai][bj][m][n][0], acc[ai][bj][m][n][1]}; v[2 * n + 1] = (f32x2){acc[ai][bj][m][n][2], acc[ai][bj][m][n][3]}; }
                    if (mode == 1) {
#pragma unroll
                        for (int i = 0; i < 4; ++i) v[i] = gelu_tanh2(v[i]);
                    } else if (mode == 2) {
#pragma unroll
                        for (int i = 0; i < 4; ++i) v[i] = silu2(v[i]);
                    } else if (mode == 3) {
#pragma unroll
                        for (int i = 0; i < 4; ++i) v[i] = v[i] * 0.125f;
                    }
                    u32x4 w; w.x = pk2(v[0][0], v[0][1]); w.y = pk2(v[1][0], v[1][1]); w.z = pk2(v[2][0], v[2][1]); w.w = pk2(v[3][0], v[3][1]);
                    *(u32x4*)(rowp + bj * HALF) = w; } }
    }
};
struct EpiPlain {
    static constexpr bool PERM = true, HAS_BIAS = false;
    __device__ __forceinline__ const float* bias_src(const Unit&, int) const { return nullptr; }
    bf16_t* O; int ldc;
    __device__ __forceinline__ void operator()(const f32x4 (&acc)[2][2][4][2], const Unit& u, int wr, int wc, int fr, int fq, const LAS float*) const {
        const int row0 = u.pm * BM + wr * 64 + fr, col0 = u.pn * BM + wc * 32 + 8 * fq;
#pragma unroll
        for (int ai = 0; ai < 2; ++ai)
#pragma unroll
            for (int m = 0; m < 4; ++m) { bf16_t* rowp = O + (size_t)(row0 + ai * HALF + m * 16) * ldc + col0;
#pragma unroll
                for (int bj = 0; bj < 2; ++bj) { const f32x4 v0 = acc[ai][bj][m][0], v1 = acc[ai][bj][m][1];
                    u32x4 w; w.x = pk2(v0[0], v0[1]); w.y = pk2(v0[2], v0[3]); w.z = pk2(v1[0], v1[1]); w.w = pk2(v1[2], v1[3]);
                    *(u32x4*)(rowp + bj * HALF) = w; } }
    }
};
struct EpiSwiglu {
    static constexpr bool PERM = true, HAS_BIAS = true;
    unsigned char* H; const float* bg; const float* bu;
    __device__ __forceinline__ const float* bias_src(const Unit& u, int j) const { return (j < 128 ? bg : bu) + (size_t)u.e * 1024 + u.pn * HALF + (j & 127); }
    __device__ __forceinline__ void operator()(const f32x4 (&acc)[2][2][4][2], const Unit& u, int wr, int wc, int fr, int fq, const LAS float* btab) const {
        const int row0 = u.pm * BM + (u.half > 0 ? HALF : 0) + wr * 64 + fr, hc0 = u.pn * HALF + wc * 32 + 8 * fq;
        f32x4 bgv[2], buv[2];
#pragma unroll
        for (int n = 0; n < 2; ++n) { bgv[n] = *(const LAS f32x4*)(btab + wc * 32 + 8 * fq + 4 * n); buv[n] = *(const LAS f32x4*)(btab + 128 + wc * 32 + 8 * fq + 4 * n); }
#pragma unroll
        for (int ai = 0; ai < 2; ++ai) if (ai == 0 || u.half < 0)
#pragma unroll
            for (int m = 0; m < 4; ++m) { f32x2 h[4];
#pragma unroll
                for (int n = 0; n < 2; ++n)
#pragma unroll
                    for (int q = 0; q < 2; ++q) {
                        f32x2 g = (f32x2){acc[ai][0][m][n][2 * q], acc[ai][0][m][n][2 * q + 1]} + (f32x2){bgv[n][2 * q], bgv[n][2 * q + 1]};
                        g = (f32x2){fminf(g[0], 7.0f), fminf(g[1], 7.0f)};
                        const f32x2 uu = clamp2((f32x2){acc[ai][1][m][n][2 * q], acc[ai][1][m][n][2 * q + 1]} + (f32x2){buv[n][2 * q], buv[n][2 * q + 1]}, -7.0f, 7.0f);
                        h[2 * n + q] = ((uu + 1.0f) * g) * rcp2(exp2_2(g * (-1.702f * 1.4426950408889634f)) + 1.0f); }
                *(u32x2*)(H + (size_t)(row0 + ai * HALF + m * 16) * 1024 + hc0) = (u32x2){pk4_fp8(h[0][0], h[0][1], h[1][0], h[1][1]), pk4_fp8(h[2][0], h[2][1], h[3][0], h[3][1])}; }
    }
};
struct EpiOut8 {
    static constexpr bool PERM = true, HAS_BIAS = true;
    unsigned char* O; const float* bd;
    __device__ __forceinline__ const float* bias_src(const Unit& u, int j) const { return bd + (size_t)u.e * 1024 + u.pn * BM + j; }
    __device__ __forceinline__ void operator()(const f32x4 (&acc)[2][2][4][2], const Unit& u, int wr, int wc, int fr, int fq, const LAS float* btab) const {
        const int row0 = u.pm * BM + (u.half > 0 ? HALF : 0) + wr * 64 + fr, col0 = u.pn * BM + wc * 32 + 8 * fq;
        f32x4 bv[2][2];
#pragma unroll
        for (int bj = 0; bj < 2; ++bj)
#pragma unroll
            for (int n = 0; n < 2; ++n) bv[bj][n] = *(const LAS f32x4*)(btab + bj * HALF + wc * 32 + 8 * fq + 4 * n);
#pragma unroll
        for (int ai = 0; ai < 2; ++ai) if (ai == 0 || u.half < 0)
#pragma unroll
            for (int m = 0; m < 4; ++m) { unsigned char* rowp = O + (size_t)(row0 + ai * HALF + m * 16) * 1024 + col0;
#pragma unroll
                for (int bj = 0; bj < 2; ++bj) { f32x2 v[4];
#pragma unroll
                    for (int n = 0; n < 2; ++n)
#pragma unroll
                        for (int q = 0; q < 2; ++q) v[2 * n + q] = clamp2(((f32x2){acc[ai][bj][m][n][2 * q], acc[ai][bj][m][n][2 * q + 1]} + (f32x2){bv[bj][n][2 * q], bv[bj][n][2 * q + 1]}) * OSCALE, -440.0f, 440.0f);
                    *(u32x2*)(rowp + bj * HALF) = (u32x2){pk4_fp8(v[0][0], v[0][1], v[1][0], v[1][1]), pk4_fp8(v[2][0], v[2][1], v[3][0], v[3][1])}; } }
    }
};

typedef int i32x4 __attribute__((ext_vector_type(4)));
typedef int i32x8 __attribute__((ext_vector_type(8)));
template <bool FP8> struct Frag;
template <> struct Frag<false> { bf16x8 k0, k1; __device__ __forceinline__ void ld(const LAS unsigned char* p0, const LAS unsigned char* p1) { k0 = *(const LAS bf16x8*)p0; k1 = *(const LAS bf16x8*)p1; } };
template <> struct Frag<true> { i32x8 v; __device__ __forceinline__ void ld(const LAS unsigned char* p0, const LAS unsigned char* p1) { v = __builtin_shufflevector(*(const LAS i32x4*)p0, *(const LAS i32x4*)p1, 0, 1, 2, 3, 4, 5, 6, 7); } };
__device__ __forceinline__ f32x4 frag_mma(const Frag<false>& b, const Frag<false>& a, f32x4 c) { c = __builtin_amdgcn_mfma_f32_16x16x32_bf16(b.k0, a.k0, c, 0, 0, 0); return __builtin_amdgcn_mfma_f32_16x16x32_bf16(b.k1, a.k1, c, 0, 0, 0); }
__device__ __forceinline__ f32x4 frag_mma(const Frag<true>& b, const Frag<true>& a, f32x4 c, int sw, int s1) {
    asm volatile("s_nop 1\n\tv_mfma_scale_f32_16x16x128_f8f6f4 %0, %1, %2, %0, %3, %4 op_sel_hi:[0,0,0]" : "+v"(c) : "v"(b.v), "v"(a.v), "v"(sw), "v"(s1)); return c; }
__device__ __forceinline__ f32x4 frag_mma(const Frag<false>& b, const Frag<false>& a, f32x4 c, int, int) { return frag_mma(b, a, c); }
template <class Epi, class Sched, bool ALIGN_EPI, bool GATHER, bool FP8>
__device__ __forceinline__ void gemm_phase(LAS unsigned char* lds, const Gemm g, const Sched& S, const Epi& E, const LAS unsigned short* tok) {
    const int tid = threadIdx.x, wid = __builtin_amdgcn_readfirstlane(tid >> 6), lane = tid & 63, wr = wid >> 2, wc = wid & 3, fr = lane & 15, fq = lane >> 4;
    constexpr int SH = FP8 ? 4 : 5;
    const int K = g.Kb, nt = K / 128;
    unsigned voffB[2]; unsigned va[2][2], vn[2][2]; int RA[2], CA[2];
#pragma unroll
    for (int i = 0; i < 2; ++i) { int R, C; stage_rc<SH>(tid * 16 + i * 8192, R, C); const int Rb = Epi::PERM ? ((R & ~31) + perm32(R & 31)) : R;
        RA[i] = R; CA[i] = C; voffB[i] = (unsigned)(Rb * K + C);
#pragma unroll
        for (int h = 0; h < 2; ++h) { va[h][i] = (unsigned)((R + h * HALF) * K + C); vn[h][i] = va[h][i]; } }
    unsigned vplain[2][2];
#pragma unroll
    for (int h = 0; h < 2; ++h)
#pragma unroll
        for (int i = 0; i < 2; ++i) vplain[h][i] = va[h][i];
    const size_t kstep = 128;
    const size_t hstep = (size_t)HALF * K;
    const size_t tstep = 2 * hstep;
    const unsigned ldsw = (unsigned)wid * 1024u;
    const int aoff0 = FP8 ? lds_byte<SH>(wr * 64 + fr, fq * 32) : lds_byte<SH>(wr * 64 + fr, fq * 16), aoff1 = FP8 ? lds_byte<SH>(wr * 64 + fr, fq * 32 + 16) : aoff0 + 1024;
    const int boff0 = FP8 ? lds_byte<SH>(wc * 32 + fr, fq * 32) : lds_byte<SH>(wc * 32 + fr, fq * 16), boff1 = FP8 ? lds_byte<SH>(wc * 32 + fr, fq * 32 + 16) : boff0 + 1024;
#define PG8_SA(b, h) (((b) * 2 + (h)) * HTB)
#define PG8_SB(b, h) ((4 + (b) * 2 + (h)) * HTB)
#define PG8_STAGE(bufoff, gbase, voff) do { _Pragma("unroll") for (int _i = 0; _i < 2; ++_i) \
        __builtin_amdgcn_global_load_lds((const unsigned*)((const char*)(gbase) + (voff)[_i]), (LAS unsigned*)(lds + (bufoff) + ldsw + _i * 8192), 16, 0, 0); } while (0)
#define PG8_LDA(dst, b, h) do { _Pragma("unroll") for (int m = 0; m < 4; ++m) dst[m].ld(lds + PG8_SA(b, h) + aoff0 + m * 2048, lds + PG8_SA(b, h) + aoff1 + m * 2048); } while (0)
#define PG8_LDB(dst, b, h) do { _Pragma("unroll") for (int n = 0; n < 2; ++n) dst[n].ld(lds + PG8_SB(b, h) + boff0 + n * 2048, lds + PG8_SB(b, h) + boff1 + n * 2048); } while (0)
#define PG8_MMA(ai, bj, At, Bt) do { __builtin_amdgcn_s_setprio(1); _Pragma("unroll") for (int m = 0; m < 4; ++m) _Pragma("unroll") for (int n = 0; n < 2; ++n) \
        acc[ai][bj][m][n] = frag_mma(Bt[n], At[m], acc[ai][bj][m][n], sc_w, sc_1); __builtin_amdgcn_s_setprio(0); } while (0)
#define PG8_WAIT_V(n) asm volatile("s_waitcnt vmcnt(" #n ")" ::: "memory")
#define PG8_WAIT_L(n) asm volatile("s_waitcnt lgkmcnt(" #n ")" ::: "memory")
#define PG8_BAR __builtin_amdgcn_s_barrier()
#define PG8_SCHED __builtin_amdgcn_sched_barrier(0)
#define PG8_GATHER_OFFS(dst, ui_, half_) do { _Pragma("unroll") for (int _h = 0; _h < 2; ++_h) _Pragma("unroll") for (int _i = 0; _i < 2; ++_i) \
        dst[_h][_i] = (unsigned)tok[(ui_) * 256 + ((half_) >= 0 ? (half_) * HALF : _h * HALF) + RA[_i]] * (unsigned)K + (unsigned)CA[_i]; } while (0)
#define PG8_PLAIN_OFFS(dst, half_) do { _Pragma("unroll") for (int _i = 0; _i < 2; ++_i) { dst[0][_i] = vplain[0][_i]; dst[1][_i] = (half_) >= 0 ? vplain[0][_i] : vplain[1][_i]; } } while (0)
    Unit cur, nxt; int ui = 0;
    if (!S.next(0, cur)) return;
    f32x4 acc[2][2][4][2];
#pragma unroll
    for (int a = 0; a < 2; ++a)
#pragma unroll
        for (int b = 0; b < 2; ++b)
#pragma unroll
            for (int m = 0; m < 4; ++m)
#pragma unroll
                for (int n = 0; n < 2; ++n) acc[a][b][m][n] = (f32x4){0.f, 0.f, 0.f, 0.f};
    Frag<FP8> At[4], B0[2], B1[2];
    int sc_w = W8_SCALE_E8M0, sc_1 = 0x7F7F7F7F;
    if constexpr (FP8) { asm volatile("" : "+v"(sc_w), "+v"(sc_1)); }
    const char* cA = GATHER ? (const char*)g.A : (const char*)g.A + (size_t)cur.pm * tstep + (cur.half > 0 ? hstep : 0);
    const char* cB = (const char*)g.Bt + (size_t)cur.bt * tstep;
    if constexpr (GATHER) { PG8_GATHER_OFFS(va, 0, cur.half); } else { PG8_PLAIN_OFFS(va, cur.half); }
#define PG8_BIAS_DMA(unit_, slot_) do { if constexpr (Epi::HAS_BIAS) { if (wid < 4) \
        __builtin_amdgcn_global_load_lds((const unsigned*)E.bias_src(unit_, wid * 64 + lane), (LAS unsigned*)(lds + BIAS_OFF + (slot_) * 1024 + wid * 256), 4, 0, 0); } } while (0)
    PG8_BIAS_DMA(cur, 0);
    PG8_STAGE(PG8_SB(0, 0), cB, voffB); PG8_STAGE(PG8_SB(0, 1), cB + hstep, voffB); PG8_STAGE(PG8_SA(0, 0), cA, va[0]); PG8_STAGE(PG8_SA(0, 1), cA, va[1]);
    if (wr == 1) PG8_BAR;
    PG8_WAIT_V(2); PG8_BAR;
    PG8_STAGE(PG8_SB(1, 0), cB + kstep, voffB); PG8_STAGE(PG8_SA(1, 0), cA + kstep, va[0]); PG8_STAGE(PG8_SB(1, 1), cB + hstep + kstep, voffB);
    PG8_WAIT_V(6); PG8_BAR;
    for (;;) {
        const bool has_next = S.next(ui + 1, nxt);
        const char* nA = GATHER ? (const char*)g.A : (has_next ? (const char*)g.A + (size_t)nxt.pm * tstep + (nxt.half > 0 ? hstep : 0) : cA);
        const char* nB = has_next ? (const char*)g.Bt + (size_t)nxt.bt * tstep : cB;
        if (has_next) { if constexpr (GATHER) { PG8_GATHER_OFFS(vn, ui + 1, nxt.half); } else { PG8_PLAIN_OFFS(vn, nxt.half); } }
        else {
#pragma unroll
            for (int h = 0; h < 2; ++h)
#pragma unroll
                for (int i = 0; i < 2; ++i) vn[h][i] = va[h][i]; }
        const bool full = cur.half < 0;
#pragma nounroll
        for (int t = 0; t < nt; t += 2) {
            const bool last = (t == nt - 2);
            const char* a1 = cA + (size_t)(t + 1) * kstep;
            const char* a2 = last ? nA : cA + (size_t)(t + 2) * kstep; const char* b2 = last ? nB : cB + (size_t)(t + 2) * kstep;
            const char* a3 = a2 + kstep; const char* b3 = b2 + kstep;
            unsigned v0[2], v1[2];
            if (last && has_next) PG8_BIAS_DMA(nxt, (ui + 1) & 1);
#pragma unroll
            for (int i = 0; i < 2; ++i) { v0[i] = last ? vn[0][i] : va[0][i]; v1[i] = last ? vn[1][i] : va[1][i]; }
            PG8_LDB(B0, 0, 0); PG8_LDB(B1, 0, 1); PG8_SCHED; PG8_LDA(At, 0, 0); PG8_STAGE(PG8_SA(1, 1), a1, va[1]);
            PG8_WAIT_V(8); PG8_WAIT_L(0); PG8_BAR; PG8_MMA(0, 0, At, B0); PG8_MMA(0, 1, At, B1); PG8_BAR; PG8_SCHED;
            PG8_LDA(At, 0, 1); PG8_STAGE(PG8_SB(0, 0), b2, voffB); PG8_STAGE(PG8_SB(0, 1), b2 + hstep, voffB); PG8_STAGE(PG8_SA(0, 0), a2, v0);
            PG8_WAIT_V(8); PG8_WAIT_L(0); PG8_BAR; if (full) { PG8_MMA(1, 0, At, B0); PG8_MMA(1, 1, At, B1); } PG8_BAR; PG8_SCHED;
            PG8_LDB(B0, 1, 0); PG8_LDB(B1, 1, 1); PG8_SCHED; PG8_LDA(At, 1, 0); PG8_STAGE(PG8_SA(0, 1), a2, v1);
            PG8_WAIT_V(8); PG8_WAIT_L(0); PG8_BAR; PG8_MMA(0, 0, At, B0); PG8_MMA(0, 1, At, B1); PG8_BAR; PG8_SCHED;
            PG8_LDA(At, 1, 1); PG8_STAGE(PG8_SB(1, 0), b3, voffB); PG8_STAGE(PG8_SB(1, 1), b3 + hstep, voffB); PG8_STAGE(PG8_SA(1, 0), a3, v0);
            PG8_WAIT_V(8); PG8_WAIT_L(0); PG8_BAR; if (full) { PG8_MMA(1, 0, At, B0); PG8_MMA(1, 1, At, B1); } PG8_BAR; PG8_SCHED;
        }
        if constexpr (ALIGN_EPI) { if (wr == 0) PG8_BAR; }
        if constexpr (FP8) { asm volatile("s_nop 15\n\ts_nop 7"); PG8_SCHED; }
        E(acc, cur, wr, wc, fr, fq, (const LAS float*)(lds + BIAS_OFF + (ui & 1) * 1024));
        if (!has_next) break;
#pragma unroll
        for (int a = 0; a < 2; ++a)
#pragma unroll
            for (int b = 0; b < 2; ++b)
#pragma unroll
                for (int m = 0; m < 4; ++m)
#pragma unroll
                    for (int n = 0; n < 2; ++n) acc[a][b][m][n] = (f32x4){0.f, 0.f, 0.f, 0.f};
        cur = nxt; cA = nA; cB = nB; ++ui;
#pragma unroll
        for (int h = 0; h < 2; ++h)
#pragma unroll
            for (int i = 0; i < 2; ++i) va[h][i] = vn[h][i];
        if constexpr (ALIGN_EPI) { if (wr == 1) PG8_BAR; }
    }
    PG8_WAIT_V(0);
    if constexpr (!ALIGN_EPI) { if (wr == 0) PG8_BAR; }
    PG8_BAR;
#undef PG8_SA
#undef PG8_SB
#undef PG8_STAGE
#undef PG8_LDA
#undef PG8_LDB
#undef PG8_MMA
#undef PG8_WAIT_V
#undef PG8_WAIT_L
#undef PG8_BAR
#undef PG8_SCHED
#undef PG8_GATHER_OFFS
#undef PG8_PLAIN_OFFS
#undef PG8_BIAS_DMA
}
}

struct Args { const float* in[24]; float* out; unsigned char* ws; int ph_lo, ph_hi; };
enum { I_X = 0, I_C, I_WADA, I_BADA, I_GPRE, I_WIN, I_GSGU, I_WS, I_BS, I_WGK2, I_BGK, I_GGLA, I_WOUT, I_GPOST, I_GPFFN, I_WR, I_BR, I_WG, I_BG, I_WU, I_BU, I_WDN, I_BDN, I_GPOSTF };

template <bool FP8>
__device__ __forceinline__ void transpose_item(const float* W, int ldw, int k0, int n0, void* WT, size_t dst_row0, LAS float* scr, int lane) {
    f32x4 v[8];
#pragma unroll
    for (int q = 0; q < 8; ++q) v[q] = *(const f32x4*)(W + (size_t)(k0 + 8 * q + (lane >> 3)) * ldw + n0 + 4 * (lane & 7));
#pragma unroll
    for (int q = 0; q < 8; ++q) { LAS float* d = scr + (8 * q + (lane >> 3)) * 33 + 4 * (lane & 7); d[0] = v[q][0]; d[1] = v[q][1]; d[2] = v[q][2]; d[3] = v[q][3]; }
    asm volatile("s_waitcnt lgkmcnt(0)" ::: "memory");
    const int c = lane & 7;
#pragma unroll
    for (int j = 0; j < 4; ++j) { const int n = (lane >> 3) + 8 * j; const LAS float* s = scr + (8 * c) * 33 + n;
        if constexpr (FP8) {
            const u32x2 o = (u32x2){pk4_fp8(s[0 * 33] * W8_SCALE, s[1 * 33] * W8_SCALE, s[2 * 33] * W8_SCALE, s[3 * 33] * W8_SCALE), pk4_fp8(s[4 * 33] * W8_SCALE, s[5 * 33] * W8_SCALE, s[6 * 33] * W8_SCALE, s[7 * 33] * W8_SCALE)};
            *(u32x2*)((unsigned char*)WT + (dst_row0 + n) * 1024 + k0 + 8 * c) = o;
        } else {
            u32x4 o; o.x = pk2(s[0 * 33], s[1 * 33]); o.y = pk2(s[2 * 33], s[3 * 33]); o.z = pk2(s[4 * 33], s[5 * 33]); o.w = pk2(s[6 * 33], s[7 * 33]);
            *(u32x4*)((bf16_t*)WT + (dst_row0 + n) * 1024 + k0 + 8 * c) = o; } }
    asm volatile("s_waitcnt lgkmcnt(0)" ::: "memory");
}
__device__ __forceinline__ void p0_prologue(const Args& a, LAS unsigned char* lds, int G) {
    const int tid = threadIdx.x, lane = tid & 63, wave = __builtin_amdgcn_readfirstlane(tid >> 6);
    const int gw = blockIdx.x * 8 + wave, NGW = G * 8;
    unsigned char* ws = a.ws;
    {
        float* mods = (float*)(ws + WS_MODS);
        const float* c = a.in[I_C]; const float* wa = a.in[I_WADA]; const float* ba = a.in[I_BADA];
        LAS float* sc = (LAS float*)lds;
        LAS float* part = (LAS float*)(lds + 16384);
        if ((int)blockIdx.x < 96) { for (int i = tid; i < 4096; i += 512) sc[i] = silu_(c[i]); __syncthreads(); }
        for (int it = blockIdx.x; it < 96; it += G) {
            const int r = lane >> 4, cq = lane & 15, k0 = wave * 128;
            const float* wp = wa + (size_t)(k0 + r) * 6144 + it * 64 + 4 * cq;
            f32x4 wv[32];
#pragma unroll
            for (int i = 0; i < 32; ++i) wv[i] = __builtin_nontemporal_load((const f32x4*)(wp + (size_t)(4 * i) * 6144));
            f32x4 acc[4];
#pragma unroll
            for (int b = 0; b < 4; ++b) acc[b] = (f32x4){0.f, 0.f, 0.f, 0.f};
#pragma unroll
            for (int i = 0; i < 32; ++i)
#pragma unroll
                for (int b = 0; b < 4; ++b) acc[b] += wv[i] * sc[b * 1024 + k0 + 4 * i + r];
#pragma unroll
            for (int b = 0; b < 4; ++b)
#pragma unroll
                for (int e2 = 0; e2 < 4; ++e2) { float t = acc[b][e2]; t += __shfl_xor(t, 16); t += __shfl_xor(t, 32); acc[b][e2] = t; }
            if (lane < 16) {
#pragma unroll
                for (int b = 0; b < 4; ++b) *(LAS f32x4*)(part + (wave * 4 + b) * 64 + 4 * cq) = acc[b]; }
            __syncthreads();
            if (tid < 256) { const int b = tid >> 6, cc = tid & 63; float sv = ba[it * 64 + cc];
#pragma unroll
                for (int w = 0; w < 8; ++w) sv += part[(w * 4 + b) * 64 + cc];
                mods[b * 6144 + it * 64 + cc] = sv; }
            __syncthreads();
        }
    }
    {
        const float* wr = a.in[I_WR]; bf16_t* wh = (bf16_t*)(ws + WS_WR); bf16_t* wl = wh + 32 * 1024;
        for (int idx = blockIdx.x * 512 + tid; idx < 32768; idx += G * 512) { const int k = idx >> 5, j = idx & 31; const float w = wr[idx];
            const unsigned h = f2bf(w); wh[j * 1024 + k] = (bf16_t)h; wl[j * 1024 + k] = (bf16_t)f2bf(w - bf2f(h)); }
    }
    {
        LAS float* scr = (LAS float*)(lds + wave * 16384);
        constexpr int I_IN = 16 * 80, I_OUT = 16 * 32, I_E = 16 * 32;
        constexpr int NITEMS = I_IN + I_OUT + 3 * NE * I_E;
        bf16_t* Win = (bf16_t*)(ws + WS_WIN); bf16_t* Wout = (bf16_t*)(ws + WS_WOUT);
        (void)NITEMS;
        for (int it = gw; it < I_IN + I_OUT; it += NGW) {
            int r = it;
            if (r < I_IN) { const int kb = r / 80, nb = r % 80; transpose_item<false>(a.in[I_WIN], D_IN, 64 * kb, 32 * nb, Win, (size_t)(32 * nb), scr, lane); continue; } r -= I_IN;
            { const int kb = r / 32, nb = r % 32; transpose_item<false>(a.in[I_WOUT], 1024, 64 * kb, 32 * nb, Wout, (size_t)(32 * nb), scr, lane); }
        }
    }
}

constexpr int MOE_ITEMS = 3 * NE * 256;
__device__ __forceinline__ void moe_convert(const Args& a, LAS unsigned char* lds, int G, int first, int last) {
    (void)lds;
    const int tid = threadIdx.x, lane = tid & 63, wave = __builtin_amdgcn_readfirstlane(tid >> 6);
    const int gw = blockIdx.x * 8 + wave, NGW = G * 8;
    unsigned char* Wd = a.ws + WS_WD; unsigned char* W1 = a.ws + WS_W1;
    constexpr int I_E8 = 8 * 32;
#define MC_DECODE(it_, src_, dst_) do { int r = (it_); const int mat = r / (NE * I_E8); r -= mat * (NE * I_E8); const int e = r / I_E8; r -= e * I_E8; \
        const int nb = 8 * (r >> 6) + (r & 7), kb = (r >> 3) & 7, n0 = 32 * nb, k0 = 128 * kb; \
        const float* Wm = (mat == 0 ? a.in[I_WG] : (mat == 1 ? a.in[I_WU] : a.in[I_WDN])) + (size_t)e * 1048576; \
        const size_t drow = (mat == 2) ? (size_t)e * 1024 + n0 : (size_t)e * 2048 + (size_t)(n0 >> 7) * 256 + (size_t)mat * 128 + (size_t)(n0 & 127); \
        dst_ = (mat == 2 ? Wd : W1) + (drow + 4 * (lane & 7)) * 1024 + k0 + 16 * (lane >> 3); src_ = Wm + (size_t)(k0 + 16 * (lane >> 3)) * 1024 + n0 + 4 * (lane & 7); } while (0)
#define MC_LOAD(vv, src_) do { _Pragma("unroll") for (int q = 0; q < 16; ++q) vv[q] = __builtin_nontemporal_load((const f32x4*)((src_) + (size_t)q * 1024)); } while (0)
#define MC_PROC(vv, dst_) do { u32x4 o_[4]; \
        _Pragma("unroll") for (int g4 = 0; g4 < 4; ++g4) { unsigned D_[4]; \
            _Pragma("unroll") for (int q = 0; q < 4; ++q) { const f32x4 t_ = vv[4 * g4 + q] * W8_SCALE; D_[q] = pk4_fp8(t_[0], t_[1], t_[2], t_[3]); } \
            const unsigned pa = __builtin_amdgcn_perm(D_[1], D_[0], 0x05010400u), pb = __builtin_amdgcn_perm(D_[1], D_[0], 0x07030602u); \
            const unsigned pc = __builtin_amdgcn_perm(D_[3], D_[2], 0x05010400u), pd = __builtin_amdgcn_perm(D_[3], D_[2], 0x07030602u); \
            o_[0][g4] = __builtin_amdgcn_perm(pc, pa, 0x05040100u); o_[1][g4] = __builtin_amdgcn_perm(pc, pa, 0x07060302u); \
            o_[2][g4] = __builtin_amdgcn_perm(pd, pb, 0x05040100u); o_[3][g4] = __builtin_amdgcn_perm(pd, pb, 0x07060302u); } \
        _Pragma("unroll") for (int j = 0; j < 4; ++j) __builtin_nontemporal_store(o_[j], (u32x4*)((dst_) + (size_t)j * 1024)); } while (0)
    int it = first + gw;
    if (it < last) {
        const int nmine = (last - 1 - it) / NGW;
        const int itlast = it + nmine * NGW;
        const float* sA; unsigned char* dA; const float* sB; unsigned char* dB; f32x4 v[16], w[16];
        MC_DECODE(it, sA, dA); MC_LOAD(v, sA);
        for (; it < last; it += 2 * NGW) {
            const int itb = (it + NGW <= itlast) ? it + NGW : itlast, ita = (it + 2 * NGW <= itlast) ? it + 2 * NGW : itlast;
            MC_DECODE(itb, sB, dB); MC_LOAD(w, sB);
            MC_PROC(v, dA);
            MC_DECODE(ita, sA, dA); MC_LOAD(v, sA);
            MC_PROC(w, dB);
        }
    }
#undef MC_DECODE
#undef MC_LOAD
#undef MC_PROC
}

__device__ __forceinline__ void p1_norm(const Args& a, LAS unsigned char* lds, int G) {
    const int tid = threadIdx.x, lane = tid & 63, wave = __builtin_amdgcn_readfirstlane(tid >> 6);
    const float* x = a.in[I_X]; const float* win = a.in[I_WIN]; const float* gpre = a.in[I_GPRE];
    const float* mods = (const float*)(a.ws + WS_MODS);
    bf16_t* XN = (bf16_t*)(a.ws + WS_XN); float* glow = (float*)(a.ws + WS_GLOW);
    constexpr int NP1 = 1032;
    LAS bf16_t* NT = (LAS bf16_t*)lds; LAS float* RP = (LAS float*)(lds + 16 * NP1 * 2);
    bf16x8 wg[4];
#pragma unroll
    for (int ks = 0; ks < 4; ++ks)
#pragma unroll
        for (int e = 0; e < 8; ++e) { const int k = 128 * wave + 32 * ks + 8 * (lane >> 4) + e; wg[ks][e] = (short)f2bf(win[(size_t)k * D_IN + C_GL + (lane & 15)]); }
    for (int blk = blockIdx.x; blk < T / 128; blk += G) {
        const int b = (blk * 128) / SEQ;
        f32x4 A1[4], B1[4];
#pragma unroll
        for (int j = 0; j < 4; ++j) { const int k = 4 * lane + 256 * j; const f32x4 gv = *(const f32x4*)(gpre + k), sc = *(const f32x4*)(mods + b * 6144 + 1024 + k);
            A1[j] = gv * (sc + 1.0f); B1[j] = *(const f32x4*)(mods + b * 6144 + k); }
        f32x4 nx[4][4];
#define P1_ROWOF(q_) ((size_t)(blk * 128 + 16 * ((q_) >> 1) + 2 * wave + ((q_) & 1)))
#pragma unroll
        for (int d = 0; d < 4; ++d) { const size_t row = P1_ROWOF(d);
#pragma unroll
          for (int j = 0; j < 4; ++j) nx[d][j] = __builtin_nontemporal_load((const f32x4*)(x + row * 1024 + 4 * lane + 256 * j)); }
        for (int it0 = 0; it0 < 8; it0 += 2) {
#pragma unroll
          for (int iu = 0; iu < 2; ++iu) {
            const int it = it0 + iu;
#pragma unroll
            for (int rr = 0; rr < 2; ++rr) {
                const int r16 = 2 * wave + rr, q = 2 * it + rr, sl = 2 * iu + rr; const size_t row = P1_ROWOF(q);
                const int qn = q + 4 < 16 ? q + 4 : 15; const size_t rown = P1_ROWOF(qn);
                f32x4 v[4]; float ss = 0.f;
#pragma unroll
                for (int j = 0; j < 4; ++j) { v[j] = nx[sl][j]; ss += (v[j][0] * v[j][0] + v[j][1] * v[j][1]) + (v[j][2] * v[j][2] + v[j][3] * v[j][3]); }
#pragma unroll
                for (int j = 0; j < 4; ++j) nx[sl][j] = __builtin_nontemporal_load((const f32x4*)(x + rown * 1024 + 4 * lane + 256 * j));
                const float rstd = __builtin_amdgcn_rsqf(wave_sum(ss) * (1.0f / 1024.0f) + EPS);
#pragma unroll
                for (int j = 0; j < 4; ++j) { v[j] = v[j] * rstd * A1[j] + B1[j];
                    const u32x2 w = (u32x2){pk2(v[j][0], v[j][1]), pk2(v[j][2], v[j][3])};
                    *(u32x2*)(XN + row * 1024 + 4 * lane + 256 * j) = w; *(LAS u32x2*)(NT + r16 * NP1 + 4 * lane + 256 * j) = w; }
            }
            LDS_BARRIER();
            {
                f32x4 acc = (f32x4){0.f, 0.f, 0.f, 0.f};
#pragma unroll
                for (int ks = 0; ks < 4; ++ks) { const bf16x8 av = *(const LAS bf16x8*)(NT + (lane & 15) * NP1 + 128 * wave + 32 * ks + 8 * (lane >> 4)); acc = mfma16(av, wg[ks], acc); }
#pragma unroll
                for (int r = 0; r < 4; ++r) RP[wave * 256 + (4 * (lane >> 4) + r) * 16 + (lane & 15)] = acc[r];
            }
            LDS_BARRIER();
            if (tid < 256) { float sv = 0.f;
#pragma unroll
                for (int w = 0; w < 8; ++w) sv += RP[w * 256 + tid];
                glow[((size_t)blk * 128 + 16 * it) * 16 + tid] = sv; }
          }
        }
#undef P1_ROWOF
        LDS_BARRIER();
    }
}

__device__ __forceinline__ unsigned lo_pair(unsigned a, unsigned b) { return (a & 0xffffu) | (b << 16); }
__device__ __forceinline__ unsigned hi_pair(unsigned a, unsigned b) { return (a >> 16) | (b & 0xffff0000u); }
constexpr int VP32 = 68;
__device__ __forceinline__ void p3_sgu(const Args& a, LAS unsigned char* lds, int G) {
    const int tid = threadIdx.x, lane = tid & 63, wave = __builtin_amdgcn_readfirstlane(tid >> 6);
    const bf16_t* PROJ = (const bf16_t*)(a.ws + WS_PROJ); bf16_t* MIXA = (bf16_t*)(a.ws + WS_XN);
    const int nper = G / 8;
    const int h = blockIdx.x & 7, sub = blockIdx.x >> 3;
    if (sub >= nper) return;
    const int t = 16 * wave + (lane & 15);
    bf16x8 wf[4];
#pragma unroll
    for (int ks = 0; ks < 4; ++ks) { const float* wrow = a.in[I_WS] + ((size_t)h * 128 + t) * 128 + 32 * ks + 8 * (lane >> 4);
#pragma unroll
        for (int e2 = 0; e2 < 8; ++e2) { const int s = 32 * ks + 8 * (lane >> 4) + e2; const float w = (s <= t) ? wrow[e2] : 0.f; wf[ks][e2] = (short)f2bf(w); } }
    const float bias = a.in[I_BS][h * 128 + t];
    const int token = tid >> 2, part = tid & 3, odd = token & 1;
    float gs[16];
#pragma unroll
    for (int j = 0; j < 16; ++j) gs[j] = a.in[I_GSGU][h * 64 + part * 16 + j];
    u32x4 nr0, nr1; u32x2 nu[4];
#define SGU_LOAD(idx_) do { const int tok0_ = ((idx_) >> 6) * SEQ + ((idx_) & 63) * 128; \
        const bf16_t* src_ = PROJ + (size_t)(tok0_ + token) * NPROJ + C_VS + h * 64 + part * 16; nr0 = *(const u32x4*)src_; nr1 = *(const u32x4*)(src_ + 8); \
        _Pragma("unroll") for (int dt = 0; dt < 4; ++dt) nu[dt] = *(const u32x2*)(PROJ + (size_t)(tok0_ + t) * NPROJ + C_US + h * 64 + 16 * dt + 4 * (lane >> 4)); } while (0)
    SGU_LOAD(sub);
    int buf = 0;
    for (int idx = sub; idx < 256; idx += nper, buf ^= 1) {
        LAS unsigned* vhT = (LAS unsigned*)(lds + buf * (64 * VP32 * 4));
        const int tok0 = (idx >> 6) * SEQ + (idx & 63) * 128;
        const u32x4 r0 = nr0, r1 = nr1; u32x2 uu[4];
#pragma unroll
        for (int dt = 0; dt < 4; ++dt) uu[dt] = nu[dt];
        { const int idn = (idx + nper < 256) ? idx + nper : idx; SGU_LOAD(idn); }
        float v[16];
#pragma unroll
        for (int i = 0; i < 4; ++i) { v[2 * i] = bflo(r0[i]); v[2 * i + 1] = bfhi(r0[i]); v[8 + 2 * i] = bflo(r1[i]); v[8 + 2 * i + 1] = bfhi(r1[i]); }
        float ss = 0.f;
#pragma unroll
        for (int j = 0; j < 16; ++j) ss += v[j] * v[j];
        ss += __shfl_xor(ss, 1); ss += __shfl_xor(ss, 2);
        const float rstd = __builtin_amdgcn_rsqf(ss * (1.0f / 64.0f) + EPS);
        unsigned pw[8];
#pragma unroll
        for (int i = 0; i < 8; ++i) pw[i] = pk2(v[2 * i] * rstd * gs[2 * i], v[2 * i + 1] * rstd * gs[2 * i + 1]);
#pragma unroll
        for (int i = 0; i < 4; ++i) {
            const unsigned snd = odd ? pw[i] : pw[4 + i], own = odd ? pw[4 + i] : pw[i], rcv = (unsigned)__shfl_xor((int)snd, 4);
            const unsigned first = odd ? rcv : own, second = odd ? own : rcv;
            const int d = 16 * part + 8 * odd + 2 * i;
            vhT[d * VP32 + ((token >> 1) ^ (4 * (d >> 4)))] = lo_pair(first, second);
            vhT[(d + 1) * VP32 + ((token >> 1) ^ (4 * (d >> 4)))] = hi_pair(first, second); }
        LDS_BARRIER();
        f32x4 acc[4];
#pragma unroll
        for (int dt = 0; dt < 4; ++dt) acc[dt] = (f32x4){0.f, 0.f, 0.f, 0.f};
#pragma unroll
        for (int ks = 0; ks < 4; ++ks) if (ks <= (wave >> 1)) {
#pragma unroll
            for (int dt = 0; dt < 4; ++dt) { const bf16x8 av = *(const LAS bf16x8*)(vhT + (16 * dt + (lane & 15)) * VP32 + ((16 * ks + 4 * (lane >> 4)) ^ (4 * dt))); acc[dt] = mfma16(av, wf[ks], acc[dt]); } }
        const size_t trow = (size_t)(tok0 + t);
#pragma unroll
        for (int dt = 0; dt < 4; ++dt) { const int d = 16 * dt + 4 * (lane >> 4);
            const float o0 = bflo(uu[dt][0]) * (acc[dt][0] + bias), o1 = bfhi(uu[dt][0]) * (acc[dt][1] + bias), o2 = bflo(uu[dt][1]) * (acc[dt][2] + bias), o3 = bfhi(uu[dt][1]) * (acc[dt][3] + bias);
            *(u32x2*)(MIXA + trow * 1024 + h * 64 + d) = (u32x2){pk2(o0, o1), pk2(o2, o3)}; }
    }
#undef SGU_LOAD
}

constexpr int GP32 = 36;
constexpr int GP = 72;
constexpr int GL_WG2 = 0  , GL_WT = 4096  , GL_A = 6144  , GL_B = GL_A + 9216  , GL_VT = GL_B + 9216  ,
              GL_PM = GL_VT + 18432  , GL_RS = GL_PM + 9216  ;
__device__ __forceinline__ void gla_decay(const LAS float* wg2, LAS float* WT, const float (&bgk)[8], f32x2 g2, int lane, int wave, float (&bc)[8], float (&tot)[8]) {
    const int a8 = (lane & 7) * 8, base = lane & ~7;
    f32x2 xp[4];
#pragma unroll
    for (int e = 0; e < 4; ++e) xp[e] = (f32x2){bgk[2 * e], bgk[2 * e + 1]};
#pragma unroll
    for (int j = 0; j < 8; ++j) { const float x0 = __shfl(g2[0], base + j), x1 = __shfl(g2[1], base + j);
        const f32x4 w00 = *(const LAS f32x4*)(wg2 + (2 * j) * 64 + a8), w01 = *(const LAS f32x4*)(wg2 + (2 * j) * 64 + a8 + 4);
        const f32x4 w10 = *(const LAS f32x4*)(wg2 + (2 * j + 1) * 64 + a8), w11 = *(const LAS f32x4*)(wg2 + (2 * j + 1) * 64 + a8 + 4);
        xp[0] += (f32x2){w00[0], w00[1]} * x0; xp[1] += (f32x2){w00[2], w00[3]} * x0; xp[2] += (f32x2){w01[0], w01[1]} * x0; xp[3] += (f32x2){w01[2], w01[3]} * x0;
        xp[0] += (f32x2){w10[0], w10[1]} * x1; xp[1] += (f32x2){w10[2], w10[3]} * x1; xp[2] += (f32x2){w11[0], w11[1]} * x1; xp[3] += (f32x2){w11[2], w11[3]} * x1; }
    float la[8];
#pragma unroll
    for (int e = 0; e < 8; ++e) { const float xx = xp[e >> 1][e & 1];
        la[e] = (fminf(xx, 0.f) - 0.6931471806f * __builtin_amdgcn_logf(1.0f + __builtin_amdgcn_exp2f(-1.4426950409f * fabsf(xx)))) * (1.0f / 16.0f); }
#pragma unroll
    for (int off = 8; off < 64; off <<= 1) {
#pragma unroll
        for (int e = 0; e < 8; ++e) { const float tv = __shfl_up(la[e], off); if (lane >= off) la[e] += tv; } }
    if (lane >= 56) { *(LAS f32x4*)(WT + wave * 64 + a8) = (f32x4){la[0], la[1], la[2], la[3]}; *(LAS f32x4*)(WT + wave * 64 + a8 + 4) = (f32x4){la[4], la[5], la[6], la[7]}; }
    LDS_BARRIER();
    float off8[8];
#pragma unroll
    for (int e = 0; e < 8; ++e) { off8[e] = 0.f; tot[e] = 0.f; }
#pragma unroll
    for (int w = 0; w < 8; ++w) { const f32x4 t0 = *(const LAS f32x4*)(WT + w * 64 + a8), t1 = *(const LAS f32x4*)(WT + w * 64 + a8 + 4);
#pragma unroll
        for (int e = 0; e < 4; ++e) { tot[e] += t0[e]; tot[4 + e] += t1[e]; if (w < wave) { off8[e] += t0[e]; off8[4 + e] += t1[e]; } } }
#pragma unroll
    for (int e = 0; e < 8; ++e) bc[e] = la[e] + off8[e];
}
__device__ __forceinline__ void gla_vt_write(LAS unsigned* VT, u32x4 v0, u32x4 v1, int lane, int wave) {
    const int cl = lane >> 3, a = lane & 7, odd = cl & 1, dcol = 4 * wave + (cl >> 1);
#pragma unroll
    for (int i = 0; i < 4; ++i) {
        const unsigned snd = odd ? v0[i] : v1[i], own = odd ? v1[i] : v0[i], rcv = (unsigned)__shfl_xor((int)snd, 8);
        const unsigned first = odd ? rcv : own, second = odd ? own : rcv;
        const int v = 16 * a + 8 * odd + 2 * i;
        VT[v * GP32 + (dcol ^ (4 * a))] = lo_pair(first, second);
        VT[(v + 1) * GP32 + (dcol ^ (4 * a))] = hi_pair(first, second); }
}

__device__ __forceinline__ void p3_gla_state(const Args& a, LAS unsigned char* lds, int G) {
    const int tid = threadIdx.x, lane = tid & 63, wave = __builtin_amdgcn_readfirstlane(tid >> 6);
    const bf16_t* PROJ = (const bf16_t*)(a.ws + WS_PROJ); bf16_t* ST = (bf16_t*)(a.ws + WS_ST); float* DEC = (float*)(a.ws + WS_DEC); const float* glow = (const float*)(a.ws + WS_GLOW); float* BCUM = (float*)(a.ws + WS_BCUM);
    LAS float* wg2 = (LAS float*)(lds + GL_WG2); LAS float* WT = (LAS float*)(lds + GL_WT);
    LAS unsigned* KDT = (LAS unsigned*)(lds + GL_A); LAS unsigned* VT = (LAS unsigned*)(lds + GL_VT);
    const int c = tid >> 3, a8 = (tid & 7) * 8, v16 = (tid & 7) * 16, cl = lane >> 3, odd = cl & 1;
    int cur_h = -1; float bgk[8];
    f32x2 ng2; u32x4 nkr, nv0, nv1;
#define ST_LOAD(idx_) do { const int bh_ = (idx_) & 15, n_ = (idx_) >> 4, tok0_ = (bh_ >> 2) * SEQ + n_ * 64, h_ = bh_ & 3; \
        ng2 = *(const f32x2*)(glow + (size_t)tok0_ * 16 + 2 * tid); nkr = *(const u32x4*)(PROJ + (size_t)(tok0_ + c) * NPROJ + C_K + h_ * 64 + a8); \
        const bf16_t* vs_ = PROJ + (size_t)(tok0_ + c) * NPROJ + C_V + h_ * 128 + v16; nv0 = *(const u32x4*)vs_; nv1 = *(const u32x4*)(vs_ + 8); } while (0)
    if ((int)blockIdx.x < 2048) ST_LOAD((int)blockIdx.x);
    for (int idx = blockIdx.x; idx < 2048; idx += G) {
        const int bh = idx & 15, n = idx >> 4, h = bh & 3, su = bh * 128 + n;
        if (h != cur_h) {
            LDS_BARRIER();
            for (int i = tid; i < 1024; i += 512) wg2[i] = a.in[I_WGK2][(i >> 6) * 256 + h * 64 + (i & 63)];
#pragma unroll
            for (int e = 0; e < 8; ++e) bgk[e] = a.in[I_BGK][h * 64 + a8 + e];
            cur_h = h; LDS_BARRIER(); }
        const f32x2 g2 = ng2; const u32x4 kr = nkr, v0 = nv0, v1 = nv1;
        { const int idn = (idx + G < 2048) ? idx + G : idx; ST_LOAD(idn); }
        float bc[8], tot[8];
        gla_decay(wg2, WT, bgk, g2, lane, wave, bc, tot);
        { float* bp = BCUM + (size_t)((bh >> 2) * SEQ + n * 64 + c) * 256 + h * 64 + a8; *(f32x4*)bp = (f32x4){bc[0], bc[1], bc[2], bc[3]}; *(f32x4*)(bp + 4) = (f32x4){bc[4], bc[5], bc[6], bc[7]}; }
        {
            unsigned pw[4];
#pragma unroll
            for (int i = 0; i < 4; ++i) pw[i] = pk2(bflo(kr[i]) * __expf(tot[2 * i] - bc[2 * i]), bfhi(kr[i]) * __expf(tot[2 * i + 1] - bc[2 * i + 1]));
            const int dcol = 4 * wave + (cl >> 1);
#pragma unroll
            for (int i = 0; i < 2; ++i) {
                const unsigned snd = odd ? pw[i] : pw[2 + i], own = odd ? pw[2 + i] : pw[i], rcv = (unsigned)__shfl_xor((int)snd, 8);
                const unsigned first = odd ? rcv : own, second = odd ? own : rcv;
                const int d = a8 + 4 * odd + 2 * i;
                KDT[d * GP32 + (dcol ^ (4 * (d >> 4)))] = lo_pair(first, second);
                KDT[(d + 1) * GP32 + (dcol ^ (4 * (d >> 4)))] = hi_pair(first, second); }
            gla_vt_write(VT, v0, v1, lane, wave);
            if (tid < 8) { float* dp = DEC + (size_t)su * 64 + a8; *(f32x4*)dp = (f32x4){__expf(tot[0]), __expf(tot[1]), __expf(tot[2]), __expf(tot[3])}; *(f32x4*)(dp + 4) = (f32x4){__expf(tot[4]), __expf(tot[5]), __expf(tot[6]), __expf(tot[7])}; }
        }
        LDS_BARRIER();
        {
            f32x4 acc[4];
#pragma unroll
            for (int dt = 0; dt < 4; ++dt) acc[dt] = (f32x4){0.f, 0.f, 0.f, 0.f};
#pragma unroll
            for (int ks = 0; ks < 2; ++ks) { const int dc = 16 * ks + 4 * (lane >> 4);
                const bf16x8 bv = *(const LAS bf16x8*)(VT + (16 * wave + (lane & 15)) * GP32 + (dc ^ (4 * wave)));
#pragma unroll
                for (int dt = 0; dt < 4; ++dt) { const bf16x8 av = *(const LAS bf16x8*)(KDT + (16 * dt + (lane & 15)) * GP32 + (dc ^ (4 * dt))); acc[dt] = mfma16(av, bv, acc[dt]); } }
            bf16_t* dst = ST + ((size_t)su * 128 + 16 * wave + (lane & 15)) * 64 + 4 * (lane >> 4);
#pragma unroll
            for (int dt = 0; dt < 4; ++dt) *(u32x2*)(dst + 16 * dt) = (u32x2){pk2(acc[dt][0], acc[dt][1]), pk2(acc[dt][2], acc[dt][3])};
        }
    }
#undef ST_LOAD
}

__device__ __forceinline__ void p4_scan(const Args& a, int G) {
    const bf16_t* ST = (const bf16_t*)(a.ws + WS_ST); const float* DEC = (const float*)(a.ws + WS_DEC); bf16_t* PREV = (bf16_t*)(a.ws + WS_PREV);
    for (int gid = blockIdx.x * 512 + threadIdx.x; gid < 131072; gid += G * 512) {
        const int bh = gid >> 13, rem = gid & 8191;
        float s0 = 0.f;
        for (int n0 = 0; n0 < 128; n0 += 16) {
            float st[16], dc[16];
#pragma unroll
            for (int j = 0; j < 16; ++j) { const size_t su = (size_t)bh * 128 + n0 + j; st[j] = bf2f(ST[su * 8192 + rem]); dc[j] = DEC[su * 64 + (rem & 63)]; }
#pragma unroll
            for (int j = 0; j < 16; ++j) { const size_t su = (size_t)bh * 128 + n0 + j; PREV[su * 8192 + rem] = (bf16_t)f2bf(s0); s0 = dc[j] * s0 + st[j]; }
        }
    }
}

__device__ __forceinline__ void p5_gla_out(const Args& a, LAS unsigned char* lds, int G) {
    const int tid = threadIdx.x, lane = tid & 63, wave = __builtin_amdgcn_readfirstlane(tid >> 6);
    const bf16_t* PROJ = (const bf16_t*)(a.ws + WS_PROJ); const bf16_t* PREV = (const bf16_t*)(a.ws + WS_PREV); bf16_t* MIXA = (bf16_t*)(a.ws + WS_XN); const float* glow = (const float*)(a.ws + WS_GLOW);
    const float* BCUM = (const float*)(a.ws + WS_BCUM);
    LAS bf16_t* QS = (LAS bf16_t*)(lds + GL_A); LAS bf16_t* KS = (LAS bf16_t*)(lds + GL_B); LAS unsigned* VT = (LAS unsigned*)(lds + GL_VT); LAS bf16_t* PM = (LAS bf16_t*)(lds + GL_PM);
    LAS float* RS = (LAS float*)(lds + GL_RS);
    const int c = tid >> 3, a8 = (tid & 7) * 8, v16 = (tid & 7) * 16;
    const int it = wave >> 1, vh = wave & 1;
    f32x4 nb0, nb1; u32x4 nqr, nkr, nv0, nv1;
#define GO_LOAD(idx_) do { const int bh_ = (idx_) & 15, n_ = (idx_) >> 4, tok0_ = (bh_ >> 2) * SEQ + n_ * 64, h_ = bh_ & 3; \
        { const float* bp_ = BCUM + (size_t)(tok0_ + c) * 256 + h_ * 64 + a8; nb0 = *(const f32x4*)bp_; nb1 = *(const f32x4*)(bp_ + 4); } \
        nqr = *(const u32x4*)(PROJ + (size_t)(tok0_ + c) * NPROJ + C_Q + h_ * 64 + a8); nkr = *(const u32x4*)(PROJ + (size_t)(tok0_ + c) * NPROJ + C_K + h_ * 64 + a8); \
        const bf16_t* vs_ = PROJ + (size_t)(tok0_ + c) * NPROJ + C_V + h_ * 128 + v16; nv0 = *(const u32x4*)vs_; nv1 = *(const u32x4*)(vs_ + 8); } while (0)
#define GO_LOAD2(idx_) do { const int bh_ = (idx_) & 15, n_ = (idx_) >> 4, tok0_ = (bh_ >> 2) * SEQ + n_ * 64, h_ = bh_ & 3, su_ = bh_ * 128 + n_; \
        _Pragma("unroll") for (int vt = 0; vt < 4; ++vt) { const int vrow_ = 16 * (4 * vh + vt) + (lane & 15); \
            _Pragma("unroll") for (int ks = 0; ks < 2; ++ks) pv[vt][ks] = *(const bf16x8*)(PREV + ((size_t)su_ * 128 + vrow_) * 64 + 32 * ks + 8 * (lane >> 4)); \
            rr[vt] = *(const u32x2*)(PROJ + (size_t)(tok0_ + 16 * it + (lane & 15)) * NPROJ + C_R + h_ * 128 + 16 * (4 * vh + vt) + 4 * (lane >> 4)); } } while (0)
    if ((int)blockIdx.x < 2048) GO_LOAD((int)blockIdx.x);
    for (int idx = blockIdx.x; idx < 2048; idx += G) {
        const int bh = idx & 15, n = idx >> 4, b = bh >> 2, h = bh & 3, tok0 = b * SEQ + n * 64;
        const f32x4 b0 = nb0, b1 = nb1; const u32x4 qr = nqr, kr = nkr, v0 = nv0, v1 = nv1; bf16x8 pv[4][2]; u32x2 rr[4];
        { const int idn = (idx + G < 2048) ? idx + G : idx; GO_LOAD(idn); }
        GO_LOAD2(idx);
        const float bc[8] = {b0[0], b0[1], b0[2], b0[3], b1[0], b1[1], b1[2], b1[3]};
        {
            u32x4 qo, ko;
#pragma unroll
            for (int i = 0; i < 4; ++i) { const float e0 = __expf(bc[2 * i]), e1 = __expf(bc[2 * i + 1]);
                qo[i] = pk2(bflo(qr[i]) * e0, bfhi(qr[i]) * e1); ko[i] = pk2(bflo(kr[i]) * __builtin_amdgcn_rcpf(e0), bfhi(kr[i]) * __builtin_amdgcn_rcpf(e1)); }
            *(LAS u32x4*)(QS + c * GP + a8) = qo; *(LAS u32x4*)(KS + c * GP + a8) = ko;
            gla_vt_write(VT, v0, v1, lane, wave);
        }
        LDS_BARRIER();
        {
#pragma unroll
            for (int q = 0; q < 2; ++q) { const int jt = 2 * (wave & 1) + q; f32x4 s = (f32x4){0.f, 0.f, 0.f, 0.f};
                if (jt <= it) {
#pragma unroll
                    for (int ks = 0; ks < 2; ++ks) { const bf16x8 av = *(const LAS bf16x8*)(KS + (16 * jt + (lane & 15)) * GP + 32 * ks + 8 * (lane >> 4));
                        const bf16x8 bv = *(const LAS bf16x8*)(QS + (16 * it + (lane & 15)) * GP + 32 * ks + 8 * (lane >> 4)); s = mfma16(av, bv, s); } }
                const int i = 16 * it + (lane & 15), j0 = 16 * jt + 4 * (lane >> 4);
                const float p0 = (j0 <= i) ? s[0] : 0.f, p1 = (j0 + 1 <= i) ? s[1] : 0.f, p2 = (j0 + 2 <= i) ? s[2] : 0.f, p3 = (j0 + 3 <= i) ? s[3] : 0.f;
                *(LAS u32x2*)(PM + i * GP + j0) = (u32x2){pk2(p0, p1), pk2(p2, p3)}; }
        }
        LDS_BARRIER();
        f32x4 acc[4];
#pragma unroll
        for (int vt = 0; vt < 4; ++vt) { acc[vt] = (f32x4){0.f, 0.f, 0.f, 0.f}; const int vrow = 16 * (4 * vh + vt) + (lane & 15), vsw = 4 * (4 * vh + vt);
#pragma unroll
            for (int ks = 0; ks < 2; ++ks) { const bf16x8 av = *(const LAS bf16x8*)(VT + vrow * GP32 + ((16 * ks + 4 * (lane >> 4)) ^ vsw));
                const bf16x8 bv = *(const LAS bf16x8*)(PM + (16 * it + (lane & 15)) * GP + 32 * ks + 8 * (lane >> 4)); acc[vt] = mfma16(av, bv, acc[vt]); }
#pragma unroll
            for (int ks = 0; ks < 2; ++ks) { const bf16x8 bv = *(const LAS bf16x8*)(QS + (16 * it + (lane & 15)) * GP + 32 * ks + 8 * (lane >> 4)); acc[vt] = mfma16(pv[vt][ks], bv, acc[vt]); } }
        float ss = 0.f;
#pragma unroll
        for (int vt = 0; vt < 4; ++vt) ss += (acc[vt][0] * acc[vt][0] + acc[vt][1] * acc[vt][1]) + (acc[vt][2] * acc[vt][2] + acc[vt][3] * acc[vt][3]);
        ss += __shfl_xor(ss, 16); ss += __shfl_xor(ss, 32);
        if (lane < 16) RS[wave * 16 + lane] = ss;
        LDS_BARRIER();
        const float tsum = RS[wave * 16 + (lane & 15)] + RS[(wave ^ 1) * 16 + (lane & 15)];
        const float rstd = __builtin_amdgcn_rsqf(tsum * (1.0f / 128.0f) + EPS);
        const size_t trow = (size_t)(tok0 + 16 * it + (lane & 15));
#pragma unroll
        for (int vt = 0; vt < 4; ++vt) { const int v = 16 * (4 * vh + vt) + 4 * (lane >> 4);
            const f32x4 gg = *(const f32x4*)(a.in[I_GGLA] + v);
            const float o0 = acc[vt][0] * rstd * gg[0] * bflo(rr[vt][0]), o1 = acc[vt][1] * rstd * gg[1] * bfhi(rr[vt][0]), o2 = acc[vt][2] * rstd * gg[2] * bflo(rr[vt][1]), o3 = acc[vt][3] * rstd * gg[3] * bfhi(rr[vt][1]);
            *(u32x2*)(MIXA + trow * 1024 + 512 + h * 128 + v) = (u32x2){pk2(o0, o1), pk2(o2, o3)}; }
    }
#undef GO_LOAD
#undef GO_LOAD2
}

constexpr int NP = 1032;
constexpr int P7_NH = 0, P7_NL = 16 * NP * 2, P7_RP = 2 * 16 * NP * 2, P7_ENT = P7_RP + 16384, P7_CNT = P7_ENT + 3 * 2048, P7_BASE = P7_CNT + 128, P7_LG = P7_BASE + 128  ;
__device__ __forceinline__ void p7_router(const Args& a, LAS unsigned char* lds, int G) {
    const int tid = threadIdx.x, lane = tid & 63, wave = __builtin_amdgcn_readfirstlane(tid >> 6);
    const float* x = a.in[I_X]; const float* mods = (const float*)(a.ws + WS_MODS);
    const bf16_t* MIX = (const bf16_t*)(a.ws + WS_MIX); unsigned char* XN2 = a.ws + WS_XN; bf16_t* H1 = (bf16_t*)(a.ws + WS_H1);
    const bf16_t* WH = (const bf16_t*)(a.ws + WS_WR); const bf16_t* WL = WH + 32 * 1024;
    LAS bf16_t* NH = (LAS bf16_t*)(lds + P7_NH); LAS bf16_t* NL = (LAS bf16_t*)(lds + P7_NL); LAS float* RP = (LAS float*)(lds + P7_RP);
    LAS int* ENT_E = (LAS int*)(lds + P7_ENT); LAS int* ENT_POS = ENT_E + 512; LAS float* ENT_P = (LAS float*)(ENT_POS + 512);
    LAS int* CNTL = (LAS int*)(lds + P7_CNT); LAS int* BASEL = (LAS int*)(lds + P7_BASE); LAS float* LG = (LAS float*)(lds + P7_LG);
    unsigned* gcnt = (unsigned*)(a.ws + WS_CTL) + CW_CNT;
    int* tok_e = (int*)(a.ws + WS_TOKE); int* tok_pos = (int*)(a.ws + WS_TOKPOS); float* tok_p = (float*)(a.ws + WS_TOKP); int* slot_tok = (int*)(a.ws + WS_SLOT);
    bf16x8 whi[4][2], wlo[4][2];
#pragma unroll
    for (int ks = 0; ks < 4; ++ks)
#pragma unroll
        for (int nt = 0; nt < 2; ++nt) { const size_t o = (size_t)(16 * nt + (lane & 15)) * 1024 + 128 * wave + 32 * ks + 8 * (lane >> 4);
            whi[ks][nt] = *(const bf16x8*)(WH + o); wlo[ks][nt] = *(const bf16x8*)(WL + o); }
    for (int blk = blockIdx.x; blk < T / 128; blk += G) {
        const int b = (blk * 128) / SEQ;
        if (tid < 32) CNTL[tid] = 0;
        f32x4 G1[4], A2[4], B2[4];
#pragma unroll
        for (int j = 0; j < 4; ++j) { const int k = 4 * lane + 256 * j;
            G1[j] = *(const f32x4*)(mods + b * 6144 + 2048 + k) * *(const f32x4*)(a.in[I_GPOST] + k);
            A2[j] = *(const f32x4*)(a.in[I_GPFFN] + k) * (*(const f32x4*)(mods + b * 6144 + 4096 + k) + 1.0f);
            B2[j] = *(const f32x4*)(mods + b * 6144 + 3072 + k); }
        LDS_BARRIER();
        u32x2 pm_[4]; f32x4 px_[4];
        { const size_t row = (size_t)(blk * 128 + 2 * wave);
#pragma unroll
          for (int j = 0; j < 4; ++j) { pm_[j] = *(const u32x2*)(MIX + row * 1024 + 4 * lane + 256 * j); px_[j] = __builtin_nontemporal_load((const f32x4*)(x + row * 1024 + 4 * lane + 256 * j)); } }
        for (int it = 0; it < 8; ++it) {
            const int r0 = blk * 128 + 16 * it;
#pragma unroll 1
            for (int rr = 0; rr < 2; ++rr) {
                const int r16 = 2 * wave + rr; const size_t row = (size_t)(r0 + r16);
                const int sn = 2 * it + rr + 1, snc = sn < 16 ? sn : 15; const size_t rown = (size_t)(blk * 128 + 16 * (snc >> 1) + 2 * wave + (snc & 1));
                f32x4 mv[4], hv[4]; float ss = 0.f;
#pragma unroll
                for (int j = 0; j < 4; ++j) { const u32x2 mm = pm_[j]; mv[j] = (f32x4){bflo(mm[0]), bfhi(mm[0]), bflo(mm[1]), bfhi(mm[1])};
                    hv[j] = px_[j]; ss += (mv[j][0] * mv[j][0] + mv[j][1] * mv[j][1]) + (mv[j][2] * mv[j][2] + mv[j][3] * mv[j][3]); }
#pragma unroll
                for (int j = 0; j < 4; ++j) { pm_[j] = *(const u32x2*)(MIX + rown * 1024 + 4 * lane + 256 * j); px_[j] = __builtin_nontemporal_load((const f32x4*)(x + rown * 1024 + 4 * lane + 256 * j)); }
                const float rstd1 = __builtin_amdgcn_rsqf(wave_sum(ss) * (1.0f / 1024.0f) + EPS);
                float ss2 = 0.f;
#pragma unroll
                for (int j = 0; j < 4; ++j) { hv[j] = hv[j] + G1[j] * mv[j] * rstd1; __builtin_nontemporal_store((u32x2){pk2(hv[j][0], hv[j][1]), pk2(hv[j][2], hv[j][3])}, (u32x2*)(H1 + row * 1024 + 4 * lane + 256 * j));
                    ss2 += (hv[j][0] * hv[j][0] + hv[j][1] * hv[j][1]) + (hv[j][2] * hv[j][2] + hv[j][3] * hv[j][3]); }
                const float rstd2 = __builtin_amdgcn_rsqf(wave_sum(ss2) * (1.0f / 1024.0f) + EPS);
#pragma unroll
                for (int j = 0; j < 4; ++j) { const f32x4 nv = hv[j] * rstd2 * A2[j] + B2[j];
                    const u32x2 hw = (u32x2){pk2(nv[0], nv[1]), pk2(nv[2], nv[3])};
                    const u32x2 lw = (u32x2){pk2(nv[0] - bflo(hw[0]), nv[1] - bfhi(hw[0])), pk2(nv[2] - bflo(hw[1]), nv[3] - bfhi(hw[1]))};
                    *(unsigned*)(XN2 + row * 1024 + 4 * lane + 256 * j) = pk4_fp8(nv[0], nv[1], nv[2], nv[3]);
                    *(LAS u32x2*)(NH + r16 * NP + 4 * lane + 256 * j) = hw; *(LAS u32x2*)(NL + r16 * NP + 4 * lane + 256 * j) = lw; }
            }
            LDS_BARRIER();
            {
                f32x4 acc[2] = {(f32x4){0.f, 0.f, 0.f, 0.f}, (f32x4){0.f, 0.f, 0.f, 0.f}};
#pragma unroll
                for (int ks = 0; ks < 4; ++ks) { const int o = (lane & 15) * NP + 128 * wave + 32 * ks + 8 * (lane >> 4);
                    const bf16x8 ah = *(const LAS bf16x8*)(NH + o), al = *(const LAS bf16x8*)(NL + o);
#pragma unroll
                    for (int nt = 0; nt < 2; ++nt) { acc[nt] = mfma16(ah, whi[ks][nt], acc[nt]); acc[nt] = mfma16(al, whi[ks][nt], acc[nt]); acc[nt] = mfma16(ah, wlo[ks][nt], acc[nt]); } }
#pragma unroll
                for (int nt = 0; nt < 2; ++nt)
#pragma unroll
                    for (int r = 0; r < 4; ++r) RP[wave * 512 + (4 * (lane >> 4) + r) * 32 + 16 * nt + (lane & 15)] = acc[nt][r];
            }
            LDS_BARRIER();
            {
                const int r16 = tid >> 5, e = tid & 31;
                float lg = a.in[I_BR][e];
#pragma unroll
                for (int w = 0; w < 8; ++w) lg += RP[w * 512 + r16 * 32 + e];
                LG[(16 * it + r16) * 33 + e] = lg;
            }
        }
        LDS_BARRIER();
        if (tid < 128) {
            float lg[32];
#pragma unroll
            for (int e = 0; e < 32; ++e) lg[e] = LG[tid * 33 + e];
            float tv[4]; int ti[4];
#pragma unroll
            for (int k = 0; k < 4; ++k) { float bv = -INFINITY; int bi = 0;
#pragma unroll
                for (int e = 0; e < 32; ++e) { bool ok = lg[e] > bv;
#pragma unroll
                    for (int q = 0; q < k; ++q) ok = ok && (e != ti[q]);
                    bv = ok ? lg[e] : bv; bi = ok ? e : bi; }
                tv[k] = bv; ti[k] = bi; }
            const float e1 = __expf(tv[1] - tv[0]), e2 = __expf(tv[2] - tv[0]), e3 = __expf(tv[3] - tv[0]);
            const float inv = 1.0f / (1.0f + e1 + e2 + e3);
            const float pr[4] = {inv, e1 * inv, e2 * inv, e3 * inv};
#pragma unroll
            for (int k = 0; k < 4; ++k) { const int pos = __hip_atomic_fetch_add(CNTL + ti[k], 1, __ATOMIC_RELAXED, __HIP_MEMORY_SCOPE_WORKGROUP); ENT_E[tid * 4 + k] = ti[k]; ENT_POS[tid * 4 + k] = pos; ENT_P[tid * 4 + k] = pr[k]; }
        }
        LDS_BARRIER();
        if (tid < 32) BASEL[tid] = (int)atomicAdd(gcnt + tid, (unsigned)CNTL[tid]);
        LDS_BARRIER();
        { const int e = ENT_E[tid], pos = BASEL[e] + ENT_POS[tid], token = blk * 128 + (tid >> 2);
            tok_e[(size_t)token * 4 + (tid & 3)] = e; tok_pos[(size_t)token * 4 + (tid & 3)] = pos; tok_p[(size_t)token * 4 + (tid & 3)] = ENT_P[tid];
            slot_tok[(size_t)e * T + pos] = token; }
        LDS_BARRIER();
    }
}

__device__ __forceinline__ int moe_tables(const Args& a, LAS unsigned char* lds) {
    LAS int* tp = (LAS int*)(lds + TP_OFF); LAS int* cn = tp + 40; LAS unsigned char* te = (LAS unsigned char*)(lds + TE_OFF);
    const unsigned* gcnt = (const unsigned*)(a.ws + WS_CTL) + CW_CNT;
    if (threadIdx.x == 0) { int s = 0; for (int e = 0; e < NE; ++e) { const int c = (int)gcnt[e]; tp[e] = s; cn[e] = c; s += (c + 255) >> 8; } tp[NE] = s; }
    __syncthreads();
    const int nM = tp[NE];
    for (int e = threadIdx.x >> 4; e < NE; e += 32) for (int p = tp[e] + (threadIdx.x & 15); p < tp[e + 1]; p += 16) te[p] = (unsigned char)e;
    __syncthreads();
    return nM;
}

__device__ __forceinline__ void p10_final(const Args& a, LAS unsigned char* lds, int G) {
    const int tid = threadIdx.x, lane = tid & 63, wave = __builtin_amdgcn_readfirstlane(tid >> 6);
    (void)moe_tables(a, lds);
    const LAS int* tp = (const LAS int*)(lds + TP_OFF);
    const float* mods = (const float*)(a.ws + WS_MODS); const unsigned char* OUT8 = a.ws + WS_OUT8; float* out = a.out; const bf16_t* H1 = (const bf16_t*)(a.ws + WS_H1);
    const int* tok_e = (const int*)(a.ws + WS_TOKE); const int* tok_pos = (const int*)(a.ws + WS_TOKPOS); const float* tok_p = (const float*)(a.ws + WS_TOKP);
    for (int rg = blockIdx.x * 8 + wave; rg < T / 16; rg += G * 8) {
        const int b = (rg * 16) / SEQ;
        f32x4 G2[4];
#pragma unroll
        for (int j = 0; j < 4; ++j) { const int k = 4 * lane + 256 * j; G2[j] = *(const f32x4*)(mods + b * 6144 + 5120 + k) * *(const f32x4*)(a.in[I_GPOSTF] + k); }
        const size_t mb = (size_t)rg * 64 + lane;
        const int me = tok_e[mb], mslot = tp[me] * 256 + tok_pos[mb]; const float mpr = tok_p[mb] * (1.0f / OSCALE);
        constexpr int P10D = 2;
        int nw[P10D][4][4]; u32x2 nh[P10D][4];
#define P10_LOADROW(d_, i_) do { const size_t m_ = (size_t)rg * 16 + (i_); \
            _Pragma("unroll") for (int k = 0; k < 4; ++k) { const size_t slot = (size_t)__builtin_amdgcn_readlane(mslot, 4 * (i_) + k); \
                _Pragma("unroll") for (int j = 0; j < 4; ++j) nw[d_][k][j] = *(const int*)(OUT8 + slot * 1024 + 4 * lane + 256 * j); } \
            _Pragma("unroll") for (int j = 0; j < 4; ++j) nh[d_][j] = __builtin_nontemporal_load((const u32x2*)(H1 + m_ * 1024 + 4 * lane + 256 * j)); } while (0)
#pragma unroll
        for (int d = 0; d < P10D; ++d) P10_LOADROW(d, d);
        for (int i0 = 0; i0 < 16; i0 += P10D) {
#pragma unroll
          for (int d = 0; d < P10D; ++d) {
            const int i = i0 + d; const size_t m = (size_t)rg * 16 + i;
            int cw[4][4]; u32x2 ch[4];
#pragma unroll
            for (int k = 0; k < 4; ++k)
#pragma unroll
                for (int j = 0; j < 4; ++j) cw[k][j] = nw[d][k][j];
#pragma unroll
            for (int j = 0; j < 4; ++j) ch[j] = nh[d][j];
            const int in_ = i + P10D < 16 ? i + P10D : 15;
            P10_LOADROW(d, in_);
            f32x4 f[4];
#pragma unroll
            for (int j = 0; j < 4; ++j) f[j] = (f32x4){0.f, 0.f, 0.f, 0.f};
#pragma unroll
            for (int k = 0; k < 4; ++k) {
                const float pk = __builtin_bit_cast(float, __builtin_amdgcn_readlane(__builtin_bit_cast(int, mpr), 4 * i + k));
#pragma unroll
                for (int j = 0; j < 4; ++j) { const int w = cw[k][j];
                    const f32x2 lo = __builtin_amdgcn_cvt_pk_f32_fp8(w, false), hi = __builtin_amdgcn_cvt_pk_f32_fp8(w, true);
                    f[j] += (f32x4){lo[0], lo[1], hi[0], hi[1]} * pk; }
            }
            float ss = 0.f;
#pragma unroll
            for (int j = 0; j < 4; ++j) ss += (f[j][0] * f[j][0] + f[j][1] * f[j][1]) + (f[j][2] * f[j][2] + f[j][3] * f[j][3]);
            const float rstd = __builtin_amdgcn_rsqf(wave_sum(ss) * (1.0f / 1024.0f) + EPS);
#pragma unroll
            for (int j = 0; j < 4; ++j) __builtin_nontemporal_store((f32x4){bflo(ch[j][0]), bfhi(ch[j][0]), bflo(ch[j][1]), bfhi(ch[j][1])} + G2[j] * f[j] * rstd, (f32x4*)(out + m * 1024 + 4 * lane + 256 * j));
          }
        }
#undef P10_LOADROW
    }
}

constexpr int N_PHASES = 11;
__global__ void __launch_bounds__(512, 2) mk_fwd(Args args) {
    extern __shared__ __attribute__((aligned(16))) unsigned char lds_raw[];
    LAS unsigned char* lds = (LAS unsigned char*)lds_raw;
    volatile LAS unsigned* MISC = (volatile LAS unsigned*)(lds + MISC_OFF);
    const int tid = threadIdx.x, G = gridDim.x;
    if (tid < 64) MISC[tid] = 0u;
    __syncthreads();
    unsigned* ctl = (unsigned*)(args.ws + WS_CTL);
    const int lo = args.ph_lo, hi = args.ph_hi;
    XcdBarrier bar; bar.bar = ctl + CW_BAR; bar.x = 0; bar.st = MISC + 8;
    if (hi - lo > 1) bar = xcd_barrier_post(ctl + CW_BAR, MISC + 8);
#define IN(k) (lo <= (k) && (k) < hi)
#define SEAM(k) do { if (IN((k) + 1)) xcd_barrier(bar); } while (0)
    const LAS unsigned short* TOK = (const LAS unsigned short*)(lds + TOK_OFF);
    if (IN(0)) { p0_prologue(args, lds, G); SEAM(0); }
    if (IN(1)) { p1_norm(args, lds, G); SEAM(1); }
    if (IN(2)) {
        pg8::Gemm g{args.ws + WS_XN, args.ws + WS_WIN, 2048}; pg8::StaticOrder S; S.init(T, NPROJ, G, (int)blockIdx.x);
        pg8::EpiProj E{(bf16_t*)(args.ws + WS_PROJ)};
        const int grp = (((int)blockIdx.x >> 3) * 6) >> 5, nun = (S.nwg + G - 1) / G, cut = grp < nun ? grp : nun;
        if (cut > 0) { S.base = 0; S.lim = cut; pg8::gemm_phase<pg8::EpiProj, pg8::StaticOrder, true, false, false>(lds, g, S, E, TOK); }
        __syncthreads(); moe_convert(args, lds, G, 0, MOE_ITEMS); __syncthreads();
        if (cut < nun) { S.base = cut; S.lim = nun - cut; pg8::gemm_phase<pg8::EpiProj, pg8::StaticOrder, true, false, false>(lds, g, S, E, TOK); }
        SEAM(2);
    }
    if (IN(3)) { p3_sgu(args, lds, G); __syncthreads(); p3_gla_state(args, lds, G); SEAM(3); }
    if (IN(4)) { p4_scan(args, G); SEAM(4); }
    if (IN(5)) { p5_gla_out(args, lds, G); SEAM(5); }
    if (IN(6)) {
        pg8::Gemm g{args.ws + WS_XN, args.ws + WS_WOUT, 2048}; pg8::StaticOrder S; S.init(T, 1024, G, (int)blockIdx.x);
        pg8::EpiPlain E{(bf16_t*)(args.ws + WS_MIX), 1024};
        pg8::gemm_phase<pg8::EpiPlain, pg8::StaticOrder, true, false, false>(lds, g, S, E, TOK);
        SEAM(6);
    }
    if (IN(7)) { p7_router(args, lds, G); SEAM(7); }
    if (IN(8)) {
        const int nM = moe_tables(args, lds);
        pg8::MoeOrder S; S.nM = nM; S.nN = 8; S.nwg = nM * 8; S.G = G; S.c = (int)blockIdx.x;
        S.tp = (const LAS int*)(lds + TP_OFF); S.cnt = S.tp + 40; S.te = (const LAS unsigned char*)(lds + TE_OFF);
        {
            LAS unsigned short* tokw = (LAS unsigned short*)(lds + TOK_OFF); const int* slot_tok = (const int*)(args.ws + WS_SLOT);
            pg8::Unit u;
            for (int i = 0; i < 18 && S.next(i, u); ++i) if (tid < 256) { const int p = u.prow + tid; tokw[i * 256 + tid] = (unsigned short)(p < u.cnt ? slot_tok[(size_t)u.e * T + p] : 0); }
            __syncthreads();
        }
        pg8::Gemm g{args.ws + WS_XN, args.ws + WS_W1, 1024};
        pg8::EpiSwiglu E{args.ws + WS_HDN, args.in[I_BG], args.in[I_BU]};
        pg8::gemm_phase<pg8::EpiSwiglu, pg8::MoeOrder, true, true, true>(lds, g, S, E, TOK);
        SEAM(8);
    }
    if (IN(9)) {
        const int nM = moe_tables(args, lds);
        pg8::MoeOrder S; S.nM = nM; S.nN = 4; S.nwg = nM * 4; S.G = G; S.c = (int)blockIdx.x;
        S.tp = (const LAS int*)(lds + TP_OFF); S.cnt = S.tp + 40; S.te = (const LAS unsigned char*)(lds + TE_OFF);
        pg8::Gemm g{args.ws + WS_HDN, args.ws + WS_WD, 1024};
        pg8::EpiOut8 E{args.ws + WS_OUT8, args.in[I_BDN]};
        pg8::gemm_phase<pg8::EpiOut8, pg8::MoeOrder, true, false, true>(lds, g, S, E, TOK);
        SEAM(9);
    }
    if (IN(10)) { p10_final(args, lds, G); }
#undef IN
#undef SEAM
}

#ifndef MK_SPLIT
#define MK_SPLIT 0
#endif
extern "C" void kernel_launch(void* const* d_in, const int* in_sizes, int n_in, void* d_out, int out_size, void* d_ws, size_t ws_size, hipStream_t stream) {
    static int grid = 0;
    if (grid == 0) {
        if (n_in != 24 || out_size != T * D || ws_size < WS_END) { fprintf(stderr, "kernel_launch: unexpected problem (n_in %d, out %d, ws %zu)\n", n_in, out_size, ws_size); grid = -1; return; }
        int dev = 0, cus = 0, per_cu = 0;
        if (hipGetDevice(&dev) != hipSuccess || hipDeviceGetAttribute(&cus, hipDeviceAttributeMultiprocessorCount, dev) != hipSuccess) { grid = -1; return; }
        if (hipFuncSetAttribute((const void*)mk_fwd, hipFuncAttributeMaxDynamicSharedMemorySize, LDS_BYTES) != hipSuccess) { grid = -1; return; }
        if (hipOccupancyMaxActiveBlocksPerMultiprocessor(&per_cu, (const void*)mk_fwd, 512, LDS_BYTES) != hipSuccess || per_cu < 1) { fprintf(stderr, "kernel_launch: occupancy query says %d\n", per_cu); (void)hipGetLastError(); grid = -1; return; }
        grid = cus;
    }
    if (grid < 0) return;
    (void)hipMemsetAsync((char*)d_ws + WS_CTL, 0, CTL_ZERO_BYTES, stream);
    Args a{};
    for (int i = 0; i < 24; ++i) a.in[i] = (const float*)d_in[i];
    a.out = (float*)d_out; a.ws = (unsigned char*)d_ws;
#if MK_SPLIT
    for (int p = 0; p < N_PHASES; ++p) { a.ph_lo = p; a.ph_hi = p + 1; hipLaunchKernelGGL(mk_fwd, dim3(grid), dim3(512), LDS_BYTES, stream, a); }
#else
    a.ph_lo = 0; a.ph_hi = N_PHASES;
    hipLaunchKernelGGL(mk_fwd, dim3(grid), dim3(512), LDS_BYTES, stream, a);
#endif
}
```

```cpp
#include <hip/hip_runtime.h>
#include <cstdio>
#include <cstdint>

#define LAS __attribute__((address_space(3)))
typedef unsigned short bf16_t;
typedef short bf16x8 __attribute__((ext_vector_type(8)));
typedef float f32x4 __attribute__((ext_vector_type(4)));
typedef float f32x2 __attribute__((ext_vector_type(2)));
typedef unsigned u32x4 __attribute__((ext_vector_type(4)));
typedef unsigned u32x2 __attribute__((ext_vector_type(2)));

constexpr int T = 32768, D = 1024, SEQ = 8192;
constexpr int D_IN = 2576, NPROJ = 2560;
constexpr int NE = 32;
constexpr float EPS = 1e-6f;
constexpr int C_US = 0, C_VS = 512, C_Q = 1024, C_K = 1280, C_V = 1536, C_R = 2048, C_GL = 2560;
constexpr float OSCALE = 8.0f;
constexpr float W8_SCALE = 32.0f;
#define W8_SCALE_E8M0 0x7A7A7A7A

constexpr size_t MiB = 1u << 20;
constexpr size_t WS_CTL = 0, CTL_ZERO_BYTES = 1 * MiB;
constexpr int CW_TMO = 0, CW_CNT = 1024, CW_BAR = 4096;
constexpr size_t WS_MODS = 256 * 1024;
constexpr size_t WS_GLOW = 2 * MiB;
constexpr size_t WS_TOKE = 4 * MiB, WS_TOKPOS = WS_TOKE + 512 * 1024, WS_TOKP = WS_TOKE + 1024 * 1024;
constexpr size_t WS_DEC = 5 * MiB + 512 * 1024;
constexpr size_t WS_SLOT = 6 * MiB;
constexpr size_t WS_WR = 10 * MiB;
constexpr size_t WS_WIN = 11 * MiB;
constexpr size_t WS_WOUT = 16 * MiB;
constexpr size_t WS_WD = 18 * MiB;
constexpr size_t WS_W1 = 50 * MiB;
constexpr size_t WS_XN = 114 * MiB;
constexpr size_t WS_PROJ = 178 * MiB;
constexpr size_t WS_ST = 338 * MiB;
constexpr size_t WS_PREV = 402 * MiB;
constexpr size_t WS_MIX = 178 * MiB;
constexpr size_t WS_HDN = 178 * MiB;
constexpr size_t WS_OUT8 = 338 * MiB;
constexpr size_t WS_BCUM = 434 * MiB;
constexpr size_t WS_H1 = 474 * MiB;
constexpr size_t WS_END = 538 * MiB;
constexpr int MAX_TILES = 543;

constexpr int RING_BYTES = 131072;
constexpr int MISC_OFF = RING_BYTES;
constexpr int TP_OFF = MISC_OFF + 256;
constexpr int TE_OFF = TP_OFF + 512;
constexpr int TOK_OFF = TE_OFF + 1024;
constexpr int BIAS_OFF = TOK_OFF + 18 * 512;
constexpr int LDS_BYTES = 147456;
static_assert(BIAS_OFF + 2048 <= LDS_BYTES && BIAS_OFF % 16 == 0, "LDS map");

__device__ __forceinline__ unsigned f2bf(float f) { unsigned u = __builtin_bit_cast(unsigned, f); return (u + 0x7fffu + ((u >> 16) & 1u)) >> 16; }
__device__ __forceinline__ float bf2f(unsigned h) { return __builtin_bit_cast(float, h << 16); }
__device__ __forceinline__ float bflo(unsigned w) { return __builtin_bit_cast(float, w << 16); }
__device__ __forceinline__ float bfhi(unsigned w) { return __builtin_bit_cast(float, w & 0xffff0000u); }
typedef __bf16 bf16x2_t __attribute__((ext_vector_type(2)));
__device__ __forceinline__ unsigned pk2(float lo, float hi) { const f32x2 v = {lo, hi}; return __builtin_bit_cast(unsigned, __builtin_convertvector(v, bf16x2_t)); }
__device__ __forceinline__ unsigned pk4_fp8(float a, float b, float c, float d) {
    int w = __builtin_amdgcn_cvt_pk_fp8_f32(a, b, 0, false); w = __builtin_amdgcn_cvt_pk_fp8_f32(c, d, w, true); return (unsigned)w; }
__device__ __forceinline__ float clamp448(float v) { return fminf(fmaxf(v, -448.0f), 448.0f); }
#define LDS_BARRIER() do { asm volatile("s_waitcnt lgkmcnt(0)" ::: "memory"); __builtin_amdgcn_s_barrier(); asm volatile("" ::: "memory"); } while (0)
__device__ __forceinline__ float wave_sum(float v) {
#pragma unroll
    for (int o = 1; o < 64; o <<= 1) v += __shfl_xor(v, o);
    return v;
}
__device__ __forceinline__ f32x4 mfma16(bf16x8 a, bf16x8 b, f32x4 c) { return __builtin_amdgcn_mfma_f32_16x16x32_bf16(a, b, c, 0, 0, 0); }
__device__ __forceinline__ float sigmoidf_(float x) { return __builtin_amdgcn_rcpf(1.0f + __builtin_amdgcn_exp2f(-1.4426950408889634f * x)); }
__device__ __forceinline__ float gelu_tanh(float x) { const float u = x + 0.044715f * x * x * x; return x * __builtin_amdgcn_rcpf(1.0f + __builtin_amdgcn_exp2f(-2.302208198f * u)); }
__device__ __forceinline__ float silu_(float x) { return x * sigmoidf_(x); }
__device__ __forceinline__ f32x2 rcp2(f32x2 v) { return (f32x2){__builtin_amdgcn_rcpf(v[0]), __builtin_amdgcn_rcpf(v[1])}; }
__device__ __forceinline__ f32x2 exp2_2(f32x2 v) { return (f32x2){__builtin_amdgcn_exp2f(v[0]), __builtin_amdgcn_exp2f(v[1])}; }
__device__ __forceinline__ f32x2 clamp2(f32x2 v, float lo, float hi) { return (f32x2){__builtin_amdgcn_fmed3f(v[0], lo, hi), __builtin_amdgcn_fmed3f(v[1], lo, hi)}; }
__device__ __forceinline__ f32x2 gelu_tanh2(f32x2 x) { const f32x2 u = x + (x * x) * (x * 0.044715f); return x * rcp2(exp2_2(u * -2.302208198f) + 1.0f); }
__device__ __forceinline__ f32x2 silu2(f32x2 x) { return x * rcp2(exp2_2(x * -1.4426950408889634f) + 1.0f); }

#define XB_TMO      128
#define XB_XCNT(j)  (256  + 64 * (j))
#define XB_XSUB(j)  (1280 + 64 * (j))
#define XB_XGEN(j)  (2304 + 64 * (j))
#define XB_TOP      3328
#define XB_TOPGEN   3392
#define XCD_BAR_WORDS 3456
#define XB_SPIN_CAP (1u << 20)
__device__ __forceinline__ unsigned xb_ld(unsigned* p)              { return __hip_atomic_load(p, __ATOMIC_RELAXED, __HIP_MEMORY_SCOPE_AGENT); }
__device__ __forceinline__ unsigned xb_add(unsigned* p, unsigned v) { return __hip_atomic_fetch_add(p, v, __ATOMIC_RELAXED, __HIP_MEMORY_SCOPE_AGENT); }
__device__ __forceinline__ unsigned xb_xcc_id() { return (unsigned)__builtin_amdgcn_s_getreg((3 << 11) | 20) & 0xFu; }
#define XB_SPIN(cond, bar) do { unsigned _sp = 0; while (cond) { __builtin_amdgcn_s_sleep(1); \
    if ((++_sp & 255u) == 0u) { if (xb_ld(&(bar)[XB_TMO])) break; if (_sp > XB_SPIN_CAP) { atomicAdd(&(bar)[XB_TMO], 1u); break; } } } } while (0)
struct XcdBarrier { unsigned* bar; unsigned x; volatile LAS unsigned* st; };
__device__ __forceinline__ XcdBarrier xcd_barrier_post(unsigned* bar, volatile LAS unsigned* st) {
    XcdBarrier b; b.bar = bar; b.x = xb_xcc_id(); b.st = st;
    if (threadIdx.x == 0) (void)xb_add(&bar[XB_XCNT(b.x)], 1u);
    return b;
}
__device__ __forceinline__ void xcd_barrier_complete(unsigned* bar, unsigned x, unsigned& nloc, unsigned& nx) {
    const unsigned G = gridDim.x * gridDim.y * gridDim.z;
    unsigned sum, cnt, mine, sp = 0u;
    for (;;) {
        sum = 0u; cnt = 0u; mine = 0u;
#pragma unroll
        for (unsigned j = 0; j < 16; ++j) { const unsigned c = xb_ld(&bar[XB_XCNT(j)]); sum += c; cnt += (c > 0u) ? 1u : 0u; mine = (j == x) ? c : mine; }
        if (sum == G) break;
        __builtin_amdgcn_s_sleep(1);
        if ((++sp & 255u) == 0u) { if (xb_ld(&bar[XB_TMO])) break; if (sp > XB_SPIN_CAP) { atomicAdd(&bar[XB_TMO], 1u); break; } }
    }
    nloc = mine > 0u ? mine : 1u; nx = cnt > 0u ? cnt : 1u;
}
__device__ __forceinline__ void xcd_barrier(const XcdBarrier& b) {
    asm volatile("s_waitcnt vmcnt(0)" ::: "memory");
    __syncthreads();
    if (threadIdx.x == 0) {
        unsigned* bar = b.bar;
        __builtin_amdgcn_s_waitcnt(0);
        unsigned nloc = b.st[0], nx = b.st[1];
        if (nloc == 0u) { xcd_barrier_complete(bar, b.x, nloc, nx); b.st[0] = nloc; b.st[1] = nx; }
        const unsigned old = xb_add(&bar[XB_XSUB(b.x)], 1u);
        const unsigned gen = old / nloc;
        if (old + 1u == (gen + 1u) * nloc) {
            __builtin_amdgcn_fence(__ATOMIC_RELEASE, "agent");
            asm volatile("s_waitcnt vmcnt(0)" ::: "memory");
            const unsigned og = xb_add(&bar[XB_TOP], 1u);
            const unsigned tg = og / nx;
            if (og + 1u == (tg + 1u) * nx) xb_add(&bar[XB_TOPGEN], 1u);
            else XB_SPIN(xb_ld(&bar[XB_TOPGEN]) == tg, bar);
            __builtin_amdgcn_fence(__ATOMIC_ACQUIRE, "agent");
            xb_add(&bar[XB_XGEN(b.x)], 1u);
            asm volatile("s_waitcnt vmcnt(0)" ::: "memory");
        } else {
            XB_SPIN(xb_ld(&bar[XB_XGEN(b.x)]) == gen, bar);
            __builtin_amdgcn_fence(__ATOMIC_ACQUIRE, "agent");
            asm volatile("s_waitcnt vmcnt(0)" ::: "memory");
        }
    }
    __syncthreads();
}

namespace pg8 {
constexpr int BM = 256, BK = 64, HALF = 128, HTB = HALF * BK * 2, STAGE_BYTES = 8 * HTB, NXCD = 8, WGM = 8;
template <int SH> __host__ __device__ __forceinline__ int lds_byte(int r, int cb) { const int st = (r >> 4) * 2 + (cb >> 6), rr = r & 15, ob = rr * 64 + (cb & 63); return st * 1024 + (ob ^ (((ob >> 9) & 1) << SH)); }
template <int SH> __host__ __device__ __forceinline__ void stage_rc(int b, int& R, int& CB) { const int st = b / 1024, sb = b % 1024, swz = sb ^ (((sb >> 9) & 1) << SH); R = (st >> 1) * 16 + swz / 64; CB = (st & 1) * 64 + (swz % 64); }
__host__ __device__ __forceinline__ int perm32(int rho) { const int n = rho >> 4, i = rho & 15; return 8 * (i >> 2) + 4 * n + (i & 3); }

struct Unit { int pm, pn, bt, e, prow, cnt, half; };
struct Gemm { const void* A; const void* Bt; int Kb; };

__device__ __forceinline__ void tile_of(int L, int nM, int nN, int nwg, int& pm, int& pn) {
    int wgid = L; { const int q = nwg / NXCD, r = nwg % NXCD, xcd = wgid % NXCD, off = wgid / NXCD; wgid = (xcd < r ? xcd * (q + 1) : r * (q + 1) + (xcd - r) * q) + off; }
    const int nig = WGM * nN, gid = wgid / nig, fm = gid * WGM, gsz = (nM - fm) < WGM ? (nM - fm) : WGM;
    pm = fm + ((wgid % nig) % gsz); pn = (wgid % nig) / gsz;
}
struct StaticOrder {
    int nM, nN, nwg, G, c, base, lim;
    __device__ void init(int M, int N, int G_, int c_) { nM = M / BM; nN = N / BM; nwg = nM * nN; G = G_; c = c_; base = 0; lim = 1 << 30; }
    __device__ __forceinline__ bool next(int i, Unit& u) const {
        if (i >= lim) return false;
        const long L = (long)(i + base) * G + c; if (L >= nwg) return false;
        tile_of((int)L, nM, nN, nwg, u.pm, u.pn); u.bt = u.pn; u.e = 0; u.prow = 0; u.cnt = 0; u.half = -1; return true;
    }
};
struct MoeOrder {
    int nM, nN, nwg, G, c; const LAS int* tp; const LAS unsigned char* te; const LAS int* cnt;
    __device__ __forceinline__ bool next(int i, Unit& u) const {
        const int Rf = nwg / G, Lo = nwg - Rf * G; const bool split = (Lo > 0) && (2 * Lo <= G);
        long L; u.half = -1;
        if (i < Rf) L = (long)i * G + c;
        else if (i == Rf && !split) { if (c >= Lo) return false; L = (long)Rf * G + c; }
        else if (i == Rf) { if (c >= 2 * Lo) return false; L = (long)Rf * G + (c >> 1); u.half = c & 1; }
        else return false;
        tile_of((int)L, nM, nN, nwg, u.pm, u.pn);
        const int e = __builtin_amdgcn_readfirstlane((int)te[u.pm]);
        u.e = e; u.bt = e * nN + u.pn; u.prow = (u.pm - __builtin_amdgcn_readfirstlane(tp[e])) * BM; u.cnt = __builtin_amdgcn_readfirstlane(cnt[e]); return true;
    }
};

struct EpiProj {
    static constexpr int PERMK = 1; static constexpr bool HAS_BIAS = false; static constexpr float BIAS_MUL = 1.0f; static constexpr int ACT_E8M0 = 0x7F7F7F7F;
    __device__ __forceinline__ const float* bias_src(const Unit&, int) const { return nullptr; }
    static __device__ __forceinline__ int bias_off(int, int, int, int) { return 0; }
    bf16_t* O;
    __device__ __forceinline__ void operator()(const f32x4 (&acc)[2][2][4][2], const Unit& u, int wr, int wc, int fr, int fq, const LAS float*) const {
        const int row0 = u.pm * BM + wr * 64 + fr, col0 = u.pn * BM + wc * 32 + 8 * fq;
        const int mode = (u.pn < 4) ? 1 : (u.pn >= 8 ? 2 : (u.pn == 4 ? 3 : 0));
#pragma unroll
        for (int ai = 0; ai < 2; ++ai)
#pragma unroll
            for (int m = 0; m < 4; ++m) { bf16_t* rowp = O + (size_t)(row0 + ai * HALF + m * 16) * NPROJ + col0;
#pragma unroll
                for (int bj = 0; bj < 2; ++bj) { f32x2 v[4];
#pragma unroll
                    for (int n = 0; n < 2; ++n) { v[2 * n] = (f32x2){acc[ai][bj][m][n][0], acc[ai][bj][m][n][1]}; v[2 * n + 1] = (f32x2){acc[ai][bj][m][n][2], acc[ai][bj][m][n][3]}; }
                    if (mode == 1) {
#pragma unroll
                        for (int i = 0; i < 4; ++i) v[i] = gelu_tanh2(v[i]);
                    } else if (mode == 2) {
#pragma unroll
                        for (int i = 0; i < 4; ++i) v[i] = silu2(v[i]);
                    } else if (mode == 3) {
#pragma unroll
                        for (int i = 0; i < 4; ++i) v[i] = v[i] * 0.125f;
                    }
                    u32x4 w; w.x = pk2(v[0][0], v[0][1]); w.y = pk2(v[1][0], v[1][1]); w.z = pk2(v[2][0], v[2][1]); w.w = pk2(v[3][0], v[3][1]);
                    *(u32x4*)(rowp + bj * HALF) = w; } }
    }
};
struct EpiPlain {
    static constexpr int PERMK = 1; static constexpr bool HAS_BIAS = false; static constexpr float BIAS_MUL = 1.0f; static constexpr int ACT_E8M0 = 0x7F7F7F7F;
    __device__ __forceinline__ const float* bias_src(const Unit&, int) const { return nullptr; }
    static __device__ __forceinline__ int bias_off(int, int, int, int) { return 0; }
    bf16_t* O; int ldc;
    __device__ __forceinline__ void operator()(const f32x4 (&acc)[2][2][4][2], const Unit& u, int wr, int wc, int fr, int fq, const LAS float*) const {
        const int row0 = u.pm * BM + wr * 64 + fr, col0 = u.pn * BM + wc * 32 + 8 * fq;
#pragma unroll
        for (int ai = 0; ai < 2; ++ai)
#pragma unroll
            for (int m = 0; m < 4; ++m) { bf16_t* rowp = O + (size_t)(row0 + ai * HALF + m * 16) * ldc + col0;
#pragma unroll
                for (int bj = 0; bj < 2; ++bj) { const f32x4 v0 = acc[ai][bj][m][0], v1 = acc[ai][bj][m][1];
                    u32x4 w; w.x = pk2(v0[0], v0[1]); w.y = pk2(v0[2], v0[3]); w.z = pk2(v1[0], v1[1]); w.w = pk2(v1[2], v1[3]);
                    *(u32x4*)(rowp + bj * HALF) = w; } }
    }
};
struct EpiSwiglu {
    static constexpr int PERMK = 1; static constexpr bool HAS_BIAS = true; static constexpr float BIAS_MUL = 1.0f; static constexpr int ACT_E8M0 = 0x7F7F7F7F;
    static __device__ __forceinline__ int bias_off(int bj, int n, int wc, int fq) { return bj * HALF + wc * 32 + 8 * fq + 4 * n; }
    unsigned char* H; const float* bg; const float* bu;
    __device__ __forceinline__ const float* bias_src(const Unit& u, int j) const { return (j < 128 ? bg : bu) + (size_t)u.e * 1024 + u.pn * HALF + (j & 127); }
    __device__ __forceinline__ void operator()(const f32x4 (&acc)[2][2][4][2], const Unit& u, int wr, int wc, int fr, int fq, const LAS float* btab) const {
        const int row0 = u.pm * BM + (u.half > 0 ? HALF : 0) + wr * 64 + fr, hc0 = u.pn * HALF + wc * 32 + 8 * fq;
#pragma unroll
        for (int ai = 0; ai < 2; ++ai) if (ai == 0 || u.half < 0)
#pragma unroll
            for (int m = 0; m < 4; ++m) { f32x2 h[4];
#pragma unroll
                for (int n = 0; n < 2; ++n)
#pragma unroll
                    for (int q = 0; q < 2; ++q) {
                        const f32x2 g = (f32x2){fminf(acc[ai][0][m][n][2 * q], 7.0f), fminf(acc[ai][0][m][n][2 * q + 1], 7.0f)};
                        const f32x2 uu = clamp2((f32x2){acc[ai][1][m][n][2 * q], acc[ai][1][m][n][2 * q + 1]}, -7.0f, 7.0f);
                        h[2 * n + q] = (uu * g + g) * rcp2(exp2_2(g * (-1.702f * 1.4426950408889634f)) + 1.0f); }
                *(u32x2*)(H + (size_t)(row0 + ai * HALF + m * 16) * 1024 + hc0) = (u32x2){pk4_fp8(h[0][0], h[0][1], h[1][0], h[1][1]), pk4_fp8(h[2][0], h[2][1], h[3][0], h[3][1])}; }
    }
};
struct EpiOut8 {
    static constexpr int PERMK = 2; static constexpr bool HAS_BIAS = true; static constexpr float BIAS_MUL = OSCALE; static constexpr int ACT_E8M0 = 0x82828282;
    static __device__ __forceinline__ int bias_off(int bj, int n, int wc, int fq) { return wc * 64 + 16 * fq + 8 * bj + 4 * n; }
    unsigned char* O; const float* bd;
    __device__ __forceinline__ const float* bias_src(const Unit& u, int j) const { return bd + (size_t)u.e * 1024 + u.pn * BM + j; }
    __device__ __forceinline__ void operator()(const f32x4 (&acc)[2][2][4][2], const Unit& u, int wr, int wc, int fr, int fq, const LAS float* btab) const {
        const int row0 = u.pm * BM + (u.half > 0 ? HALF : 0) + wr * 64 + fr, col0 = u.pn * BM + wc * 64 + 16 * fq;
#pragma unroll
        for (int ai = 0; ai < 2; ++ai) if (ai == 0 || u.half < 0)
#pragma unroll
            for (int m = 0; m < 4; ++m) { u32x4 w;
#pragma unroll
                for (int bj = 0; bj < 2; ++bj)
#pragma unroll
                    for (int n = 0; n < 2; ++n) { const f32x4 c = acc[ai][bj][m][n];
                        w[2 * bj + n] = pk4_fp8(__builtin_amdgcn_fmed3f(c[0], -440.0f, 440.0f), __builtin_amdgcn_fmed3f(c[1], -440.0f, 440.0f), __builtin_amdgcn_fmed3f(c[2], -440.0f, 440.0f), __builtin_amdgcn_fmed3f(c[3], -440.0f, 440.0f)); }
                *(u32x4*)(O + (size_t)(row0 + ai * HALF + m * 16) * 1024 + col0) = w; }
    }
};

typedef int i32x4 __attribute__((ext_vector_type(4)));
typedef int i32x8 __attribute__((ext_vector_type(8)));
template <bool FP8> struct Frag;
template <> struct Frag<false> { bf16x8 k0, k1; __device__ __forceinline__ void ld(const LAS unsigned char* p0, const LAS unsigned char* p1) { k0 = *(const LAS bf16x8*)p0; k1 = *(const LAS bf16x8*)p1; } };
template <> struct Frag<true> { i32x8 v; __device__ __forceinline__ void ld(const LAS unsigned char* p0, const LAS unsigned char* p1) { v = __builtin_shufflevector(*(const LAS i32x4*)p0, *(const LAS i32x4*)p1, 0, 1, 2, 3, 4, 5, 6, 7); } };
__device__ __forceinline__ f32x4 frag_mma(const Frag<false>& b, const Frag<false>& a, f32x4 c) { c = __builtin_amdgcn_mfma_f32_16x16x32_bf16(b.k0, a.k0, c, 0, 0, 0); return __builtin_amdgcn_mfma_f32_16x16x32_bf16(b.k1, a.k1, c, 0, 0, 0); }
__device__ __forceinline__ f32x4 frag_mma(const Frag<true>& b, const Frag<true>& a, f32x4 c, int sw, int s1) {
    asm volatile("s_nop 1\n\tv_mfma_scale_f32_16x16x128_f8f6f4 %0, %1, %2, %0, %3, %4 op_sel_hi:[0,0,0]" : "+v"(c) : "v"(b.v), "v"(a.v), "v"(sw), "v"(s1)); return c; }
__device__ __forceinline__ f32x4 frag_mma(const Frag<false>& b, const Frag<false>& a, f32x4 c, int, int) { return frag_mma(b, a, c); }
template <class Epi, class Sched, bool ALIGN_EPI, bool GATHER, bool FP8>
__device__ __forceinline__ void gemm_phase(LAS unsigned char* lds, const Gemm g, const Sched& S, const Epi& E, const LAS unsigned short* tok) {
    const int tid = threadIdx.x, wid = __builtin_amdgcn_readfirstlane(tid >> 6), lane = tid & 63, wr = wid >> 2, wc = wid & 3, fr = lane & 15, fq = lane >> 4;
    constexpr int SH = FP8 ? 4 : 5;
    const int K = g.Kb, nt = K / 128;
    unsigned voffB[2]; unsigned va[2][2], vn[2][2]; int RA[2], CA[2];
#pragma unroll
    for (int i = 0; i < 2; ++i) { int R, C; stage_rc<SH>(tid * 16 + i * 8192, R, C);
        const int Rb = Epi::PERMK == 2 ? (((R >> 5) & 3) * 64 + ((R >> 2) & 3) * 16 + ((R >> 4) & 1) * 4 + (R & 3)) : (Epi::PERMK == 1 ? ((R & ~31) + perm32(R & 31)) : R);
        RA[i] = R; CA[i] = C; voffB[i] = (unsigned)(Rb * K + C);
#pragma unroll
        for (int h = 0; h < 2; ++h) { va[h][i] = (unsigned)((R + h * HALF) * K + C); vn[h][i] = va[h][i]; } }
    unsigned vplain[2][2];
#pragma unroll
    for (int h = 0; h < 2; ++h)
#pragma unroll
        for (int i = 0; i < 2; ++i) vplain[h][i] = va[h][i];
    const size_t kstep = 128;
    const size_t hstep = (size_t)HALF * K;
    const size_t tstep = 2 * hstep;
    const size_t hstepB = Epi::PERMK == 2 ? (size_t)8 * K : hstep;
    const unsigned ldsw = (unsigned)wid * 1024u;
    const int aoff0 = FP8 ? lds_byte<SH>(wr * 64 + fr, fq * 32) : lds_byte<SH>(wr * 64 + fr, fq * 16), aoff1 = FP8 ? lds_byte<SH>(wr * 64 + fr, fq * 32 + 16) : aoff0 + 1024;
    const int boff0 = FP8 ? lds_byte<SH>(wc * 32 + fr, fq * 32) : lds_byte<SH>(wc * 32 + fr, fq * 16), boff1 = FP8 ? lds_byte<SH>(wc * 32 + fr, fq * 32 + 16) : boff0 + 1024;
#define PG8_SA(b, h) (((b) * 2 + (h)) * HTB)
#define PG8_SB(b, h) ((4 + (b) * 2 + (h)) * HTB)
#define PG8_STAGE(bufoff, gbase, voff) do { _Pragma("unroll") for (int _i = 0; _i < 2; ++_i) \
        __builtin_amdgcn_global_load_lds((const unsigned*)((const char*)(gbase) + (voff)[_i]), (LAS unsigned*)(lds + (bufoff) + ldsw + _i * 8192), 16, 0, 0); } while (0)
#define PG8_LDA(dst, b, h) do { _Pragma("unroll") for (int m = 0; m < 4; ++m) dst[m].ld(lds + PG8_SA(b, h) + aoff0 + m * 2048, lds + PG8_SA(b, h) + aoff1 + m * 2048); } while (0)
#define PG8_LDB(dst, b, h) do { _Pragma("unroll") for (int n = 0; n < 2; ++n) dst[n].ld(lds + PG8_SB(b, h) + boff0 + n * 2048, lds + PG8_SB(b, h) + boff1 + n * 2048); } while (0)
#define PG8_MMA(ai, bj, At, Bt) do { __builtin_amdgcn_s_setprio(1); _Pragma("unroll") for (int m = 0; m < 4; ++m) _Pragma("unroll") for (int n = 0; n < 2; ++n) \
        acc[ai][bj][m][n] = frag_mma(Bt[n], At[m], acc[ai][bj][m][n], sc_w, sc_1); __builtin_amdgcn_s_setprio(0); } while (0)
#define PG8_WAIT_V(n) asm volatile("s_waitcnt vmcnt(" #n ")" ::: "memory")
#define PG8_WAIT_L(n) asm volatile("s_waitcnt lgkmcnt(" #n ")" ::: "memory")
#define PG8_BAR __builtin_amdgcn_s_barrier()
#define PG8_SCHED __builtin_amdgcn_sched_barrier(0)
#define PG8_GATHER_OFFS(dst, ui_, half_) do { _Pragma("unroll") for (int _h = 0; _h < 2; ++_h) _Pragma("unroll") for (int _i = 0; _i < 2; ++_i) \
        dst[_h][_i] = (unsigned)tok[(ui_) * 256 + ((half_) >= 0 ? (half_) * HALF : _h * HALF) + RA[_i]] * (unsigned)K + (unsigned)CA[_i]; } while (0)
#define PG8_PLAIN_OFFS(dst, half_) do { _Pragma("unroll") for (int _i = 0; _i < 2; ++_i) { dst[0][_i] = vplain[0][_i]; dst[1][_i] = (half_) >= 0 ? vplain[0][_i] : vplain[1][_i]; } } while (0)
    Unit cur, nxt; int ui = 0;
    if (!S.next(0, cur)) return;
    f32x4 acc[2][2][4][2];
#define PG8_ACC_INIT(slot_) do { _Pragma("unroll") for (int b = 0; b < 2; ++b) _Pragma("unroll") for (int n = 0; n < 2; ++n) { f32x4 bi_ = (f32x4){0.f, 0.f, 0.f, 0.f}; \
        if constexpr (Epi::HAS_BIAS) bi_ = *(const LAS f32x4*)(lds + BIAS_OFF + (slot_) * 1024 + 4 * Epi::bias_off(b, n, wc, fq)) * Epi::BIAS_MUL; \
        _Pragma("unroll") for (int a = 0; a < 2; ++a) _Pragma("unroll") for (int m = 0; m < 4; ++m) acc[a][b][m][n] = bi_; } } while (0)
    Frag<FP8> At[4], B0[2], B1[2];
    int sc_w = W8_SCALE_E8M0, sc_1 = Epi::ACT_E8M0;
    if constexpr (FP8) { asm volatile("" : "+v"(sc_w), "+v"(sc_1)); }
    const char* cA = GATHER ? (const char*)g.A : (const char*)g.A + (size_t)cur.pm * tstep + (cur.half > 0 ? hstep : 0);
    const char* cB = (const char*)g.Bt + (size_t)cur.bt * tstep;
    if constexpr (GATHER) { PG8_GATHER_OFFS(va, 0, cur.half); } else { PG8_PLAIN_OFFS(va, cur.half); }
#define PG8_BIAS_DMA(unit_, slot_) do { if constexpr (Epi::HAS_BIAS) { if (wid < 4) \
        __builtin_amdgcn_global_load_lds((const unsigned*)E.bias_src(unit_, wid * 64 + lane), (LAS unsigned*)(lds + BIAS_OFF + (slot_) * 1024 + wid * 256), 4, 0, 0); } } while (0)
    PG8_BIAS_DMA(cur, 0);
    PG8_STAGE(PG8_SB(0, 0), cB, voffB); PG8_STAGE(PG8_SB(0, 1), cB + hstepB, voffB); PG8_STAGE(PG8_SA(0, 0), cA, va[0]); PG8_STAGE(PG8_SA(0, 1), cA, va[1]);
    if (wr == 1) PG8_BAR;
    PG8_WAIT_V(2); PG8_BAR;
    PG8_STAGE(PG8_SB(1, 0), cB + kstep, voffB); PG8_STAGE(PG8_SA(1, 0), cA + kstep, va[0]); PG8_STAGE(PG8_SB(1, 1), cB + hstepB + kstep, voffB);
    PG8_WAIT_V(6); PG8_BAR;
    PG8_ACC_INIT(0);
    for (;;) {
        const bool has_next = S.next(ui + 1, nxt);
        const char* nA = GATHER ? (const char*)g.A : (has_next ? (const char*)g.A + (size_t)nxt.pm * tstep + (nxt.half > 0 ? hstep : 0) : cA);
        const char* nB = has_next ? (const char*)g.Bt + (size_t)nxt.bt * tstep : cB;
        if (has_next) { if constexpr (GATHER) { PG8_GATHER_OFFS(vn, ui + 1, nxt.half); } else { PG8_PLAIN_OFFS(vn, nxt.half); } }
        else {
#pragma unroll
            for (int h = 0; h < 2; ++h)
#pragma unroll
                for (int i = 0; i < 2; ++i) vn[h][i] = va[h][i]; }
        const bool full = cur.half < 0;
#pragma nounroll
        for (int t = 0; t < nt; t += 2) {
            const bool last = (t == nt - 2);
            const char* a1 = cA + (size_t)(t + 1) * kstep;
            const char* a2 = last ? nA : cA + (size_t)(t + 2) * kstep; const char* b2 = last ? nB : cB + (size_t)(t + 2) * kstep;
            const char* a3 = a2 + kstep; const char* b3 = b2 + kstep;
            unsigned v0[2], v1[2];
            if (last && has_next) PG8_BIAS_DMA(nxt, (ui + 1) & 1);
#pragma unroll
            for (int i = 0; i < 2; ++i) { v0[i] = last ? vn[0][i] : va[0][i]; v1[i] = last ? vn[1][i] : va[1][i]; }
            PG8_LDB(B0, 0, 0); PG8_LDB(B1, 0, 1); PG8_SCHED; PG8_LDA(At, 0, 0); PG8_STAGE(PG8_SA(1, 1), a1, va[1]);
            PG8_WAIT_V(8); PG8_WAIT_L(0); PG8_BAR; PG8_MMA(0, 0, At, B0); PG8_MMA(0, 1, At, B1); PG8_BAR; PG8_SCHED;
            PG8_LDA(At, 0, 1); PG8_STAGE(PG8_SB(0, 0), b2, voffB); PG8_STAGE(PG8_SB(0, 1), b2 + hstepB, voffB); PG8_STAGE(PG8_SA(0, 0), a2, v0);
            PG8_WAIT_V(8); PG8_WAIT_L(0); PG8_BAR; if (full) { PG8_MMA(1, 0, At, B0); PG8_MMA(1, 1, At, B1); } PG8_BAR; PG8_SCHED;
            PG8_LDB(B0, 1, 0); PG8_LDB(B1, 1, 1); PG8_SCHED; PG8_LDA(At, 1, 0); PG8_STAGE(PG8_SA(0, 1), a2, v1);
            PG8_WAIT_V(8); PG8_WAIT_L(0); PG8_BAR; PG8_MMA(0, 0, At, B0); PG8_MMA(0, 1, At, B1); PG8_BAR; PG8_SCHED;
            PG8_LDA(At, 1, 1); PG8_STAGE(PG8_SB(1, 0), b3, voffB); PG8_STAGE(PG8_SB(1, 1), b3 + hstepB, voffB); PG8_STAGE(PG8_SA(1, 0), a3, v0);
            PG8_WAIT_V(8); PG8_WAIT_L(0); PG8_BAR; if (full) { PG8_MMA(1, 0, At, B0); PG8_MMA(1, 1, At, B1); } PG8_BAR; PG8_SCHED;
        }
        if constexpr (ALIGN_EPI) { if (wr == 0) PG8_BAR; }
        if constexpr (FP8) { asm volatile("s_nop 15\n\ts_nop 7"); PG8_SCHED; }
        E(acc, cur, wr, wc, fr, fq, (const LAS float*)(lds + BIAS_OFF + (ui & 1) * 1024));
        if (!has_next) break;
        PG8_ACC_INIT((ui + 1) & 1);
        cur = nxt; cA = nA; cB = nB; ++ui;
#pragma unroll
        for (int h = 0; h < 2; ++h)
#pragma unroll
            for (int i = 0; i < 2; ++i) va[h][i] = vn[h][i];
        if constexpr (ALIGN_EPI) { if (wr == 1) PG8_BAR; }
    }
    PG8_WAIT_V(0);
    if constexpr (!ALIGN_EPI) { if (wr == 0) PG8_BAR; }
    PG8_BAR;
#undef PG8_SA
#undef PG8_SB
#undef PG8_STAGE
#undef PG8_LDA
#undef PG8_LDB
#undef PG8_MMA
#undef PG8_WAIT_V
#undef PG8_WAIT_L
#undef PG8_BAR
#undef PG8_SCHED
#undef PG8_GATHER_OFFS
#undef PG8_PLAIN_OFFS
#undef PG8_BIAS_DMA
#undef PG8_ACC_INIT
}
}

struct Args { const float* in[24]; float* out; unsigned char* ws; int ph_lo, ph_hi; };
enum { I_X = 0, I_C, I_WADA, I_BADA, I_GPRE, I_WIN, I_GSGU, I_WS, I_BS, I_WGK2, I_BGK, I_GGLA, I_WOUT, I_GPOST, I_GPFFN, I_WR, I_BR, I_WG, I_BG, I_WU, I_BU, I_WDN, I_BDN, I_GPOSTF };

template <bool FP8>
__device__ __forceinline__ void transpose_item(const float* W, int ldw, int k0, int n0, void* WT, size_t dst_row0, LAS float* scr, int lane) {
    f32x4 v[8];
#pragma unroll
    for (int q = 0; q < 8; ++q) v[q] = *(const f32x4*)(W + (size_t)(k0 + 8 * q + (lane >> 3)) * ldw + n0 + 4 * (lane & 7));
#pragma unroll
    for (int q = 0; q < 8; ++q) { LAS float* d = scr + (8 * q + (lane >> 3)) * 33 + 4 * (lane & 7); d[0] = v[q][0]; d[1] = v[q][1]; d[2] = v[q][2]; d[3] = v[q][3]; }
    asm volatile("s_waitcnt lgkmcnt(0)" ::: "memory");
    const int c = lane & 7;
#pragma unroll
    for (int j = 0; j < 4; ++j) { const int n = (lane >> 3) + 8 * j; const LAS float* s = scr + (8 * c) * 33 + n;
        if constexpr (FP8) {
            const u32x2 o = (u32x2){pk4_fp8(s[0 * 33] * W8_SCALE, s[1 * 33] * W8_SCALE, s[2 * 33] * W8_SCALE, s[3 * 33] * W8_SCALE), pk4_fp8(s[4 * 33] * W8_SCALE, s[5 * 33] * W8_SCALE, s[6 * 33] * W8_SCALE, s[7 * 33] * W8_SCALE)};
            *(u32x2*)((unsigned char*)WT + (dst_row0 + n) * 1024 + k0 + 8 * c) = o;
        } else {
            u32x4 o; o.x = pk2(s[0 * 33], s[1 * 33]); o.y = pk2(s[2 * 33], s[3 * 33]); o.z = pk2(s[4 * 33], s[5 * 33]); o.w = pk2(s[6 * 33], s[7 * 33]);
            *(u32x4*)((bf16_t*)WT + (dst_row0 + n) * 1024 + k0 + 8 * c) = o; } }
    asm volatile("s_waitcnt lgkmcnt(0)" ::: "memory");
}
__device__ __forceinline__ void p0_prologue(const Args& a, LAS unsigned char* lds, int G) {
    const int tid = threadIdx.x, lane = tid & 63, wave = __builtin_amdgcn_readfirstlane(tid >> 6);
    const int gw = blockIdx.x * 8 + wave, NGW = G * 8;
    unsigned char* ws = a.ws;
    {
        float* mods = (float*)(ws + WS_MODS);
        const float* c = a.in[I_C]; const float* wa = a.in[I_WADA]; const float* ba = a.in[I_BADA];
        LAS float* sc = (LAS float*)lds;
        LAS float* part = (LAS float*)(lds + 16384);
        if ((int)blockIdx.x < 96) { for (int i = tid; i < 4096; i += 512) sc[i] = silu_(c[i]); __syncthreads(); }
        for (int it = blockIdx.x; it < 96; it += G) {
            const int r = lane >> 4, cq = lane & 15, k0 = wave * 128;
            const float* wp = wa + (size_t)(k0 + r) * 6144 + it * 64 + 4 * cq;
            f32x4 wv[32];
#pragma unroll
            for (int i = 0; i < 32; ++i) wv[i] = __builtin_nontemporal_load((const f32x4*)(wp + (size_t)(4 * i) * 6144));
            f32x4 acc[4];
#pragma unroll
            for (int b = 0; b < 4; ++b) acc[b] = (f32x4){0.f, 0.f, 0.f, 0.f};
#pragma unroll
            for (int i = 0; i < 32; ++i)
#pragma unroll
                for (int b = 0; b < 4; ++b) acc[b] += wv[i] * sc[b * 1024 + k0 + 4 * i + r];
#pragma unroll
            for (int b = 0; b < 4; ++b)
#pragma unroll
                for (int e2 = 0; e2 < 4; ++e2) { float t = acc[b][e2]; t += __shfl_xor(t, 16); t += __shfl_xor(t, 32); acc[b][e2] = t; }
            if (lane < 16) {
#pragma unroll
                for (int b = 0; b < 4; ++b) *(LAS f32x4*)(part + (wave * 4 + b) * 64 + 4 * cq) = acc[b]; }
            __syncthreads();
            if (tid < 256) { const int b = tid >> 6, cc = tid & 63; float sv = ba[it * 64 + cc];
#pragma unroll
                for (int w = 0; w < 8; ++w) sv += part[(w * 4 + b) * 64 + cc];
                mods[b * 6144 + it * 64 + cc] = sv; }
            __syncthreads();
        }
    }
    {
        const float* wr = a.in[I_WR]; bf16_t* wh = (bf16_t*)(ws + WS_WR); bf16_t* wl = wh + 32 * 1024;
        for (int idx = blockIdx.x * 512 + tid; idx < 32768; idx += G * 512) { const int k = idx >> 5, j = idx & 31; const float w = wr[idx];
            const unsigned h = f2bf(w); wh[j * 1024 + k] = (bf16_t)h; wl[j * 1024 + k] = (bf16_t)f2bf(w - bf2f(h)); }
    }
    {
        LAS float* scr = (LAS float*)(lds + wave * 16384);
        constexpr int I_IN = 16 * 80, I_OUT = 16 * 32, I_E = 16 * 32;
        constexpr int NITEMS = I_IN + I_OUT + 3 * NE * I_E;
        bf16_t* Win = (bf16_t*)(ws + WS_WIN); bf16_t* Wout = (bf16_t*)(ws + WS_WOUT);
        (void)NITEMS;
        for (int it = gw; it < I_IN + I_OUT; it += NGW) {
            int r = it;
            if (r < I_IN) { const int kb = r / 80, nb = r % 80; transpose_item<false>(a.in[I_WIN], D_IN, 64 * kb, 32 * nb, Win, (size_t)(32 * nb), scr, lane); continue; } r -= I_IN;
            { const int kb = r / 32, nb = r % 32; transpose_item<false>(a.in[I_WOUT], 1024, 64 * kb, 32 * nb, Wout, (size_t)(32 * nb), scr, lane); }
        }
    }
}

constexpr int MOE_ITEMS = 3 * NE * 256;
__device__ __forceinline__ void moe_convert(const Args& a, LAS unsigned char* lds, int G, int first, int last) {
    (void)lds;
    const int tid = threadIdx.x, lane = tid & 63, wave = __builtin_amdgcn_readfirstlane(tid >> 6);
    const int gw = blockIdx.x * 8 + wave, NGW = G * 8;
    unsigned char* Wd = a.ws + WS_WD; unsigned char* W1 = a.ws + WS_W1;
    constexpr int I_E8 = 8 * 32;
#define MC_DECODE(it_, src_, dst_) do { int r = (it_); const int mat = r / (NE * I_E8); r -= mat * (NE * I_E8); const int e = r / I_E8; r -= e * I_E8; \
        const int nb = 8 * (r >> 6) + (r & 7), kb = (r >> 3) & 7, n0 = 32 * nb, k0 = 128 * kb; \
        const float* Wm = (mat == 0 ? a.in[I_WG] : (mat == 1 ? a.in[I_WU] : a.in[I_WDN])) + (size_t)e * 1048576; \
        const size_t drow = (mat == 2) ? (size_t)e * 1024 + n0 : (size_t)e * 2048 + (size_t)(n0 >> 7) * 256 + (size_t)mat * 128 + (size_t)(n0 & 127); \
        dst_ = (mat == 2 ? Wd : W1) + (drow + 4 * (lane & 7)) * 1024 + k0 + 16 * (lane >> 3); src_ = Wm + (size_t)(k0 + 16 * (lane >> 3)) * 1024 + n0 + 4 * (lane & 7); } while (0)
#define MC_LOAD(vv, src_) do { _Pragma("unroll") for (int q = 0; q < 16; ++q) vv[q] = __builtin_nontemporal_load((const f32x4*)((src_) + (size_t)q * 1024)); } while (0)
#define MC_PROC(vv, dst_) do { u32x4 o_[4]; \
        _Pragma("unroll") for (int g4 = 0; g4 < 4; ++g4) { unsigned D_[4]; \
            _Pragma("unroll") for (int q = 0; q < 4; ++q) { const f32x4 t_ = vv[4 * g4 + q] * W8_SCALE; D_[q] = pk4_fp8(t_[0], t_[1], t_[2], t_[3]); } \
            const unsigned pa = __builtin_amdgcn_perm(D_[1], D_[0], 0x05010400u), pb = __builtin_amdgcn_perm(D_[1], D_[0], 0x07030602u); \
            const unsigned pc = __builtin_amdgcn_perm(D_[3], D_[2], 0x05010400u), pd = __builtin_amdgcn_perm(D_[3], D_[2], 0x07030602u); \
            o_[0][g4] = __builtin_amdgcn_perm(pc, pa, 0x05040100u); o_[1][g4] = __builtin_amdgcn_perm(pc, pa, 0x07060302u); \
            o_[2][g4] = __builtin_amdgcn_perm(pd, pb, 0x05040100u); o_[3][g4] = __builtin_amdgcn_perm(pd, pb, 0x07060302u); } \
        _Pragma("unroll") for (int j = 0; j < 4; ++j) __builtin_nontemporal_store(o_[j], (u32x4*)((dst_) + (size_t)j * 1024)); } while (0)
    int it = first + gw;
    if (it < last) {
        const int nmine = (last - 1 - it) / NGW;
        const int itlast = it + nmine * NGW;
        const float* sA; unsigned char* dA; const float* sB; unsigned char* dB; f32x4 v[16], w[16];
        MC_DECODE(it, sA, dA); MC_LOAD(v, sA);
        for (; it < last; it += 2 * NGW) {
            const int itb = (it + NGW <= itlast) ? it + NGW : itlast, ita = (it + 2 * NGW <= itlast) ? it + 2 * NGW : itlast;
            MC_DECODE(itb, sB, dB); MC_LOAD(w, sB);
            MC_PROC(v, dA);
            MC_DECODE(ita, sA, dA); MC_LOAD(v, sA);
            MC_PROC(w, dB);
        }
    }
#undef MC_DECODE
#undef MC_LOAD
#undef MC_PROC
}

__device__ __forceinline__ void p1_norm(const Args& a, LAS unsigned char* lds, int G) {
    const int tid = threadIdx.x, lane = tid & 63, wave = __builtin_amdgcn_readfirstlane(tid >> 6);
    const float* x = a.in[I_X]; const float* win = a.in[I_WIN]; const float* gpre = a.in[I_GPRE];
    const float* mods = (const float*)(a.ws + WS_MODS);
    bf16_t* XN = (bf16_t*)(a.ws + WS_XN); float* glow = (float*)(a.ws + WS_GLOW);
    constexpr int NP1 = 1032;
    LAS bf16_t* NT = (LAS bf16_t*)lds; LAS float* RP = (LAS float*)(lds + 16 * NP1 * 2);
    bf16x8 wg[4];
#pragma unroll
    for (int ks = 0; ks < 4; ++ks)
#pragma unroll
        for (int e = 0; e < 8; ++e) { const int k = 128 * wave + 32 * ks + 8 * (lane >> 4) + e; wg[ks][e] = (short)f2bf(win[(size_t)k * D_IN + C_GL + (lane & 15)]); }
    for (int blk = blockIdx.x; blk < T / 128; blk += G) {
        const int b = (blk * 128) / SEQ;
        f32x4 A1[4], B1[4];
#pragma unroll
        for (int j = 0; j < 4; ++j) { const int k = 4 * lane + 256 * j; const f32x4 gv = *(const f32x4*)(gpre + k), sc = *(const f32x4*)(mods + b * 6144 + 1024 + k);
            A1[j] = gv * (sc + 1.0f); B1[j] = *(const f32x4*)(mods + b * 6144 + k); }
        f32x4 nx[4][4];
#define P1_ROWOF(q_) ((size_t)(blk * 128 + 16 * ((q_) >> 1) + 2 * wave + ((q_) & 1)))
#pragma unroll
        for (int d = 0; d < 4; ++d) { const size_t row = P1_ROWOF(d);
#pragma unroll
          for (int j = 0; j < 4; ++j) nx[d][j] = __builtin_nontemporal_load((const f32x4*)(x + row * 1024 + 4 * lane + 256 * j)); }
        for (int it0 = 0; it0 < 8; it0 += 2) {
#pragma unroll
          for (int iu = 0; iu < 2; ++iu) {
            const int it = it0 + iu;
#pragma unroll
            for (int rr = 0; rr < 2; ++rr) {
                const int r16 = 2 * wave + rr, q = 2 * it + rr, sl = 2 * iu + rr; const size_t row = P1_ROWOF(q);
                const int qn = q + 4 < 16 ? q + 4 : 15; const size_t rown = P1_ROWOF(qn);
                f32x4 v[4]; float ss = 0.f;
#pragma unroll
                for (int j = 0; j < 4; ++j) { v[j] = nx[sl][j]; ss += (v[j][0] * v[j][0] + v[j][1] * v[j][1]) + (v[j][2] * v[j][2] + v[j][3] * v[j][3]); }
#pragma unroll
                for (int j = 0; j < 4; ++j) nx[sl][j] = __builtin_nontemporal_load((const f32x4*)(x + rown * 1024 + 4 * lane + 256 * j));
                const float rstd = __builtin_amdgcn_rsqf(wave_sum(ss) * (1.0f / 1024.0f) + EPS);
#pragma unroll
                for (int j = 0; j < 4; ++j) { v[j] = v[j] * rstd * A1[j] + B1[j];
                    const u32x2 w = (u32x2){pk2(v[j][0], v[j][1]), pk2(v[j][2], v[j][3])};
                    *(u32x2*)(XN + row * 1024 + 4 * lane + 256 * j) = w; *(LAS u32x2*)(NT + r16 * NP1 + 4 * lane + 256 * j) = w; }
            }
            LDS_BARRIER();
            {
                f32x4 acc = (f32x4){0.f, 0.f, 0.f, 0.f};
#pragma unroll
                for (int ks = 0; ks < 4; ++ks) { const bf16x8 av = *(const LAS bf16x8*)(NT + (lane & 15) * NP1 + 128 * wave + 32 * ks + 8 * (lane >> 4)); acc = mfma16(av, wg[ks], acc); }
#pragma unroll
                for (int r = 0; r < 4; ++r) RP[wave * 256 + (4 * (lane >> 4) + r) * 16 + (lane & 15)] = acc[r];
            }
            LDS_BARRIER();
            if (tid < 256) { float sv = 0.f;
#pragma unroll
                for (int w = 0; w < 8; ++w) sv += RP[w * 256 + tid];
                glow[((size_t)blk * 128 + 16 * it) * 16 + tid] = sv; }
          }
        }
#undef P1_ROWOF
        LDS_BARRIER();
    }
}

__device__ __forceinline__ unsigned lo_pair(unsigned a, unsigned b) { return (a & 0xffffu) | (b << 16); }
__device__ __forceinline__ unsigned hi_pair(unsigned a, unsigned b) { return (a >> 16) | (b & 0xffff0000u); }
constexpr int VP32 = 68;
__device__ __forceinline__ void p3_sgu(const Args& a, LAS unsigned char* lds, int G) {
    const int tid = threadIdx.x, lane = tid & 63, wave = __builtin_amdgcn_readfirstlane(tid >> 6);
    const bf16_t* PROJ = (const bf16_t*)(a.ws + WS_PROJ); bf16_t* MIXA = (bf16_t*)(a.ws + WS_XN);
    const int nper = G / 8;
    const int h = blockIdx.x & 7, sub = blockIdx.x >> 3;
    if (sub >= nper) return;
    const int t = 16 * wave + (lane & 15);
    bf16x8 wf[4];
#pragma unroll
    for (int ks = 0; ks < 4; ++ks) { const float* wrow = a.in[I_WS] + ((size_t)h * 128 + t) * 128 + 32 * ks + 8 * (lane >> 4);
#pragma unroll
        for (int e2 = 0; e2 < 8; ++e2) { const int s = 32 * ks + 8 * (lane >> 4) + e2; const float w = (s <= t) ? wrow[e2] : 0.f; wf[ks][e2] = (short)f2bf(w); } }
    const float bias = a.in[I_BS][h * 128 + t];
    const int token = tid >> 2, part = tid & 3, odd = token & 1;
    float gs[16];
#pragma unroll
    for (int j = 0; j < 16; ++j) gs[j] = a.in[I_GSGU][h * 64 + part * 16 + j];
    u32x4 nr0, nr1; u32x2 nu[4];
#define SGU_LOAD(idx_) do { const int tok0_ = ((idx_) >> 6) * SEQ + ((idx_) & 63) * 128; \
        const bf16_t* src_ = PROJ + (size_t)(tok0_ + token) * NPROJ + C_VS + h * 64 + part * 16; nr0 = *(const u32x4*)src_; nr1 = *(const u32x4*)(src_ + 8); \
        _Pragma("unroll") for (int dt = 0; dt < 4; ++dt) nu[dt] = *(const u32x2*)(PROJ + (size_t)(tok0_ + t) * NPROJ + C_US + h * 64 + 16 * dt + 4 * (lane >> 4)); } while (0)
    SGU_LOAD(sub);
    int buf = 0;
    for (int idx = sub; idx < 256; idx += nper, buf ^= 1) {
        LAS unsigned* vhT = (LAS unsigned*)(lds + buf * (64 * VP32 * 4));
        const int tok0 = (idx >> 6) * SEQ + (idx & 63) * 128;
        const u32x4 r0 = nr0, r1 = nr1; u32x2 uu[4];
#pragma unroll
        for (int dt = 0; dt < 4; ++dt) uu[dt] = nu[dt];
        { const int idn = (idx + nper < 256) ? idx + nper : idx; SGU_LOAD(idn); }
        float v[16];
#pragma unroll
        for (int i = 0; i < 4; ++i) { v[2 * i] = bflo(r0[i]); v[2 * i + 1] = bfhi(r0[i]); v[8 + 2 * i] = bflo(r1[i]); v[8 + 2 * i + 1] = bfhi(r1[i]); }
        float ss = 0.f;
#pragma unroll
        for (int j = 0; j < 16; ++j) ss += v[j] * v[j];
        ss += __shfl_xor(ss, 1); ss += __shfl_xor(ss, 2);
        const float rstd = __builtin_amdgcn_rsqf(ss * (1.0f / 64.0f) + EPS);
        unsigned pw[8];
#pragma unroll
        for (int i = 0; i < 8; ++i) pw[i] = pk2(v[2 * i] * rstd * gs[2 * i], v[2 * i + 1] * rstd * gs[2 * i + 1]);
#pragma unroll
        for (int i = 0; i < 4; ++i) {
            const unsigned snd = odd ? pw[i] : pw[4 + i], own = odd ? pw[4 + i] : pw[i], rcv = (unsigned)__shfl_xor((int)snd, 4);
            const unsigned first = odd ? rcv : own, second = odd ? own : rcv;
            const int d = 16 * part + 8 * odd + 2 * i;
            vhT[d * VP32 + ((token >> 1) ^ (4 * (d >> 4)))] = lo_pair(first, second);
            vhT[(d + 1) * VP32 + ((token >> 1) ^ (4 * (d >> 4)))] = hi_pair(first, second); }
        LDS_BARRIER();
        f32x4 acc[4];
#pragma unroll
        for (int dt = 0; dt < 4; ++dt) acc[dt] = (f32x4){0.f, 0.f, 0.f, 0.f};
#pragma unroll
        for (int ks = 0; ks < 4; ++ks) if (ks <= (wave >> 1)) {
#pragma unroll
            for (int dt = 0; dt < 4; ++dt) { const bf16x8 av = *(const LAS bf16x8*)(vhT + (16 * dt + (lane & 15)) * VP32 + ((16 * ks + 4 * (lane >> 4)) ^ (4 * dt))); acc[dt] = mfma16(av, wf[ks], acc[dt]); } }
        const size_t trow = (size_t)(tok0 + t);
#pragma unroll
        for (int dt = 0; dt < 4; ++dt) { const int d = 16 * dt + 4 * (lane >> 4);
            const float o0 = bflo(uu[dt][0]) * (acc[dt][0] + bias), o1 = bfhi(uu[dt][0]) * (acc[dt][1] + bias), o2 = bflo(uu[dt][1]) * (acc[dt][2] + bias), o3 = bfhi(uu[dt][1]) * (acc[dt][3] + bias);
            *(u32x2*)(MIXA + trow * 1024 + h * 64 + d) = (u32x2){pk2(o0, o1), pk2(o2, o3)}; }
    }
#undef SGU_LOAD
}

constexpr int GP32 = 36;
constexpr int GP = 72;
constexpr int GL_WG2 = 0  , GL_WT = 4096  , GL_A = 6144  , GL_B = GL_A + 9216  , GL_VT = GL_B + 9216  ,
              GL_PM = GL_VT + 18432  , GL_RS = GL_PM + 9216  ;
__device__ __forceinline__ void gla_decay(const LAS float* wg2, LAS float* WT, const float (&bgk)[8], f32x2 g2, int lane, int wave, float (&bc)[8], float (&tot)[8]) {
    const int a8 = (lane & 7) * 8, base = lane & ~7;
    f32x2 xp[4];
#pragma unroll
    for (int e = 0; e < 4; ++e) xp[e] = (f32x2){bgk[2 * e], bgk[2 * e + 1]};
#pragma unroll
    for (int j = 0; j < 8; ++j) { const float x0 = __shfl(g2[0], base + j), x1 = __shfl(g2[1], base + j);
        const f32x4 w00 = *(const LAS f32x4*)(wg2 + (2 * j) * 64 + a8), w01 = *(const LAS f32x4*)(wg2 + (2 * j) * 64 + a8 + 4);
        const f32x4 w10 = *(const LAS f32x4*)(wg2 + (2 * j + 1) * 64 + a8), w11 = *(const LAS f32x4*)(wg2 + (2 * j + 1) * 64 + a8 + 4);
        xp[0] += (f32x2){w00[0], w00[1]} * x0; xp[1] += (f32x2){w00[2], w00[3]} * x0; xp[2] += (f32x2){w01[0], w01[1]} * x0; xp[3] += (f32x2){w01[2], w01[3]} * x0;
        xp[0] += (f32x2){w10[0], w10[1]} * x1; xp[1] += (f32x2){w10[2], w10[3]} * x1; xp[2] += (f32x2){w11[0], w11[1]} * x1; xp[3] += (f32x2){w11[2], w11[3]} * x1; }
    float la[8];
#pragma unroll
    for (int e = 0; e < 8; ++e) { const float xx = xp[e >> 1][e & 1];
        la[e] = (fminf(xx, 0.f) - 0.6931471806f * __builtin_amdgcn_logf(1.0f + __builtin_amdgcn_exp2f(-1.4426950409f * fabsf(xx)))) * (1.0f / 16.0f); }
#pragma unroll
    for (int off = 8; off < 64; off <<= 1) {
#pragma unroll
        for (int e = 0; e < 8; ++e) { const float tv = __shfl_up(la[e], off); if (lane >= off) la[e] += tv; } }
    if (lane >= 56) { *(LAS f32x4*)(WT + wave * 64 + a8) = (f32x4){la[0], la[1], la[2], la[3]}; *(LAS f32x4*)(WT + wave * 64 + a8 + 4) = (f32x4){la[4], la[5], la[6], la[7]}; }
    LDS_BARRIER();
    float off8[8];
#pragma unroll
    for (int e = 0; e < 8; ++e) { off8[e] = 0.f; tot[e] = 0.f; }
#pragma unroll
    for (int w = 0; w < 8; ++w) { const f32x4 t0 = *(const LAS f32x4*)(WT + w * 64 + a8), t1 = *(const LAS f32x4*)(WT + w * 64 + a8 + 4);
#pragma unroll
        for (int e = 0; e < 4; ++e) { tot[e] += t0[e]; tot[4 + e] += t1[e]; if (w < wave) { off8[e] += t0[e]; off8[4 + e] += t1[e]; } } }
#pragma unroll
    for (int e = 0; e < 8; ++e) bc[e] = la[e] + off8[e];
}
__device__ __forceinline__ void gla_vt_write(LAS unsigned* VT, u32x4 v0, u32x4 v1, int lane, int wave) {
    const int cl = lane >> 3, a = lane & 7, odd = cl & 1, dcol = 4 * wave + (cl >> 1);
#pragma unroll
    for (int i = 0; i < 4; ++i) {
        const unsigned snd = odd ? v0[i] : v1[i], own = odd ? v1[i] : v0[i], rcv = (unsigned)__shfl_xor((int)snd, 8);
        const unsigned first = odd ? rcv : own, second = odd ? own : rcv;
        const int v = 16 * a + 8 * odd + 2 * i;
        VT[v * GP32 + (dcol ^ (4 * a))] = lo_pair(first, second);
        VT[(v + 1) * GP32 + (dcol ^ (4 * a))] = hi_pair(first, second); }
}

__device__ __forceinline__ void p3_gla_state(const Args& a, LAS unsigned char* lds, int G) {
    const int tid = threadIdx.x, lane = tid & 63, wave = __builtin_amdgcn_readfirstlane(tid >> 6);
    const bf16_t* PROJ = (const bf16_t*)(a.ws + WS_PROJ); bf16_t* ST = (bf16_t*)(a.ws + WS_ST); float* DEC = (float*)(a.ws + WS_DEC); const float* glow = (const float*)(a.ws + WS_GLOW); float* BCUM = (float*)(a.ws + WS_BCUM);
    LAS float* wg2 = (LAS float*)(lds + GL_WG2); LAS float* WT = (LAS float*)(lds + GL_WT);
    LAS unsigned* KDT = (LAS unsigned*)(lds + GL_A); LAS unsigned* VT = (LAS unsigned*)(lds + GL_VT);
    const int c = tid >> 3, a8 = (tid & 7) * 8, v16 = (tid & 7) * 16, cl = lane >> 3, odd = cl & 1;
    int cur_h = -1; float bgk[8];
    f32x2 ng2; u32x4 nkr, nv0, nv1;
#define ST_LOAD(idx_) do { const int bh_ = (idx_) & 15, n_ = (idx_) >> 4, tok0_ = (bh_ >> 2) * SEQ + n_ * 64, h_ = bh_ & 3; \
        ng2 = *(const f32x2*)(glow + (size_t)tok0_ * 16 + 2 * tid); nkr = *(const u32x4*)(PROJ + (size_t)(tok0_ + c) * NPROJ + C_K + h_ * 64 + a8); \
        const bf16_t* vs_ = PROJ + (size_t)(tok0_ + c) * NPROJ + C_V + h_ * 128 + v16; nv0 = *(const u32x4*)vs_; nv1 = *(const u32x4*)(vs_ + 8); } while (0)
    if ((int)blockIdx.x < 2048) ST_LOAD((int)blockIdx.x);
    for (int idx = blockIdx.x; idx < 2048; idx += G) {
        const int bh = idx & 15, n = idx >> 4, h = bh & 3, su = bh * 128 + n;
        if (h != cur_h) {
            LDS_BARRIER();
            for (int i = tid; i < 1024; i += 512) wg2[i] = a.in[I_WGK2][(i >> 6) * 256 + h * 64 + (i & 63)];
#pragma unroll
            for (int e = 0; e < 8; ++e) bgk[e] = a.in[I_BGK][h * 64 + a8 + e];
            cur_h = h; LDS_BARRIER(); }
        const f32x2 g2 = ng2; const u32x4 kr = nkr, v0 = nv0, v1 = nv1;
        { const int idn = (idx + G < 2048) ? idx + G : idx; ST_LOAD(idn); }
        float bc[8], tot[8];
        gla_decay(wg2, WT, bgk, g2, lane, wave, bc, tot);
        { float* bp = BCUM + (size_t)((bh >> 2) * SEQ + n * 64 + c) * 256 + h * 64 + a8; *(f32x4*)bp = (f32x4){bc[0], bc[1], bc[2], bc[3]}; *(f32x4*)(bp + 4) = (f32x4){bc[4], bc[5], bc[6], bc[7]}; }
        {
            unsigned pw[4];
#pragma unroll
            for (int i = 0; i < 4; ++i) pw[i] = pk2(bflo(kr[i]) * __expf(tot[2 * i] - bc[2 * i]), bfhi(kr[i]) * __expf(tot[2 * i + 1] - bc[2 * i + 1]));
            const int dcol = 4 * wave + (cl >> 1);
#pragma unroll
            for (int i = 0; i < 2; ++i) {
                const unsigned snd = odd ? pw[i] : pw[2 + i], own = odd ? pw[2 + i] : pw[i], rcv = (unsigned)__shfl_xor((int)snd, 8);
                const unsigned first = odd ? rcv : own, second = odd ? own : rcv;
                const int d = a8 + 4 * odd + 2 * i;
                KDT[d * GP32 + (dcol ^ (4 * (d >> 4)))] = lo_pair(first, second);
                KDT[(d + 1) * GP32 + (dcol ^ (4 * (d >> 4)))] = hi_pair(first, second); }
            gla_vt_write(VT, v0, v1, lane, wave);
            if (tid < 8) { float* dp = DEC + (size_t)su * 64 + a8; *(f32x4*)dp = (f32x4){__expf(tot[0]), __expf(tot[1]), __expf(tot[2]), __expf(tot[3])}; *(f32x4*)(dp + 4) = (f32x4){__expf(tot[4]), __expf(tot[5]), __expf(tot[6]), __expf(tot[7])}; }
        }
        LDS_BARRIER();
        {
            f32x4 acc[4];
#pragma unroll
            for (int dt = 0; dt < 4; ++dt) acc[dt] = (f32x4){0.f, 0.f, 0.f, 0.f};
#pragma unroll
            for (int ks = 0; ks < 2; ++ks) { const int dc = 16 * ks + 4 * (lane >> 4);
                const bf16x8 bv = *(const LAS bf16x8*)(VT + (16 * wave + (lane & 15)) * GP32 + (dc ^ (4 * wave)));
#pragma unroll
                for (int dt = 0; dt < 4; ++dt) { const bf16x8 av = *(const LAS bf16x8*)(KDT + (16 * dt + (lane & 15)) * GP32 + (dc ^ (4 * dt))); acc[dt] = mfma16(av, bv, acc[dt]); } }
            bf16_t* dst = ST + ((size_t)su * 128 + 16 * wave + (lane & 15)) * 64 + 4 * (lane >> 4);
#pragma unroll
            for (int dt = 0; dt < 4; ++dt) *(u32x2*)(dst + 16 * dt) = (u32x2){pk2(acc[dt][0], acc[dt][1]), pk2(acc[dt][2], acc[dt][3])};
        }
    }
#undef ST_LOAD
}

__device__ __forceinline__ void p4_scan(const Args& a, int G) {
    const bf16_t* ST = (const bf16_t*)(a.ws + WS_ST); const float* DEC = (const float*)(a.ws + WS_DEC); bf16_t* PREV = (bf16_t*)(a.ws + WS_PREV);
    for (int gid = blockIdx.x * 512 + threadIdx.x; gid < 131072; gid += G * 512) {
        const int bh = gid >> 13, rem = gid & 8191;
        float s0 = 0.f;
        for (int n0 = 0; n0 < 128; n0 += 16) {
            float st[16], dc[16];
#pragma unroll
            for (int j = 0; j < 16; ++j) { const size_t su = (size_t)bh * 128 + n0 + j; st[j] = bf2f(ST[su * 8192 + rem]); dc[j] = DEC[su * 64 + (rem & 63)]; }
#pragma unroll
            for (int j = 0; j < 16; ++j) { const size_t su = (size_t)bh * 128 + n0 + j; PREV[su * 8192 + rem] = (bf16_t)f2bf(s0); s0 = dc[j] * s0 + st[j]; }
        }
    }
}

__device__ __forceinline__ void p5_gla_out(const Args& a, LAS unsigned char* lds, int G) {
    const int tid = threadIdx.x, lane = tid & 63, wave = __builtin_amdgcn_readfirstlane(tid >> 6);
    const bf16_t* PROJ = (const bf16_t*)(a.ws + WS_PROJ); const bf16_t* PREV = (const bf16_t*)(a.ws + WS_PREV); bf16_t* MIXA = (bf16_t*)(a.ws + WS_XN); const float* glow = (const float*)(a.ws + WS_GLOW);
    const float* BCUM = (const float*)(a.ws + WS_BCUM);
    LAS bf16_t* QS = (LAS bf16_t*)(lds + GL_A); LAS bf16_t* KS = (LAS bf16_t*)(lds + GL_B); LAS unsigned* VT = (LAS unsigned*)(lds + GL_VT); LAS bf16_t* PM = (LAS bf16_t*)(lds + GL_PM);
    LAS float* RS = (LAS float*)(lds + GL_RS);
    const int c = tid >> 3, a8 = (tid & 7) * 8, v16 = (tid & 7) * 16;
    const int it = wave >> 1, vh = wave & 1;
    f32x4 nb0, nb1; u32x4 nqr, nkr, nv0, nv1;
#define GO_LOAD(idx_) do { const int bh_ = (idx_) & 15, n_ = (idx_) >> 4, tok0_ = (bh_ >> 2) * SEQ + n_ * 64, h_ = bh_ & 3; \
        { const float* bp_ = BCUM + (size_t)(tok0_ + c) * 256 + h_ * 64 + a8; nb0 = *(const f32x4*)bp_; nb1 = *(const f32x4*)(bp_ + 4); } \
        nqr = *(const u32x4*)(PROJ + (size_t)(tok0_ + c) * NPROJ + C_Q + h_ * 64 + a8); nkr = *(const u32x4*)(PROJ + (size_t)(tok0_ + c) * NPROJ + C_K + h_ * 64 + a8); \
        const bf16_t* vs_ = PROJ + (size_t)(tok0_ + c) * NPROJ + C_V + h_ * 128 + v16; nv0 = *(const u32x4*)vs_; nv1 = *(const u32x4*)(vs_ + 8); } while (0)
#define GO_LOAD2(idx_) do { const int bh_ = (idx_) & 15, n_ = (idx_) >> 4, tok0_ = (bh_ >> 2) * SEQ + n_ * 64, h_ = bh_ & 3, su_ = bh_ * 128 + n_; \
        _Pragma("unroll") for (int vt = 0; vt < 4; ++vt) { const int vrow_ = 16 * (4 * vh + vt) + (lane & 15); \
            _Pragma("unroll") for (int ks = 0; ks < 2; ++ks) pv[vt][ks] = *(const bf16x8*)(PREV + ((size_t)su_ * 128 + vrow_) * 64 + 32 * ks + 8 * (lane >> 4)); \
            rr[vt] = *(const u32x2*)(PROJ + (size_t)(tok0_ + 16 * it + (lane & 15)) * NPROJ + C_R + h_ * 128 + 16 * (4 * vh + vt) + 4 * (lane >> 4)); } } while (0)
    if ((int)blockIdx.x < 2048) GO_LOAD((int)blockIdx.x);
    for (int idx = blockIdx.x; idx < 2048; idx += G) {
        const int bh = idx & 15, n = idx >> 4, b = bh >> 2, h = bh & 3, tok0 = b * SEQ + n * 64;
        const f32x4 b0 = nb0, b1 = nb1; const u32x4 qr = nqr, kr = nkr, v0 = nv0, v1 = nv1; bf16x8 pv[4][2]; u32x2 rr[4];
        { const int idn = (idx + G < 2048) ? idx + G : idx; GO_LOAD(idn); }
        GO_LOAD2(idx);
        const float bc[8] = {b0[0], b0[1], b0[2], b0[3], b1[0], b1[1], b1[2], b1[3]};
        {
            u32x4 qo, ko;
#pragma unroll
            for (int i = 0; i < 4; ++i) { const float e0 = __expf(bc[2 * i]), e1 = __expf(bc[2 * i + 1]);
                qo[i] = pk2(bflo(qr[i]) * e0, bfhi(qr[i]) * e1); ko[i] = pk2(bflo(kr[i]) * __builtin_amdgcn_rcpf(e0), bfhi(kr[i]) * __builtin_amdgcn_rcpf(e1)); }
            *(LAS u32x4*)(QS + c * GP + a8) = qo; *(LAS u32x4*)(KS + c * GP + a8) = ko;
            gla_vt_write(VT, v0, v1, lane, wave);
        }
        LDS_BARRIER();
        {
#pragma unroll
            for (int q = 0; q < 2; ++q) { const int jt = 2 * (wave & 1) + q; f32x4 s = (f32x4){0.f, 0.f, 0.f, 0.f};
                if (jt <= it) {
#pragma unroll
                    for (int ks = 0; ks < 2; ++ks) { const bf16x8 av = *(const LAS bf16x8*)(KS + (16 * jt + (lane & 15)) * GP + 32 * ks + 8 * (lane >> 4));
                        const bf16x8 bv = *(const LAS bf16x8*)(QS + (16 * it + (lane & 15)) * GP + 32 * ks + 8 * (lane >> 4)); s = mfma16(av, bv, s); } }
                const int i = 16 * it + (lane & 15), j0 = 16 * jt + 4 * (lane >> 4);
                const float p0 = (j0 <= i) ? s[0] : 0.f, p1 = (j0 + 1 <= i) ? s[1] : 0.f, p2 = (j0 + 2 <= i) ? s[2] : 0.f, p3 = (j0 + 3 <= i) ? s[3] : 0.f;
                *(LAS u32x2*)(PM + i * GP + j0) = (u32x2){pk2(p0, p1), pk2(p2, p3)}; }
        }
        LDS_BARRIER();
        f32x4 acc[4];
#pragma unroll
        for (int vt = 0; vt < 4; ++vt) { acc[vt] = (f32x4){0.f, 0.f, 0.f, 0.f}; const int vrow = 16 * (4 * vh + vt) + (lane & 15), vsw = 4 * (4 * vh + vt);
#pragma unroll
            for (int ks = 0; ks < 2; ++ks) { const bf16x8 av = *(const LAS bf16x8*)(VT + vrow * GP32 + ((16 * ks + 4 * (lane >> 4)) ^ vsw));
                const bf16x8 bv = *(const LAS bf16x8*)(PM + (16 * it + (lane & 15)) * GP + 32 * ks + 8 * (lane >> 4)); acc[vt] = mfma16(av, bv, acc[vt]); }
#pragma unroll
            for (int ks = 0; ks < 2; ++ks) { const bf16x8 bv = *(const LAS bf16x8*)(QS + (16 * it + (lane & 15)) * GP + 32 * ks + 8 * (lane >> 4)); acc[vt] = mfma16(pv[vt][ks], bv, acc[vt]); } }
        float ss = 0.f;
#pragma unroll
        for (int vt = 0; vt < 4; ++vt) ss += (acc[vt][0] * acc[vt][0] + acc[vt][1] * acc[vt][1]) + (acc[vt][2] * acc[vt][2] + acc[vt][3] * acc[vt][3]);
        ss += __shfl_xor(ss, 16); ss += __shfl_xor(ss, 32);
        if (lane < 16) RS[wave * 16 + lane] = ss;
        LDS_BARRIER();
        const float tsum = RS[wave * 16 + (lane & 15)] + RS[(wave ^ 1) * 16 + (lane & 15)];
        const float rstd = __builtin_amdgcn_rsqf(tsum * (1.0f / 128.0f) + EPS);
        const size_t trow = (size_t)(tok0 + 16 * it + (lane & 15));
#pragma unroll
        for (int vt = 0; vt < 4; ++vt) { const int v = 16 * (4 * vh + vt) + 4 * (lane >> 4);
            const f32x4 gg = *(const f32x4*)(a.in[I_GGLA] + v);
            const float o0 = acc[vt][0] * rstd * gg[0] * bflo(rr[vt][0]), o1 = acc[vt][1] * rstd * gg[1] * bfhi(rr[vt][0]), o2 = acc[vt][2] * rstd * gg[2] * bflo(rr[vt][1]), o3 = acc[vt][3] * rstd * gg[3] * bfhi(rr[vt][1]);
            *(u32x2*)(MIXA + trow * 1024 + 512 + h * 128 + v) = (u32x2){pk2(o0, o1), pk2(o2, o3)}; }
    }
#undef GO_LOAD
#undef GO_LOAD2
}

constexpr int NP = 1032;
constexpr int P7_NH = 0, P7_NL = 16 * NP * 2, P7_RP = 2 * 16 * NP * 2, P7_ENT = P7_RP + 16384, P7_CNT = P7_ENT + 3 * 2048, P7_BASE = P7_CNT + 128, P7_LG = P7_BASE + 128  ;
__device__ __forceinline__ void p7_router(const Args& a, LAS unsigned char* lds, int G) {
    const int tid = threadIdx.x, lane = tid & 63, wave = __builtin_amdgcn_readfirstlane(tid >> 6);
    const float* x = a.in[I_X]; const float* mods = (const float*)(a.ws + WS_MODS);
    const bf16_t* MIX = (const bf16_t*)(a.ws + WS_MIX); unsigned char* XN2 = a.ws + WS_XN; bf16_t* H1 = (bf16_t*)(a.ws + WS_H1);
    const bf16_t* WH = (const bf16_t*)(a.ws + WS_WR); const bf16_t* WL = WH + 32 * 1024;
    LAS bf16_t* NH = (LAS bf16_t*)(lds + P7_NH); LAS bf16_t* NL = (LAS bf16_t*)(lds + P7_NL); LAS float* RP = (LAS float*)(lds + P7_RP);
    LAS int* ENT_E = (LAS int*)(lds + P7_ENT); LAS int* ENT_POS = ENT_E + 512; LAS float* ENT_P = (LAS float*)(ENT_POS + 512);
    LAS int* CNTL = (LAS int*)(lds + P7_CNT); LAS int* BASEL = (LAS int*)(lds + P7_BASE); LAS float* LG = (LAS float*)(lds + P7_LG);
    unsigned* gcnt = (unsigned*)(a.ws + WS_CTL) + CW_CNT;
    int* tok_e = (int*)(a.ws + WS_TOKE); int* tok_pos = (int*)(a.ws + WS_TOKPOS); float* tok_p = (float*)(a.ws + WS_TOKP); int* slot_tok = (int*)(a.ws + WS_SLOT);
    bf16x8 whi[4][2], wlo[4][2];
#pragma unroll
    for (int ks = 0; ks < 4; ++ks)
#pragma unroll
        for (int nt = 0; nt < 2; ++nt) { const size_t o = (size_t)(16 * nt + (lane & 15)) * 1024 + 128 * wave + 32 * ks + 8 * (lane >> 4);
            whi[ks][nt] = *(const bf16x8*)(WH + o); wlo[ks][nt] = *(const bf16x8*)(WL + o); }
    for (int blk = blockIdx.x; blk < T / 128; blk += G) {
        const int b = (blk * 128) / SEQ;
        if (tid < 32) CNTL[tid] = 0;
        f32x4 G1[4], A2[4], B2[4];
#pragma unroll
        for (int j = 0; j < 4; ++j) { const int k = 4 * lane + 256 * j;
            G1[j] = *(const f32x4*)(mods + b * 6144 + 2048 + k) * *(const f32x4*)(a.in[I_GPOST] + k);
            A2[j] = *(const f32x4*)(a.in[I_GPFFN] + k) * (*(const f32x4*)(mods + b * 6144 + 4096 + k) + 1.0f);
            B2[j] = *(const f32x4*)(mods + b * 6144 + 3072 + k); }
        LDS_BARRIER();
        u32x2 pm_[4]; f32x4 px_[4];
        { const size_t row = (size_t)(blk * 128 + 2 * wave);
#pragma unroll
          for (int j = 0; j < 4; ++j) { pm_[j] = *(const u32x2*)(MIX + row * 1024 + 4 * lane + 256 * j); px_[j] = __builtin_nontemporal_load((const f32x4*)(x + row * 1024 + 4 * lane + 256 * j)); } }
        for (int it = 0; it < 8; ++it) {
            const int r0 = blk * 128 + 16 * it;
#pragma unroll 1
            for (int rr = 0; rr < 2; ++rr) {
                const int r16 = 2 * wave + rr; const size_t row = (size_t)(r0 + r16);
                const int sn = 2 * it + rr + 1, snc = sn < 16 ? sn : 15; const size_t rown = (size_t)(blk * 128 + 16 * (snc >> 1) + 2 * wave + (snc & 1));
                f32x4 mv[4], hv[4]; float ss = 0.f;
#pragma unroll
                for (int j = 0; j < 4; ++j) { const u32x2 mm = pm_[j]; mv[j] = (f32x4){bflo(mm[0]), bfhi(mm[0]), bflo(mm[1]), bfhi(mm[1])};
                    hv[j] = px_[j]; ss += (mv[j][0] * mv[j][0] + mv[j][1] * mv[j][1]) + (mv[j][2] * mv[j][2] + mv[j][3] * mv[j][3]); }
#pragma unroll
                for (int j = 0; j < 4; ++j) { pm_[j] = *(const u32x2*)(MIX + rown * 1024 + 4 * lane + 256 * j); px_[j] = __builtin_nontemporal_load((const f32x4*)(x + rown * 1024 + 4 * lane + 256 * j)); }
                const float rstd1 = __builtin_amdgcn_rsqf(wave_sum(ss) * (1.0f / 1024.0f) + EPS);
                float ss2 = 0.f;
#pragma unroll
                for (int j = 0; j < 4; ++j) { hv[j] = hv[j] + G1[j] * mv[j] * rstd1; __builtin_nontemporal_store((u32x2){pk2(hv[j][0], hv[j][1]), pk2(hv[j][2], hv[j][3])}, (u32x2*)(H1 + row * 1024 + 4 * lane + 256 * j));
                    ss2 += (hv[j][0] * hv[j][0] + hv[j][1] * hv[j][1]) + (hv[j][2] * hv[j][2] + hv[j][3] * hv[j][3]); }
                const float rstd2 = __builtin_amdgcn_rsqf(wave_sum(ss2) * (1.0f / 1024.0f) + EPS);
#pragma unroll
                for (int j = 0; j < 4; ++j) { const f32x4 nv = hv[j] * rstd2 * A2[j] + B2[j];
                    const u32x2 hw = (u32x2){pk2(nv[0], nv[1]), pk2(nv[2], nv[3])};
                    const u32x2 lw = (u32x2){pk2(nv[0] - bflo(hw[0]), nv[1] - bfhi(hw[0])), pk2(nv[2] - bflo(hw[1]), nv[3] - bfhi(hw[1]))};
                    *(unsigned*)(XN2 + row * 1024 + 4 * lane + 256 * j) = pk4_fp8(nv[0], nv[1], nv[2], nv[3]);
                    *(LAS u32x2*)(NH + r16 * NP + 4 * lane + 256 * j) = hw; *(LAS u32x2*)(NL + r16 * NP + 4 * lane + 256 * j) = lw; }
            }
            LDS_BARRIER();
            {
                f32x4 acc[2] = {(f32x4){0.f, 0.f, 0.f, 0.f}, (f32x4){0.f, 0.f, 0.f, 0.f}};
#pragma unroll
                for (int ks = 0; ks < 4; ++ks) { const int o = (lane & 15) * NP + 128 * wave + 32 * ks + 8 * (lane >> 4);
                    const bf16x8 ah = *(const LAS bf16x8*)(NH + o), al = *(const LAS bf16x8*)(NL + o);
#pragma unroll
                    for (int nt = 0; nt < 2; ++nt) { acc[nt] = mfma16(ah, whi[ks][nt], acc[nt]); acc[nt] = mfma16(al, whi[ks][nt], acc[nt]); acc[nt] = mfma16(ah, wlo[ks][nt], acc[nt]); } }
#pragma unroll
                for (int nt = 0; nt < 2; ++nt)
#pragma unroll
                    for (int r = 0; r < 4; ++r) RP[wave * 512 + (4 * (lane >> 4) + r) * 32 + 16 * nt + (lane & 15)] = acc[nt][r];
            }
            LDS_BARRIER();
            {
                const int r16 = tid >> 5, e = tid & 31;
                float lg = a.in[I_BR][e];
#pragma unroll
                for (int w = 0; w < 8; ++w) lg += RP[w * 512 + r16 * 32 + e];
                LG[(16 * it + r16) * 33 + e] = lg;
            }
        }
        LDS_BARRIER();
        if (tid < 128) {
            float lg[32];
#pragma unroll
            for (int e = 0; e < 32; ++e) lg[e] = LG[tid * 33 + e];
            float tv[4]; int ti[4];
#pragma unroll
            for (int k = 0; k < 4; ++k) { float bv = -INFINITY; int bi = 0;
#pragma unroll
                for (int e = 0; e < 32; ++e) { bool ok = lg[e] > bv;
#pragma unroll
                    for (int q = 0; q < k; ++q) ok = ok && (e != ti[q]);
                    bv = ok ? lg[e] : bv; bi = ok ? e : bi; }
                tv[k] = bv; ti[k] = bi; }
            const float e1 = __expf(tv[1] - tv[0]), e2 = __expf(tv[2] - tv[0]), e3 = __expf(tv[3] - tv[0]);
            const float inv = 1.0f / (1.0f + e1 + e2 + e3);
            const float pr[4] = {inv, e1 * inv, e2 * inv, e3 * inv};
#pragma unroll
            for (int k = 0; k < 4; ++k) { const int pos = __hip_atomic_fetch_add(CNTL + ti[k], 1, __ATOMIC_RELAXED, __HIP_MEMORY_SCOPE_WORKGROUP); ENT_E[tid * 4 + k] = ti[k]; ENT_POS[tid * 4 + k] = pos; ENT_P[tid * 4 + k] = pr[k]; }
        }
        LDS_BARRIER();
        if (tid < 32) BASEL[tid] = (int)atomicAdd(gcnt + tid, (unsigned)CNTL[tid]);
        LDS_BARRIER();
        { const int e = ENT_E[tid], pos = BASEL[e] + ENT_POS[tid], token = blk * 128 + (tid >> 2);
            tok_e[(size_t)token * 4 + (tid & 3)] = e; tok_pos[(size_t)token * 4 + (tid & 3)] = pos; tok_p[(size_t)token * 4 + (tid & 3)] = ENT_P[tid];
            slot_tok[(size_t)e * T + pos] = token; }
        LDS_BARRIER();
    }
}

__device__ __forceinline__ int moe_tables(const Args& a, LAS unsigned char* lds) {
    LAS int* tp = (LAS int*)(lds + TP_OFF); LAS int* cn = tp + 40; LAS unsigned char* te = (LAS unsigned char*)(lds + TE_OFF);
    const unsigned* gcnt = (const unsigned*)(a.ws + WS_CTL) + CW_CNT;
    if (threadIdx.x == 0) { int s = 0; for (int e = 0; e < NE; ++e) { const int c = (int)gcnt[e]; tp[e] = s; cn[e] = c; s += (c + 255) >> 8; } tp[NE] = s; }
    __syncthreads();
    const int nM = tp[NE];
    for (int e = threadIdx.x >> 4; e < NE; e += 32) for (int p = tp[e] + (threadIdx.x & 15); p < tp[e + 1]; p += 16) te[p] = (unsigned char)e;
    __syncthreads();
    return nM;
}

__device__ __forceinline__ void p10_final(const Args& a, LAS unsigned char* lds, int G) {
    const int tid = threadIdx.x, lane = tid & 63, wave = __builtin_amdgcn_readfirstlane(tid >> 6);
    (void)moe_tables(a, lds);
    const LAS int* tp = (const LAS int*)(lds + TP_OFF);
    const float* mods = (const float*)(a.ws + WS_MODS); const unsigned char* OUT8 = a.ws + WS_OUT8; float* out = a.out; const bf16_t* H1 = (const bf16_t*)(a.ws + WS_H1);
    const int* tok_e = (const int*)(a.ws + WS_TOKE); const int* tok_pos = (const int*)(a.ws + WS_TOKPOS); const float* tok_p = (const float*)(a.ws + WS_TOKP);
    for (int rg = blockIdx.x * 8 + wave; rg < T / 16; rg += G * 8) {
        const int b = (rg * 16) / SEQ;
        f32x4 G2[4];
#pragma unroll
        for (int j = 0; j < 4; ++j) { const int k = 4 * lane + 256 * j; G2[j] = *(const f32x4*)(mods + b * 6144 + 5120 + k) * *(const f32x4*)(a.in[I_GPOSTF] + k); }
        const size_t mb = (size_t)rg * 64 + lane;
        const int me = tok_e[mb], mslot = tp[me] * 256 + tok_pos[mb]; const float mpr = tok_p[mb] * (1.0f / OSCALE);
        constexpr int P10D = 2;
        int nw[P10D][4][4]; u32x2 nh[P10D][4];
#define P10_LOADROW(d_, i_) do { const size_t m_ = (size_t)rg * 16 + (i_); \
            _Pragma("unroll") for (int k = 0; k < 4; ++k) { const size_t slot = (size_t)__builtin_amdgcn_readlane(mslot, 4 * (i_) + k); \
                _Pragma("unroll") for (int j = 0; j < 4; ++j) nw[d_][k][j] = *(const int*)(OUT8 + slot * 1024 + 4 * lane + 256 * j); } \
            _Pragma("unroll") for (int j = 0; j < 4; ++j) nh[d_][j] = __builtin_nontemporal_load((const u32x2*)(H1 + m_ * 1024 + 4 * lane + 256 * j)); } while (0)
#pragma unroll
        for (int d = 0; d < P10D; ++d) P10_LOADROW(d, d);
        for (int i0 = 0; i0 < 16; i0 += P10D) {
#pragma unroll
          for (int d = 0; d < P10D; ++d) {
            const int i = i0 + d; const size_t m = (size_t)rg * 16 + i;
            int cw[4][4]; u32x2 ch[4];
#pragma unroll
            for (int k = 0; k < 4; ++k)
#pragma unroll
                for (int j = 0; j < 4; ++j) cw[k][j] = nw[d][k][j];
#pragma unroll
            for (int j = 0; j < 4; ++j) ch[j] = nh[d][j];
            const int in_ = i + P10D < 16 ? i + P10D : 15;
            P10_LOADROW(d, in_);
            f32x4 f[4];
#pragma unroll
            for (int j = 0; j < 4; ++j) f[j] = (f32x4){0.f, 0.f, 0.f, 0.f};
#pragma unroll
            for (int k = 0; k < 4; ++k) {
                const float pk = __builtin_bit_cast(float, __builtin_amdgcn_readlane(__builtin_bit_cast(int, mpr), 4 * i + k));
#pragma unroll
                for (int j = 0; j < 4; ++j) { const int w = cw[k][j];
                    const f32x2 lo = __builtin_amdgcn_cvt_pk_f32_fp8(w, false), hi = __builtin_amdgcn_cvt_pk_f32_fp8(w, true);
                    f[j] += (f32x4){lo[0], lo[1], hi[0], hi[1]} * pk; }
            }
            float ss = 0.f;
#pragma unroll
            for (int j = 0; j < 4; ++j) ss += (f[j][0] * f[j][0] + f[j][1] * f[j][1]) + (f[j][2] * f[j][2] + f[j][3] * f[j][3]);
            const float rstd = __builtin_amdgcn_rsqf(wave_sum(ss) * (1.0f / 1024.0f) + EPS);
#pragma unroll
            for (int j = 0; j < 4; ++j) __builtin_nontemporal_store((f32x4){bflo(ch[j][0]), bfhi(ch[j][0]), bflo(ch[j][1]), bfhi(ch[j][1])} + G2[j] * f[j] * rstd, (f32x4*)(out + m * 1024 + 4 * lane + 256 * j));
          }
        }
#undef P10_LOADROW
    }
}

constexpr int N_PHASES = 11;
__global__ void __launch_bounds__(512, 2) mk_fwd(Args args) {
    extern __shared__ __attribute__((aligned(16))) unsigned char lds_raw[];
    LAS unsigned char* lds = (LAS unsigned char*)lds_raw;
    volatile LAS unsigned* MISC = (volatile LAS unsigned*)(lds + MISC_OFF);
    const int tid = threadIdx.x, G = gridDim.x;
    if (tid < 64) MISC[tid] = 0u;
    __syncthreads();
    unsigned* ctl = (unsigned*)(args.ws + WS_CTL);
    const int lo = args.ph_lo, hi = args.ph_hi;
    XcdBarrier bar; bar.bar = ctl + CW_BAR; bar.x = 0; bar.st = MISC + 8;
    if (hi - lo > 1) bar = xcd_barrier_post(ctl + CW_BAR, MISC + 8);
#define IN(k) (lo <= (k) && (k) < hi)
#define SEAM(k) do { if (IN((k) + 1)) xcd_barrier(bar); } while (0)
    const LAS unsigned short* TOK = (const LAS unsigned short*)(lds + TOK_OFF);
    if (IN(0)) { p0_prologue(args, lds, G); SEAM(0); }
    if (IN(1)) { p1_norm(args, lds, G); SEAM(1); }
    if (IN(2)) {
        pg8::Gemm g{args.ws + WS_XN, args.ws + WS_WIN, 2048}; pg8::StaticOrder S; S.init(T, NPROJ, G, (int)blockIdx.x);
        pg8::EpiProj E{(bf16_t*)(args.ws + WS_PROJ)};
        const int grp = (((int)blockIdx.x >> 3) * 6) >> 5, nun = (S.nwg + G - 1) / G, cut = grp < nun ? grp : nun;
        if (cut > 0) { S.base = 0; S.lim = cut; pg8::gemm_phase<pg8::EpiProj, pg8::StaticOrder, true, false, false>(lds, g, S, E, TOK); }
        __syncthreads(); moe_convert(args, lds, G, 0, MOE_ITEMS); __syncthreads();
        if (cut < nun) { S.base = cut; S.lim = nun - cut; pg8::gemm_phase<pg8::EpiProj, pg8::StaticOrder, true, false, false>(lds, g, S, E, TOK); }
        SEAM(2);
    }
    if (IN(3)) { p3_sgu(args, lds, G); __syncthreads(); p3_gla_state(args, lds, G); SEAM(3); }
    if (IN(4)) { p4_scan(args, G); SEAM(4); }
    if (IN(5)) { p5_gla_out(args, lds, G); SEAM(5); }
    if (IN(6)) {
        pg8::Gemm g{args.ws + WS_XN, args.ws + WS_WOUT, 2048}; pg8::StaticOrder S; S.init(T, 1024, G, (int)blockIdx.x);
        pg8::EpiPlain E{(bf16_t*)(args.ws + WS_MIX), 1024};
        pg8::gemm_phase<pg8::EpiPlain, pg8::StaticOrder, true, false, false>(lds, g, S, E, TOK);
        SEAM(6);
    }
    if (IN(7)) { p7_router(args, lds, G); SEAM(7); }
    if (IN(8)) {
        const int nM = moe_tables(args, lds);
        pg8::MoeOrder S; S.nM = nM; S.nN = 8; S.nwg = nM * 8; S.G = G; S.c = (int)blockIdx.x;
        S.tp = (const LAS int*)(lds + TP_OFF); S.cnt = S.tp + 40; S.te = (const LAS unsigned char*)(lds + TE_OFF);
        {
            LAS unsigned short* tokw = (LAS unsigned short*)(lds + TOK_OFF); const int* slot_tok = (const int*)(args.ws + WS_SLOT);
            pg8::Unit u;
            for (int i = 0; i < 18 && S.next(i, u); ++i) if (tid < 256) { const int p = u.prow + tid; tokw[i * 256 + tid] = (unsigned short)(p < u.cnt ? slot_tok[(size_t)u.e * T + p] : 0); }
            __syncthreads();
        }
        pg8::Gemm g{args.ws + WS_XN, args.ws + WS_W1, 1024};
        pg8::EpiSwiglu E{args.ws + WS_HDN, args.in[I_BG], args.in[I_BU]};
        pg8::gemm_phase<pg8::EpiSwiglu, pg8::MoeOrder, true, true, true>(lds, g, S, E, TOK);
        SEAM(8);
    }
    if (IN(9)) {
        const int nM = moe_tables(args, lds);
        pg8::MoeOrder S; S.nM = nM; S.nN = 4; S.nwg = nM * 4; S.G = G; S.c = (int)blockIdx.x;
        S.tp = (const LAS int*)(lds + TP_OFF); S.cnt = S.tp + 40; S.te = (const LAS unsigned char*)(lds + TE_OFF);
        pg8::Gemm g{args.ws + WS_HDN, args.ws + WS_WD, 1024};
        pg8::EpiOut8 E{args.ws + WS_OUT8, args.in[I_BDN]};
        pg8::gemm_phase<pg8::EpiOut8, pg8::MoeOrder, true, false, true>(lds, g, S, E, TOK);
        SEAM(9);
    }
    if (IN(10)) { p10_final(args, lds, G); }
#undef IN
#undef SEAM
}

#ifndef MK_SPLIT
#define MK_SPLIT 0
#endif
extern "C" void kernel_launch(void* const* d_in, const int* in_sizes, int n_in, void* d_out, int out_size, void* d_ws, size_t ws_size, hipStream_t stream) {
    static int grid = 0;
    if (grid == 0) {
        if (n_in != 24 || out_size != T * D || ws_size < WS_END) { fprintf(stderr, "kernel_launch: unexpected problem (n_in %d, out %d, ws %zu)\n", n_in, out_size, ws_size); grid = -1; return; }
        int dev = 0, cus = 0, per_cu = 0;
        if (hipGetDevice(&dev) != hipSuccess || hipDeviceGetAttribute(&cus, hipDeviceAttributeMultiprocessorCount, dev) != hipSuccess) { grid = -1; return; }
        if (hipFuncSetAttribute((const void*)mk_fwd, hipFuncAttributeMaxDynamicSharedMemorySize, LDS_BYTES) != hipSuccess) { grid = -1; return; }
        if (hipOccupancyMaxActiveBlocksPerMultiprocessor(&per_cu, (const void*)mk_fwd, 512, LDS_BYTES) != hipSuccess || per_cu < 1) { fprintf(stderr, "kernel_launch: occupancy query says %d\n", per_cu); (void)hipGetLastError(); grid = -1; return; }
        grid = cus;
    }
    if (grid < 0) return;
    (void)hipMemsetAsync((char*)d_ws + WS_CTL, 0, CTL_ZERO_BYTES, stream);
    Args a{};
    for (int i = 0; i < 24; ++i) a.in[i] = (const float*)d_in[i];
    a.out = (float*)d_out; a.ws = (unsigned char*)d_ws;
#if MK_SPLIT
    for (int p = 0; p < N_PHASES; ++p) { a.ph_lo = p; a.ph_hi = p + 1; hipLaunchKernelGGL(mk_fwd, dim3(grid), dim3(512), LDS_BYTES, stream, a); }
#else
    a.ph_lo = 0; a.ph_hi = N_PHASES;
    hipLaunchKernelGGL(mk_fwd, dim3(grid), dim3(512), LDS_BYTES, stream, a);
#endif
}
```

```cpp
#include <hip/hip_runtime.h>
#include <cstdio>
#include <cstdint>

#define LAS __attribute__((address_space(3)))
typedef unsigned short bf16_t;
typedef short bf16x8 __attribute__((ext_vector_type(8)));
typedef float f32x4 __attribute__((ext_vector_type(4)));
typedef float f32x2 __attribute__((ext_vector_type(2)));
typedef unsigned u32x4 __attribute__((ext_vector_type(4)));
typedef unsigned u32x2 __attribute__((ext_vector_type(2)));

constexpr int T = 32768, D = 1024, SEQ = 8192;
constexpr int D_IN = 2576, NPROJ = 2560;
constexpr int NE = 32;
constexpr float EPS = 1e-6f;
constexpr int C_US = 0, C_VS = 512, C_Q = 1024, C_K = 1280, C_V = 1536, C_R = 2048, C_GL = 2560;
constexpr float OSCALE = 8.0f;
constexpr float W8_SCALE = 32.0f;
#define W8_SCALE_E8M0 0x7A7A7A7A

constexpr size_t MiB = 1u << 20;
constexpr size_t WS_CTL = 0, CTL_ZERO_BYTES = 1 * MiB;
constexpr int CW_TMO = 0, CW_CNT = 1024, CW_BAR = 4096;
constexpr size_t WS_MODS = 256 * 1024;
constexpr size_t WS_GLOW = 2 * MiB;
constexpr size_t WS_TOKE = 4 * MiB, WS_TOKPOS = WS_TOKE + 512 * 1024, WS_TOKP = WS_TOKE + 1024 * 1024;
constexpr size_t WS_DEC = 5 * MiB + 512 * 1024;
constexpr size_t WS_SLOT = 6 * MiB;
constexpr size_t WS_WR = 10 * MiB;
constexpr size_t WS_WIN = 11 * MiB;
constexpr size_t WS_WOUT = 16 * MiB;
constexpr size_t WS_WD = 18 * MiB;
constexpr size_t WS_W1 = 50 * MiB;
constexpr size_t WS_XN = 114 * MiB;
constexpr size_t WS_PROJ = 178 * MiB;
constexpr size_t WS_ST = 338 * MiB;
constexpr size_t WS_PREV = 402 * MiB;
constexpr size_t WS_MIX = 178 * MiB;
constexpr size_t WS_HDN = 178 * MiB;
constexpr size_t WS_OUT8 = 338 * MiB;
constexpr size_t WS_BCUM = 434 * MiB;
constexpr size_t WS_H1 = 474 * MiB;
constexpr size_t WS_END = 538 * MiB;
constexpr int MAX_TILES = 543;

constexpr int RING_BYTES = 131072;
constexpr int MISC_OFF = RING_BYTES;
constexpr int TP_OFF = MISC_OFF + 256;
constexpr int TE_OFF = TP_OFF + 512;
constexpr int TOK_OFF = TE_OFF + 1024;
constexpr int BIAS_OFF = TOK_OFF + 18 * 512;
constexpr int LDS_BYTES = 147456;
static_assert(BIAS_OFF + 2048 <= LDS_BYTES && BIAS_OFF % 16 == 0, "LDS map");

__device__ __forceinline__ unsigned f2bf(float f) { unsigned u = __builtin_bit_cast(unsigned, f); return (u + 0x7fffu + ((u >> 16) & 1u)) >> 16; }
__device__ __forceinline__ float bf2f(unsigned h) { return __builtin_bit_cast(float, h << 16); }
__device__ __forceinline__ float bflo(unsigned w) { return __builtin_bit_cast(float, w << 16); }
__device__ __forceinline__ float bfhi(unsigned w) { return __builtin_bit_cast(float, w & 0xffff0000u); }
typedef __bf16 bf16x2_t __attribute__((ext_vector_type(2)));
__device__ __forceinline__ unsigned pk2(float lo, float hi) { const f32x2 v = {lo, hi}; return __builtin_bit_cast(unsigned, __builtin_convertvector(v, bf16x2_t)); }
__device__ __forceinline__ unsigned pk4_fp8(float a, float b, float c, float d) {
    int w = __builtin_amdgcn_cvt_pk_fp8_f32(a, b, 0, false); w = __builtin_amdgcn_cvt_pk_fp8_f32(c, d, w, true); return (unsigned)w; }
__device__ __forceinline__ float clamp448(float v) { return fminf(fmaxf(v, -448.0f), 448.0f); }
#define LDS_BARRIER() do { asm volatile("s_waitcnt lgkmcnt(0)" ::: "memory"); __builtin_amdgcn_s_barrier(); asm volatile("" ::: "memory"); } while (0)
__device__ __forceinline__ float wave_sum(float v) {
#pragma unroll
    for (int o = 1; o < 64; o <<= 1) v += __shfl_xor(v, o);
    return v;
}
__device__ __forceinline__ f32x4 mfma16(bf16x8 a, bf16x8 b, f32x4 c) { return __builtin_amdgcn_mfma_f32_16x16x32_bf16(a, b, c, 0, 0, 0); }
__device__ __forceinline__ float sigmoidf_(float x) { return __builtin_amdgcn_rcpf(1.0f + __builtin_amdgcn_exp2f(-1.4426950408889634f * x)); }
__device__ __forceinline__ float gelu_tanh(float x) { const float u = x + 0.044715f * x * x * x; return x * __builtin_amdgcn_rcpf(1.0f + __builtin_amdgcn_exp2f(-2.302208198f * u)); }
__device__ __forceinline__ float silu_(float x) { return x * sigmoidf_(x); }
__device__ __forceinline__ f32x2 rcp2(f32x2 v) { return (f32x2){__builtin_amdgcn_rcpf(v[0]), __builtin_amdgcn_rcpf(v[1])}; }
__device__ __forceinline__ f32x2 exp2_2(f32x2 v) { return (f32x2){__builtin_amdgcn_exp2f(v[0]), __builtin_amdgcn_exp2f(v[1])}; }
__device__ __forceinline__ f32x2 clamp2(f32x2 v, float lo, float hi) { return (f32x2){__builtin_amdgcn_fmed3f(v[0], lo, hi), __builtin_amdgcn_fmed3f(v[1], lo, hi)}; }
__device__ __forceinline__ f32x2 gelu_tanh2(f32x2 x) { const f32x2 u = x + (x * x) * (x * 0.044715f); return x * rcp2(exp2_2(u * -2.302208198f) + 1.0f); }
__device__ __forceinline__ f32x2 silu2(f32x2 x) { return x * rcp2(exp2_2(x * -1.4426950408889634f) + 1.0f); }

#define XB_TMO      128
#define XB_XCNT(j)  (256  + 64 * (j))
#define XB_XSUB(j)  (1280 + 64 * (j))
#define XB_XGEN(j)  (2304 + 64 * (j))
#define XB_TOP      3328
#define XB_TOPGEN   3392
#define XCD_BAR_WORDS 3456
#define XB_SPIN_CAP (1u << 20)
__device__ __forceinline__ unsigned xb_ld(unsigned* p)              { return __hip_atomic_load(p, __ATOMIC_RELAXED, __HIP_MEMORY_SCOPE_AGENT); }
__device__ __forceinline__ unsigned xb_add(unsigned* p, unsigned v) { return __hip_atomic_fetch_add(p, v, __ATOMIC_RELAXED, __HIP_MEMORY_SCOPE_AGENT); }
__device__ __forceinline__ unsigned xb_xcc_id() { return (unsigned)__builtin_amdgcn_s_getreg((3 << 11) | 20) & 0xFu; }
#define XB_SPIN(cond, bar) do { unsigned _sp = 0; while (cond) { __builtin_amdgcn_s_sleep(1); \
    if ((++_sp & 255u) == 0u) { if (xb_ld(&(bar)[XB_TMO])) break; if (_sp > XB_SPIN_CAP) { atomicAdd(&(bar)[XB_TMO], 1u); break; } } } } while (0)
struct XcdBarrier { unsigned* bar; unsigned x; volatile LAS unsigned* st; };
__device__ __forceinline__ XcdBarrier xcd_barrier_post(unsigned* bar, volatile LAS unsigned* st) {
    XcdBarrier b; b.bar = bar; b.x = xb_xcc_id(); b.st = st;
    if (threadIdx.x == 0) (void)xb_add(&bar[XB_XCNT(b.x)], 1u);
    return b;
}
__device__ __forceinline__ void xcd_barrier_complete(unsigned* bar, unsigned x, unsigned& nloc, unsigned& nx) {
    const unsigned G = gridDim.x * gridDim.y * gridDim.z;
    unsigned sum, cnt, mine, sp = 0u;
    for (;;) {
        sum = 0u; cnt = 0u; mine = 0u;
#pragma unroll
        for (unsigned j = 0; j < 16; ++j) { const unsigned c = xb_ld(&bar[XB_XCNT(j)]); sum += c; cnt += (c > 0u) ? 1u : 0u; mine = (j == x) ? c : mine; }
        if (sum == G) break;
        __builtin_amdgcn_s_sleep(1);
        if ((++sp & 255u) == 0u) { if (xb_ld(&bar[XB_TMO])) break; if (sp > XB_SPIN_CAP) { atomicAdd(&bar[XB_TMO], 1u); break; } }
    }
    nloc = mine > 0u ? mine : 1u; nx = cnt > 0u ? cnt : 1u;
}
__device__ __forceinline__ void xcd_barrier(const XcdBarrier& b) {
    asm volatile("s_waitcnt vmcnt(0)" ::: "memory");
    __syncthreads();
    if (threadIdx.x == 0) {
        unsigned* bar = b.bar;
        __builtin_amdgcn_s_waitcnt(0);
        unsigned nloc = b.st[0], nx = b.st[1];
        if (nloc == 0u) { xcd_barrier_complete(bar, b.x, nloc, nx); b.st[0] = nloc; b.st[1] = nx; }
        const unsigned old = xb_add(&bar[XB_XSUB(b.x)], 1u);
        const unsigned gen = old / nloc;
        if (old + 1u == (gen + 1u) * nloc) {
            __builtin_amdgcn_fence(__ATOMIC_RELEASE, "agent");
            asm volatile("s_waitcnt vmcnt(0)" ::: "memory");
            const unsigned og = xb_add(&bar[XB_TOP], 1u);
            const unsigned tg = og / nx;
            if (og + 1u == (tg + 1u) * nx) xb_add(&bar[XB_TOPGEN], 1u);
            else XB_SPIN(xb_ld(&bar[XB_TOPGEN]) == tg, bar);
            __builtin_amdgcn_fence(__ATOMIC_ACQUIRE, "agent");
            xb_add(&bar[XB_XGEN(b.x)], 1u);
            asm volatile("s_waitcnt vmcnt(0)" ::: "memory");
        } else {
            XB_SPIN(xb_ld(&bar[XB_XGEN(b.x)]) == gen, bar);
            __builtin_amdgcn_fence(__ATOMIC_ACQUIRE, "agent");
            asm volatile("s_waitcnt vmcnt(0)" ::: "memory");
        }
    }
    __syncthreads();
}

namespace pg8 {
constexpr int BM = 256, BK = 64, HALF = 128, HTB = HALF * BK * 2, STAGE_BYTES = 8 * HTB, NXCD = 8, WGM = 8;
template <int SH> __host__ __device__ __forceinline__ int lds_byte(int r, int cb) { const int st = (r >> 4) * 2 + (cb >> 6), rr = r & 15, ob = rr * 64 + (cb & 63); return st * 1024 + (ob ^ (((ob >> 9) & 1) << SH)); }
template <int SH> __host__ __device__ __forceinline__ void stage_rc(int b, int& R, int& CB) { const int st = b / 1024, sb = b % 1024, swz = sb ^ (((sb >> 9) & 1) << SH); R = (st >> 1) * 16 + swz / 64; CB = (st & 1) * 64 + (swz % 64); }
__host__ __device__ __forceinline__ int perm32(int rho) { const int n = rho >> 4, i = rho & 15; return 8 * (i >> 2) + 4 * n + (i & 3); }

struct Unit { int pm, pn, bt, e, prow, cnt, half; };
struct Gemm { const void* A; const void* Bt; int Kb; };

__device__ __forceinline__ void tile_of(int L, int nM, int nN, int nwg, int& pm, int& pn) {
    int wgid = L; { const int q = nwg / NXCD, r = nwg % NXCD, xcd = wgid % NXCD, off = wgid / NXCD; wgid = (xcd < r ? xcd * (q + 1) : r * (q + 1) + (xcd - r) * q) + off; }
    const int nig = WGM * nN, gid = wgid / nig, fm = gid * WGM, gsz = (nM - fm) < WGM ? (nM - fm) : WGM;
    pm = fm + ((wgid % nig) % gsz); pn = (wgid % nig) / gsz;
}
struct StaticOrder {
    int nM, nN, nwg, G, c, base, lim;
    __device__ void init(int M, int N, int G_, int c_) { nM = M / BM; nN = N / BM; nwg = nM * nN; G = G_; c = c_; base = 0; lim = 1 << 30; }
    __device__ __forceinline__ bool next(int i, Unit& u) const {
        if (i >= lim) return false;
        const long L = (long)(i + base) * G + c; if (L >= nwg) return false;
        tile_of((int)L, nM, nN, nwg, u.pm, u.pn); u.bt = u.pn; u.e = 0; u.prow = 0; u.cnt = 0; u.half = -1; return true;
    }
};
struct MoeOrder {
    int nM, nN, nwg, G, c; const LAS int* tp; const LAS unsigned char* te; const LAS int* cnt;
    __device__ __forceinline__ bool next(int i, Unit& u) const {
        const int Rf = nwg / G, Lo = nwg - Rf * G; const bool split = (Lo > 0) && (2 * Lo <= G);
        long L; u.half = -1;
        if (i < Rf) L = (long)i * G + c;
        else if (i == Rf && !split) { if (c >= Lo) return false; L = (long)Rf * G + c; }
        else if (i == Rf) { if (c >= 2 * Lo) return false; L = (long)Rf * G + (c >> 1); u.half = c & 1; }
        else return false;
        tile_of((int)L, nM, nN, nwg, u.pm, u.pn);
        const int e = __builtin_amdgcn_readfirstlane((int)te[u.pm]);
        u.e = e; u.bt = e * nN + u.pn; u.prow = (u.pm - __builtin_amdgcn_readfirstlane(tp[e])) * BM; u.cnt = __builtin_amdgcn_readfirstlane(cnt[e]); return true;
    }
};

struct EpiProj {
    static constexpr int PERMK = 1; static constexpr bool HAS_BIAS = false; static constexpr float BIAS_MUL = 1.0f; static constexpr int ACT_E8M0 = 0x7F7F7F7F;
    __device__ __forceinline__ const float* bias_src(const Unit&, int) const { return nullptr; }
    static __device__ __forceinline__ int bias_off(int, int, int, int) { return 0; }
    bf16_t* O;
    __device__ __forceinline__ void operator()(const f32x4 (&acc)[2][2][4][2], const Unit& u, int wr, int wc, int fr, int fq, const LAS float*) const {
        const int row0 = u.pm * BM + wr * 64 + fr, col0 = u.pn * BM + wc * 32 + 8 * fq;
        const int mode = (u.pn < 4) ? 1 : (u.pn >= 8 ? 2 : (u.pn == 4 ? 3 : 0));
#pragma unroll
        for (int ai = 0; ai < 2; ++ai)
#pragma unroll
            for (int m = 0; m < 4; ++m) { bf16_t* rowp = O + (size_t)(row0 + ai * HALF + m * 16) * NPROJ + col0;
#pragma unroll
                for (int bj = 0; bj < 2; ++bj) { f32x2 v[4];
#pragma unroll
                    for (int n = 0; n < 2; ++n) { v[2 * n] = (f32x2){acc[ai][bj][m][n][0], acc[ai][bj][m][n][1]}; v[2 * n + 1] = (f32x2){acc[ai][bj][m][n][2], acc[ai][bj][m][n][3]}; }
                    if (mode == 1) {
#pragma unroll
                        for (int i = 0; i < 4; ++i) v[i] = gelu_tanh2(v[i]);
                    } else if (mode == 2) {
#pragma unroll
                        for (int i = 0; i < 4; ++i) v[i] = silu2(v[i]);
                    } else if (mode == 3) {
#pragma unroll
                        for (int i = 0; i < 4; ++i) v[i] = v[i] * 0.125f;
                    }
                    u32x4 w; w.x = pk2(v[0][0], v[0][1]); w.y = pk2(v[1][0], v[1][1]); w.z = pk2(v[2][0], v[2][1]); w.w = pk2(v[3][0], v[3][1]);
                    *(u32x4*)(rowp + bj * HALF) = w; } }
    }
};
struct EpiPlain {
    static constexpr int PERMK = 1; static constexpr bool HAS_BIAS = false; static constexpr float BIAS_MUL = 1.0f; static constexpr int ACT_E8M0 = 0x7F7F7F7F;
    __device__ __forceinline__ const float* bias_src(const Unit&, int) const { return nullptr; }
    static __device__ __forceinline__ int bias_off(int, int, int, int) { return 0; }
    bf16_t* O; int ldc;
    __device__ __forceinline__ void operator()(const f32x4 (&acc)[2][2][4][2], const Unit& u, int wr, int wc, int fr, int fq, const LAS float*) const {
        const int row0 = u.pm * BM + wr * 64 + fr, col0 = u.pn * BM + wc * 32 + 8 * fq;
#pragma unroll
        for (int ai = 0; ai < 2; ++ai)
#pragma unroll
            for (int m = 0; m < 4; ++m) { bf16_t* rowp = O + (size_t)(row0 + ai * HALF + m * 16) * ldc + col0;
#pragma unroll
                for (int bj = 0; bj < 2; ++bj) { const f32x4 v0 = acc[ai][bj][m][0], v1 = acc[ai][bj][m][1];
                    u32x4 w; w.x = pk2(v0[0], v0[1]); w.y = pk2(v0[2], v0[3]); w.z = pk2(v1[0], v1[1]); w.w = pk2(v1[2], v1[3]);
                    *(u32x4*)(rowp + bj * HALF) = w; } }
    }
};
struct EpiSwiglu {
    static constexpr int PERMK = 1; static constexpr bool HAS_BIAS = true; static constexpr float BIAS_MUL = 1.0f; static constexpr int ACT_E8M0 = 0x7F7F7F7F;
    static __device__ __forceinline__ int bias_off(int bj, int n, int wc, int fq) { return bj * HALF + wc * 32 + 8 * fq + 4 * n; }
    unsigned char* H; const float* bg; const float* bu;
    __device__ __forceinline__ const float* bias_src(const Unit& u, int j) const { return (j < 128 ? bg : bu) + (size_t)u.e * 1024 + u.pn * HALF + (j & 127); }
    __device__ __forceinline__ void operator()(const f32x4 (&acc)[2][2][4][2], const Unit& u, int wr, int wc, int fr, int fq, const LAS float* btab) const {
        const int row0 = u.pm * BM + (u.half > 0 ? HALF : 0) + wr * 64 + fr, hc0 = u.pn * HALF + wc * 32 + 8 * fq;
#pragma unroll
        for (int ai = 0; ai < 2; ++ai) if (ai == 0 || u.half < 0)
#pragma unroll
            for (int m = 0; m < 4; ++m) { f32x2 h[4];
#pragma unroll
                for (int n = 0; n < 2; ++n)
#pragma unroll
                    for (int q = 0; q < 2; ++q) {
                        const f32x2 g = (f32x2){fminf(acc[ai][0][m][n][2 * q], 7.0f), fminf(acc[ai][0][m][n][2 * q + 1], 7.0f)};
                        const f32x2 uu = clamp2((f32x2){acc[ai][1][m][n][2 * q], acc[ai][1][m][n][2 * q + 1]}, -7.0f, 7.0f);
                        h[2 * n + q] = (uu * g + g) * rcp2(exp2_2(g * (-1.702f * 1.4426950408889634f)) + 1.0f); }
                *(u32x2*)(H + (size_t)(row0 + ai * HALF + m * 16) * 1024 + hc0) = (u32x2){pk4_fp8(h[0][0], h[0][1], h[1][0], h[1][1]), pk4_fp8(h[2][0], h[2][1], h[3][0], h[3][1])}; }
    }
};
struct EpiOut8 {
    static constexpr int PERMK = 2; static constexpr bool HAS_BIAS = true; static constexpr float BIAS_MUL = OSCALE; static constexpr int ACT_E8M0 = 0x82828282;
    static __device__ __forceinline__ int bias_off(int bj, int n, int wc, int fq) { return wc * 64 + 16 * fq + 8 * bj + 4 * n; }
    unsigned char* O; const float* bd;
    __device__ __forceinline__ const float* bias_src(const Unit& u, int j) const { return bd + (size_t)u.e * 1024 + u.pn * BM + j; }
    __device__ __forceinline__ void operator()(const f32x4 (&acc)[2][2][4][2], const Unit& u, int wr, int wc, int fr, int fq, const LAS float* btab) const {
        const int row0 = u.pm * BM + (u.half > 0 ? HALF : 0) + wr * 64 + fr, col0 = u.pn * BM + wc * 64 + 16 * fq;
#pragma unroll
        for (int ai = 0; ai < 2; ++ai) if (ai == 0 || u.half < 0)
#pragma unroll
            for (int m = 0; m < 4; ++m) { u32x4 w;
#pragma unroll
                for (int bj = 0; bj < 2; ++bj)
#pragma unroll
                    for (int n = 0; n < 2; ++n) { const f32x4 c = acc[ai][bj][m][n];
                        w[2 * bj + n] = pk4_fp8(__builtin_amdgcn_fmed3f(c[0], -440.0f, 440.0f), __builtin_amdgcn_fmed3f(c[1], -440.0f, 440.0f), __builtin_amdgcn_fmed3f(c[2], -440.0f, 440.0f), __builtin_amdgcn_fmed3f(c[3], -440.0f, 440.0f)); }
                *(u32x4*)(O + (size_t)(row0 + ai * HALF + m * 16) * 1024 + col0) = w; }
    }
};

typedef int i32x4 __attribute__((ext_vector_type(4)));
typedef int i32x8 __attribute__((ext_vector_type(8)));
template <bool FP8> struct Frag;
template <> struct Frag<false> { bf16x8 k0, k1; __device__ __forceinline__ void ld(const LAS unsigned char* p0, const LAS unsigned char* p1) { k0 = *(const LAS bf16x8*)p0; k1 = *(const LAS bf16x8*)p1; } };
template <> struct Frag<true> { i32x8 v; __device__ __forceinline__ void ld(const LAS unsigned char* p0, const LAS unsigned char* p1) { v = __builtin_shufflevector(*(const LAS i32x4*)p0, *(const LAS i32x4*)p1, 0, 1, 2, 3, 4, 5, 6, 7); } };
__device__ __forceinline__ f32x4 frag_mma(const Frag<false>& b, const Frag<false>& a, f32x4 c) { c = __builtin_amdgcn_mfma_f32_16x16x32_bf16(b.k0, a.k0, c, 0, 0, 0); return __builtin_amdgcn_mfma_f32_16x16x32_bf16(b.k1, a.k1, c, 0, 0, 0); }
__device__ __forceinline__ f32x4 frag_mma(const Frag<true>& b, const Frag<true>& a, f32x4 c, int sw, int s1) {
    asm volatile("s_nop 1\n\tv_mfma_scale_f32_16x16x128_f8f6f4 %0, %1, %2, %0, %3, %4 op_sel_hi:[0,0,0]" : "+v"(c) : "v"(b.v), "v"(a.v), "v"(sw), "v"(s1)); return c; }
__device__ __forceinline__ f32x4 frag_mma(const Frag<false>& b, const Frag<false>& a, f32x4 c, int, int) { return frag_mma(b, a, c); }
template <class Epi, class Sched, bool ALIGN_EPI, bool GATHER, bool FP8>
__device__ __forceinline__ void gemm_phase(LAS unsigned char* lds, const Gemm g, const Sched& S, const Epi& E, const LAS unsigned short* tok) {
    const int tid = threadIdx.x, wid = __builtin_amdgcn_readfirstlane(tid >> 6), lane = tid & 63, wr = wid >> 2, wc = wid & 3, fr = lane & 15, fq = lane >> 4;
    constexpr int SH = FP8 ? 4 : 5;
    const int K = g.Kb, nt = K / 128;
    unsigned voffB[2]; unsigned va[2][2], vn[2][2]; int RA[2], CA[2];
#pragma unroll
    for (int i = 0; i < 2; ++i) { int R, C; stage_rc<SH>(tid * 16 + i * 8192, R, C);
        const int Rb = Epi::PERMK == 2 ? (((R >> 5) & 3) * 64 + ((R >> 2) & 3) * 16 + ((R >> 4) & 1) * 4 + (R & 3)) : (Epi::PERMK == 1 ? ((R & ~31) + perm32(R & 31)) : R);
        RA[i] = R; CA[i] = C; voffB[i] = (unsigned)(Rb * K + C);
#pragma unroll
        for (int h = 0; h < 2; ++h) { va[h][i] = (unsigned)((R + h * HALF) * K + C); vn[h][i] = va[h][i]; } }
    unsigned vplain[2][2];
#pragma unroll
    for (int h = 0; h < 2; ++h)
#pragma unroll
        for (int i = 0; i < 2; ++i) vplain[h][i] = va[h][i];
    const size_t kstep = 128;
    const size_t hstep = (size_t)HALF * K;
    const size_t tstep = 2 * hstep;
    const size_t hstepB = Epi::PERMK == 2 ? (size_t)8 * K : hstep;
    const unsigned ldsw = (unsigned)wid * 1024u;
    const int aoff0 = FP8 ? lds_byte<SH>(wr * 64 + fr, fq * 32) : lds_byte<SH>(wr * 64 + fr, fq * 16), aoff1 = FP8 ? lds_byte<SH>(wr * 64 + fr, fq * 32 + 16) : aoff0 + 1024;
    const int boff0 = FP8 ? lds_byte<SH>(wc * 32 + fr, fq * 32) : lds_byte<SH>(wc * 32 + fr, fq * 16), boff1 = FP8 ? lds_byte<SH>(wc * 32 + fr, fq * 32 + 16) : boff0 + 1024;
#define PG8_SA(b, h) (((b) * 2 + (h)) * HTB)
#define PG8_SB(b, h) ((4 + (b) * 2 + (h)) * HTB)
#define PG8_STAGE(bufoff, gbase, voff) do { _Pragma("unroll") for (int _i = 0; _i < 2; ++_i) \
        __builtin_amdgcn_global_load_lds((const unsigned*)((const char*)(gbase) + (voff)[_i]), (LAS unsigned*)(lds + (bufoff) + ldsw + _i * 8192), 16, 0, 0); } while (0)
#define PG8_LDA(dst, b, h) do { _Pragma("unroll") for (int m = 0; m < 4; ++m) dst[m].ld(lds + PG8_SA(b, h) + aoff0 + m * 2048, lds + PG8_SA(b, h) + aoff1 + m * 2048); } while (0)
#define PG8_LDB(dst, b, h) do { _Pragma("unroll") for (int n = 0; n < 2; ++n) dst[n].ld(lds + PG8_SB(b, h) + boff0 + n * 2048, lds + PG8_SB(b, h) + boff1 + n * 2048); } while (0)
#define PG8_MMA(ai, bj, At, Bt) do { __builtin_amdgcn_s_setprio(1); _Pragma("unroll") for (int m = 0; m < 4; ++m) _Pragma("unroll") for (int n = 0; n < 2; ++n) \
        acc[ai][bj][m][n] = frag_mma(Bt[n], At[m], acc[ai][bj][m][n], sc_w, sc_1); __builtin_amdgcn_s_setprio(0); } while (0)
#define PG8_WAIT_V(n) asm volatile("s_waitcnt vmcnt(" #n ")" ::: "memory")
#define PG8_WAIT_L(n) asm volatile("s_waitcnt lgkmcnt(" #n ")" ::: "memory")
#define PG8_BAR __builtin_amdgcn_s_barrier()
#define PG8_SCHED __builtin_amdgcn_sched_barrier(0)
#define PG8_GATHER_OFFS(dst, ui_, half_) do { _Pragma("unroll") for (int _h = 0; _h < 2; ++_h) _Pragma("unroll") for (int _i = 0; _i < 2; ++_i) \
        dst[_h][_i] = (unsigned)tok[(ui_) * 256 + ((half_) >= 0 ? (half_) * HALF : _h * HALF) + RA[_i]] * (unsigned)K + (unsigned)CA[_i]; } while (0)
#define PG8_PLAIN_OFFS(dst, half_) do { _Pragma("unroll") for (int _i = 0; _i < 2; ++_i) { dst[0][_i] = vplain[0][_i]; dst[1][_i] = (half_) >= 0 ? vplain[0][_i] : vplain[1][_i]; } } while (0)
    Unit cur, nxt; int ui = 0;
    if (!S.next(0, cur)) return;
    f32x4 acc[2][2][4][2];
#define PG8_ACC_INIT(slot_) do { _Pragma("unroll") for (int b = 0; b < 2; ++b) _Pragma("unroll") for (int n = 0; n < 2; ++n) { f32x4 bi_ = (f32x4){0.f, 0.f, 0.f, 0.f}; \
        if constexpr (Epi::HAS_BIAS) bi_ = *(const LAS f32x4*)(lds + BIAS_OFF + (slot_) * 1024 + 4 * Epi::bias_off(b, n, wc, fq)) * Epi::BIAS_MUL; \
        _Pragma("unroll") for (int a = 0; a < 2; ++a) _Pragma("unroll") for (int m = 0; m < 4; ++m) acc[a][b][m][n] = bi_; } } while (0)
    Frag<FP8> At[4], B0[2], B1[2];
    int sc_w = W8_SCALE_E8M0, sc_1 = Epi::ACT_E8M0;
    if constexpr (FP8) { asm volatile("" : "+v"(sc_w), "+v"(sc_1)); }
    const char* cA = GATHER ? (const char*)g.A : (const char*)g.A + (size_t)cur.pm * tstep + (cur.half > 0 ? hstep : 0);
    const char* cB = (const char*)g.Bt + (size_t)cur.bt * tstep;
    if constexpr (GATHER) { PG8_GATHER_OFFS(va, 0, cur.half); } else { PG8_PLAIN_OFFS(va, cur.half); }
#define PG8_BIAS_DMA(unit_, slot_) do { if constexpr (Epi::HAS_BIAS) { if (wid < 4) \
        __builtin_amdgcn_global_load_lds((const unsigned*)E.bias_src(unit_, wid * 64 + lane), (LAS unsigned*)(lds + BIAS_OFF + (slot_) * 1024 + wid * 256), 4, 0, 0); } } while (0)
    PG8_BIAS_DMA(cur, 0);
    PG8_STAGE(PG8_SB(0, 0), cB, voffB); PG8_STAGE(PG8_SB(0, 1), cB + hstepB, voffB); PG8_STAGE(PG8_SA(0, 0), cA, va[0]); PG8_STAGE(PG8_SA(0, 1), cA, va[1]);
    if (wr == 1) PG8_BAR;
    PG8_WAIT_V(2); PG8_BAR;
    PG8_STAGE(PG8_SB(1, 0), cB + kstep, voffB); PG8_STAGE(PG8_SA(1, 0), cA + kstep, va[0]); PG8_STAGE(PG8_SB(1, 1), cB + hstepB + kstep, voffB);
    PG8_WAIT_V(6); PG8_BAR;
    PG8_ACC_INIT(0);
    for (;;) {
        const bool has_next = S.next(ui + 1, nxt);
        const char* nA = GATHER ? (const char*)g.A : (has_next ? (const char*)g.A + (size_t)nxt.pm * tstep + (nxt.half > 0 ? hstep : 0) : cA);
        const char* nB = has_next ? (const char*)g.Bt + (size_t)nxt.bt * tstep : cB;
        if (has_next) { if constexpr (GATHER) { PG8_GATHER_OFFS(vn, ui + 1, nxt.half); } else { PG8_PLAIN_OFFS(vn, nxt.half); } }
        else {
#pragma unroll
            for (int h = 0; h < 2; ++h)
#pragma unroll
                for (int i = 0; i < 2; ++i) vn[h][i] = va[h][i]; }
        const bool full = cur.half < 0;
#pragma nounroll
        for (int t = 0; t < nt; t += 2) {
            const bool last = (t == nt - 2);
            const char* a1 = cA + (size_t)(t + 1) * kstep;
            const char* a2 = last ? nA : cA + (size_t)(t + 2) * kstep; const char* b2 = last ? nB : cB + (size_t)(t + 2) * kstep;
            const char* a3 = a2 + kstep; const char* b3 = b2 + kstep;
            unsigned v0[2], v1[2];
            if (last && has_next) PG8_BIAS_DMA(nxt, (ui + 1) & 1);
#pragma unroll
            for (int i = 0; i < 2; ++i) { v0[i] = last ? vn[0][i] : va[0][i]; v1[i] = last ? vn[1][i] : va[1][i]; }
            PG8_STAGE(PG8_SA(1, 1), a1, va[1]); PG8_SCHED; PG8_LDA(At, 0, 0); PG8_SCHED; PG8_LDB(B0, 0, 0); PG8_LDB(B1, 0, 1);
            PG8_WAIT_V(8); PG8_WAIT_L(0); PG8_BAR; PG8_MMA(0, 0, At, B0); PG8_MMA(0, 1, At, B1); PG8_BAR; PG8_SCHED;
            PG8_LDA(At, 0, 1); PG8_STAGE(PG8_SB(0, 0), b2, voffB); PG8_STAGE(PG8_SB(0, 1), b2 + hstepB, voffB); PG8_STAGE(PG8_SA(0, 0), a2, v0);
            PG8_WAIT_V(8); PG8_WAIT_L(0); PG8_BAR; if (full) { PG8_MMA(1, 0, At, B0); PG8_MMA(1, 1, At, B1); } PG8_BAR; PG8_SCHED;
            PG8_STAGE(PG8_SA(0, 1), a2, v1); PG8_SCHED; PG8_LDA(At, 1, 0); PG8_SCHED; PG8_LDB(B0, 1, 0); PG8_LDB(B1, 1, 1);
            PG8_WAIT_V(8); PG8_WAIT_L(0); PG8_BAR; PG8_MMA(0, 0, At, B0); PG8_MMA(0, 1, At, B1); PG8_BAR; PG8_SCHED;
            PG8_LDA(At, 1, 1); PG8_STAGE(PG8_SB(1, 0), b3, voffB); PG8_STAGE(PG8_SB(1, 1), b3 + hstepB, voffB); PG8_STAGE(PG8_SA(1, 0), a3, v0);
            PG8_WAIT_V(8); PG8_WAIT_L(0); PG8_BAR; if (full) { PG8_MMA(1, 0, At, B0); PG8_MMA(1, 1, At, B1); } PG8_BAR; PG8_SCHED;
        }
        if constexpr (ALIGN_EPI) { if (wr == 0) PG8_BAR; }
        if constexpr (FP8) { asm volatile("s_nop 15\n\ts_nop 7"); PG8_SCHED; }
        E(acc, cur, wr, wc, fr, fq, (const LAS float*)(lds + BIAS_OFF + (ui & 1) * 1024));
        if (!has_next) break;
        PG8_ACC_INIT((ui + 1) & 1);
        cur = nxt; cA = nA; cB = nB; ++ui;
#pragma unroll
        for (int h = 0; h < 2; ++h)
#pragma unroll
            for (int i = 0; i < 2; ++i) va[h][i] = vn[h][i];
        if constexpr (ALIGN_EPI) { if (wr == 1) PG8_BAR; }
    }
    PG8_WAIT_V(0);
    if constexpr (!ALIGN_EPI) { if (wr == 0) PG8_BAR; }
    PG8_BAR;
#undef PG8_SA
#undef PG8_SB
#undef PG8_STAGE
#undef PG8_LDA
#undef PG8_LDB
#undef PG8_MMA
#undef PG8_WAIT_V
#undef PG8_WAIT_L
#undef PG8_BAR
#undef PG8_SCHED
#undef PG8_GATHER_OFFS
#undef PG8_PLAIN_OFFS
#undef PG8_BIAS_DMA
#undef PG8_ACC_INIT
}
}

struct Args { const float* in[24]; float* out; unsigned char* ws; int ph_lo, ph_hi; };
enum { I_X = 0, I_C, I_WADA, I_BADA, I_GPRE, I_WIN, I_GSGU, I_WS, I_BS, I_WGK2, I_BGK, I_GGLA, I_WOUT, I_GPOST, I_GPFFN, I_WR, I_BR, I_WG, I_BG, I_WU, I_BU, I_WDN, I_BDN, I_GPOSTF };

template <bool FP8>
__device__ __forceinline__ void transpose_item(const float* W, int ldw, int k0, int n0, void* WT, size_t dst_row0, LAS float* scr, int lane) {
    f32x4 v[8];
#pragma unroll
    for (int q = 0; q < 8; ++q) v[q] = *(const f32x4*)(W + (size_t)(k0 + 8 * q + (lane >> 3)) * ldw + n0 + 4 * (lane & 7));
#pragma unroll
    for (int q = 0; q < 8; ++q) { LAS float* d = scr + (8 * q + (lane >> 3)) * 33 + 4 * (lane & 7); d[0] = v[q][0]; d[1] = v[q][1]; d[2] = v[q][2]; d[3] = v[q][3]; }
    asm volatile("s_waitcnt lgkmcnt(0)" ::: "memory");
    const int c = lane & 7;
#pragma unroll
    for (int j = 0; j < 4; ++j) { const int n = (lane >> 3) + 8 * j; const LAS float* s = scr + (8 * c) * 33 + n;
        if constexpr (FP8) {
            const u32x2 o = (u32x2){pk4_fp8(s[0 * 33] * W8_SCALE, s[1 * 33] * W8_SCALE, s[2 * 33] * W8_SCALE, s[3 * 33] * W8_SCALE), pk4_fp8(s[4 * 33] * W8_SCALE, s[5 * 33] * W8_SCALE, s[6 * 33] * W8_SCALE, s[7 * 33] * W8_SCALE)};
            *(u32x2*)((unsigned char*)WT + (dst_row0 + n) * 1024 + k0 + 8 * c) = o;
        } else {
            u32x4 o; o.x = pk2(s[0 * 33], s[1 * 33]); o.y = pk2(s[2 * 33], s[3 * 33]); o.z = pk2(s[4 * 33], s[5 * 33]); o.w = pk2(s[6 * 33], s[7 * 33]);
            *(u32x4*)((bf16_t*)WT + (dst_row0 + n) * 1024 + k0 + 8 * c) = o; } }
    asm volatile("s_waitcnt lgkmcnt(0)" ::: "memory");
}
__device__ __forceinline__ void p0_prologue(const Args& a, LAS unsigned char* lds, int G) {
    const int tid = threadIdx.x, lane = tid & 63, wave = __builtin_amdgcn_readfirstlane(tid >> 6);
    const int gw = blockIdx.x * 8 + wave, NGW = G * 8;
    unsigned char* ws = a.ws;
    {
        float* mods = (float*)(ws + WS_MODS);
        const float* c = a.in[I_C]; const float* wa = a.in[I_WADA]; const float* ba = a.in[I_BADA];
        LAS float* sc = (LAS float*)lds;
        LAS float* part = (LAS float*)(lds + 16384);
        if ((int)blockIdx.x < 96) { for (int i = tid; i < 4096; i += 512) sc[i] = silu_(c[i]); __syncthreads(); }
        for (int it = blockIdx.x; it < 96; it += G) {
            const int r = lane >> 4, cq = lane & 15, k0 = wave * 128;
            const float* wp = wa + (size_t)(k0 + r) * 6144 + it * 64 + 4 * cq;
            f32x4 wv[32];
#pragma unroll
            for (int i = 0; i < 32; ++i) wv[i] = __builtin_nontemporal_load((const f32x4*)(wp + (size_t)(4 * i) * 6144));
            f32x4 acc[4];
#pragma unroll
            for (int b = 0; b < 4; ++b) acc[b] = (f32x4){0.f, 0.f, 0.f, 0.f};
#pragma unroll
            for (int i = 0; i < 32; ++i)
#pragma unroll
                for (int b = 0; b < 4; ++b) acc[b] += wv[i] * sc[b * 1024 + k0 + 4 * i + r];
#pragma unroll
            for (int b = 0; b < 4; ++b)
#pragma unroll
                for (int e2 = 0; e2 < 4; ++e2) { float t = acc[b][e2]; t += __shfl_xor(t, 16); t += __shfl_xor(t, 32); acc[b][e2] = t; }
            if (lane < 16) {
#pragma unroll
                for (int b = 0; b < 4; ++b) *(LAS f32x4*)(part + (wave * 4 + b) * 64 + 4 * cq) = acc[b]; }
            __syncthreads();
            if (tid < 256) { const int b = tid >> 6, cc = tid & 63; float sv = ba[it * 64 + cc];
#pragma unroll
                for (int w = 0; w < 8; ++w) sv += part[(w * 4 + b) * 64 + cc];
                mods[b * 6144 + it * 64 + cc] = sv; }
            __syncthreads();
        }
    }
    {
        const float* wr = a.in[I_WR]; bf16_t* wh = (bf16_t*)(ws + WS_WR); bf16_t* wl = wh + 32 * 1024;
        for (int idx = blockIdx.x * 512 + tid; idx < 32768; idx += G * 512) { const int k = idx >> 5, j = idx & 31; const float w = wr[idx];
            const unsigned h = f2bf(w); wh[j * 1024 + k] = (bf16_t)h; wl[j * 1024 + k] = (bf16_t)f2bf(w - bf2f(h)); }
    }
    {
        LAS float* scr = (LAS float*)(lds + wave * 16384);
        constexpr int I_IN = 16 * 80, I_OUT = 16 * 32, I_E = 16 * 32;
        constexpr int NITEMS = I_IN + I_OUT + 3 * NE * I_E;
        bf16_t* Win = (bf16_t*)(ws + WS_WIN); bf16_t* Wout = (bf16_t*)(ws + WS_WOUT);
        (void)NITEMS;
        for (int it = gw; it < I_IN + I_OUT; it += NGW) {
            int r = it;
            if (r < I_IN) { const int kb = r / 80, nb = r % 80; transpose_item<false>(a.in[I_WIN], D_IN, 64 * kb, 32 * nb, Win, (size_t)(32 * nb), scr, lane); continue; } r -= I_IN;
            { const int kb = r / 32, nb = r % 32; transpose_item<false>(a.in[I_WOUT], 1024, 64 * kb, 32 * nb, Wout, (size_t)(32 * nb), scr, lane); }
        }
    }
}

constexpr int MOE_ITEMS = 3 * NE * 256;
__device__ __forceinline__ void moe_convert(const Args& a, LAS unsigned char* lds, int G, int first, int last) {
    (void)lds;
    const int tid = threadIdx.x, lane = tid & 63, wave = __builtin_amdgcn_readfirstlane(tid >> 6);
    const int gw = blockIdx.x * 8 + wave, NGW = G * 8;
    unsigned char* Wd = a.ws + WS_WD; unsigned char* W1 = a.ws + WS_W1;
    constexpr int I_E8 = 8 * 32;
#define MC_DECODE(it_, src_, dst_) do { int r = (it_); const int mat = r / (NE * I_E8); r -= mat * (NE * I_E8); const int e = r / I_E8; r -= e * I_E8; \
        const int nb = 8 * (r >> 6) + (r & 7), kb = (r >> 3) & 7, n0 = 32 * nb, k0 = 128 * kb; \
        const float* Wm = (mat == 0 ? a.in[I_WG] : (mat == 1 ? a.in[I_WU] : a.in[I_WDN])) + (size_t)e * 1048576; \
        const size_t drow = (mat == 2) ? (size_t)e * 1024 + n0 : (size_t)e * 2048 + (size_t)(n0 >> 7) * 256 + (size_t)mat * 128 + (size_t)(n0 & 127); \
        dst_ = (mat == 2 ? Wd : W1) + (drow + 4 * (lane & 7)) * 1024 + k0 + 16 * (lane >> 3); src_ = Wm + (size_t)(k0 + 16 * (lane >> 3)) * 1024 + n0 + 4 * (lane & 7); } while (0)
#define MC_LOAD(vv, src_) do { _Pragma("unroll") for (int q = 0; q < 16; ++q) vv[q] = __builtin_nontemporal_load((const f32x4*)((src_) + (size_t)q * 1024)); } while (0)
#define MC_PROC(vv, dst_) do { u32x4 o_[4]; \
        _Pragma("unroll") for (int g4 = 0; g4 < 4; ++g4) { unsigned D_[4]; \
            _Pragma("unroll") for (int q = 0; q < 4; ++q) { const f32x4 t_ = vv[4 * g4 + q] * W8_SCALE; D_[q] = pk4_fp8(t_[0], t_[1], t_[2], t_[3]); } \
            const unsigned pa = __builtin_amdgcn_perm(D_[1], D_[0], 0x05010400u), pb = __builtin_amdgcn_perm(D_[1], D_[0], 0x07030602u); \
            const unsigned pc = __builtin_amdgcn_perm(D_[3], D_[2], 0x05010400u), pd = __builtin_amdgcn_perm(D_[3], D_[2], 0x07030602u); \
            o_[0][g4] = __builtin_amdgcn_perm(pc, pa, 0x05040100u); o_[1][g4] = __builtin_amdgcn_perm(pc, pa, 0x07060302u); \
            o_[2][g4] = __builtin_amdgcn_perm(pd, pb, 0x05040100u); o_[3][g4] = __builtin_amdgcn_perm(pd, pb, 0x07060302u); } \
        _Pragma("unroll") for (int j = 0; j < 4; ++j) __builtin_nontemporal_store(o_[j], (u32x4*)((dst_) + (size_t)j * 1024)); } while (0)
    int it = first + gw;
    if (it < last) {
        const int nmine = (last - 1 - it) / NGW;
        const int itlast = it + nmine * NGW;
        const float* sA; unsigned char* dA; const float* sB; unsigned char* dB; f32x4 v[16], w[16];
        MC_DECODE(it, sA, dA); MC_LOAD(v, sA);
        for (; it < last; it += 2 * NGW) {
            const int itb = (it + NGW <= itlast) ? it + NGW : itlast, ita = (it + 2 * NGW <= itlast) ? it + 2 * NGW : itlast;
            MC_DECODE(itb, sB, dB); MC_LOAD(w, sB);
            MC_PROC(v, dA);
            MC_DECODE(ita, sA, dA); MC_LOAD(v, sA);
            MC_PROC(w, dB);
        }
    }
#undef MC_DECODE
#undef MC_LOAD
#undef MC_PROC
}

__device__ __forceinline__ void p1_norm(const Args& a, LAS unsigned char* lds, int G) {
    const int tid = threadIdx.x, lane = tid & 63, wave = __builtin_amdgcn_readfirstlane(tid >> 6);
    const float* x = a.in[I_X]; const float* win = a.in[I_WIN]; const float* gpre = a.in[I_GPRE];
    const float* mods = (const float*)(a.ws + WS_MODS);
    bf16_t* XN = (bf16_t*)(a.ws + WS_XN); float* glow = (float*)(a.ws + WS_GLOW);
    constexpr int NP1 = 1032;
    LAS bf16_t* NT = (LAS bf16_t*)lds; LAS float* RP = (LAS float*)(lds + 16 * NP1 * 2);
    bf16x8 wg[4];
#pragma unroll
    for (int ks = 0; ks < 4; ++ks)
#pragma unroll
        for (int e = 0; e < 8; ++e) { const int k = 128 * wave + 32 * ks + 8 * (lane >> 4) + e; wg[ks][e] = (short)f2bf(win[(size_t)k * D_IN + C_GL + (lane & 15)]); }
    for (int blk = blockIdx.x; blk < T / 128; blk += G) {
        const int b = (blk * 128) / SEQ;
        f32x4 A1[4], B1[4];
#pragma unroll
        for (int j = 0; j < 4; ++j) { const int k = 4 * lane + 256 * j; const f32x4 gv = *(const f32x4*)(gpre + k), sc = *(const f32x4*)(mods + b * 6144 + 1024 + k);
            A1[j] = gv * (sc + 1.0f); B1[j] = *(const f32x4*)(mods + b * 6144 + k); }
        f32x4 nx[4][4];
#define P1_ROWOF(q_) ((size_t)(blk * 128 + 16 * ((q_) >> 1) + 2 * wave + ((q_) & 1)))
#pragma unroll
        for (int d = 0; d < 4; ++d) { const size_t row = P1_ROWOF(d);
#pragma unroll
          for (int j = 0; j < 4; ++j) nx[d][j] = __builtin_nontemporal_load((const f32x4*)(x + row * 1024 + 4 * lane + 256 * j)); }
        for (int it0 = 0; it0 < 8; it0 += 2) {
#pragma unroll
          for (int iu = 0; iu < 2; ++iu) {
            const int it = it0 + iu;
#pragma unroll
            for (int rr = 0; rr < 2; ++rr) {
                const int r16 = 2 * wave + rr, q = 2 * it + rr, sl = 2 * iu + rr; const size_t row = P1_ROWOF(q);
                const int qn = q + 4 < 16 ? q + 4 : 15; const size_t rown = P1_ROWOF(qn);
                f32x4 v[4]; float ss = 0.f;
#pragma unroll
                for (int j = 0; j < 4; ++j) { v[j] = nx[sl][j]; ss += (v[j][0] * v[j][0] + v[j][1] * v[j][1]) + (v[j][2] * v[j][2] + v[j][3] * v[j][3]); }
#pragma unroll
                for (int j = 0; j < 4; ++j) nx[sl][j] = __builtin_nontemporal_load((const f32x4*)(x + rown * 1024 + 4 * lane + 256 * j));
                const float rstd = __builtin_amdgcn_rsqf(wave_sum(ss) * (1.0f / 1024.0f) + EPS);
#pragma unroll
                for (int j = 0; j < 4; ++j) { v[j] = v[j] * rstd * A1[j] + B1[j];
                    const u32x2 w = (u32x2){pk2(v[j][0], v[j][1]), pk2(v[j][2], v[j][3])};
                    *(u32x2*)(XN + row * 1024 + 4 * lane + 256 * j) = w; *(LAS u32x2*)(NT + r16 * NP1 + 4 * lane + 256 * j) = w; }
            }
            LDS_BARRIER();
            {
                f32x4 acc = (f32x4){0.f, 0.f, 0.f, 0.f};
#pragma unroll
                for (int ks = 0; ks < 4; ++ks) { const bf16x8 av = *(const LAS bf16x8*)(NT + (lane & 15) * NP1 + 128 * wave + 32 * ks + 8 * (lane >> 4)); acc = mfma16(av, wg[ks], acc); }
#pragma unroll
                for (int r = 0; r < 4; ++r) RP[wave * 256 + (4 * (lane >> 4) + r) * 16 + (lane & 15)] = acc[r];
            }
            LDS_BARRIER();
            if (tid < 256) { float sv = 0.f;
#pragma unroll
                for (int w = 0; w < 8; ++w) sv += RP[w * 256 + tid];
                glow[((size_t)blk * 128 + 16 * it) * 16 + tid] = sv; }
          }
        }
#undef P1_ROWOF
        LDS_BARRIER();
    }
}

__device__ __forceinline__ unsigned lo_pair(unsigned a, unsigned b) { return (a & 0xffffu) | (b << 16); }
__device__ __forceinline__ unsigned hi_pair(unsigned a, unsigned b) { return (a >> 16) | (b & 0xffff0000u); }
constexpr int VP32 = 68;
__device__ __forceinline__ void p3_sgu(const Args& a, LAS unsigned char* lds, int G) {
    const int tid = threadIdx.x, lane = tid & 63, wave = __builtin_amdgcn_readfirstlane(tid >> 6);
    const bf16_t* PROJ = (const bf16_t*)(a.ws + WS_PROJ); bf16_t* MIXA = (bf16_t*)(a.ws + WS_XN);
    const int nper = G / 8;
    const int h = blockIdx.x & 7, sub = blockIdx.x >> 3;
    if (sub >= nper) return;
    const int t = 16 * wave + (lane & 15);
    bf16x8 wf[4];
#pragma unroll
    for (int ks = 0; ks < 4; ++ks) { const float* wrow = a.in[I_WS] + ((size_t)h * 128 + t) * 128 + 32 * ks + 8 * (lane >> 4);
#pragma unroll
        for (int e2 = 0; e2 < 8; ++e2) { const int s = 32 * ks + 8 * (lane >> 4) + e2; const float w = (s <= t) ? wrow[e2] : 0.f; wf[ks][e2] = (short)f2bf(w); } }
    const float bias = a.in[I_BS][h * 128 + t];
    const int token = tid >> 2, part = tid & 3, odd = token & 1;
    float gs[16];
#pragma unroll
    for (int j = 0; j < 16; ++j) gs[j] = a.in[I_GSGU][h * 64 + part * 16 + j];
    u32x4 nr0, nr1; u32x2 nu[4];
#define SGU_LOAD(idx_) do { const int tok0_ = ((idx_) >> 6) * SEQ + ((idx_) & 63) * 128; \
        const bf16_t* src_ = PROJ + (size_t)(tok0_ + token) * NPROJ + C_VS + h * 64 + part * 16; nr0 = *(const u32x4*)src_; nr1 = *(const u32x4*)(src_ + 8); \
        _Pragma("unroll") for (int dt = 0; dt < 4; ++dt) nu[dt] = *(const u32x2*)(PROJ + (size_t)(tok0_ + t) * NPROJ + C_US + h * 64 + 16 * dt + 4 * (lane >> 4)); } while (0)
    SGU_LOAD(sub);
    int buf = 0;
    for (int idx = sub; idx < 256; idx += nper, buf ^= 1) {
        LAS unsigned* vhT = (LAS unsigned*)(lds + buf * (64 * VP32 * 4));
        const int tok0 = (idx >> 6) * SEQ + (idx & 63) * 128;
        const u32x4 r0 = nr0, r1 = nr1; u32x2 uu[4];
#pragma unroll
        for (int dt = 0; dt < 4; ++dt) uu[dt] = nu[dt];
        { const int idn = (idx + nper < 256) ? idx + nper : idx; SGU_LOAD(idn); }
        float v[16];
#pragma unroll
        for (int i = 0; i < 4; ++i) { v[2 * i] = bflo(r0[i]); v[2 * i + 1] = bfhi(r0[i]); v[8 + 2 * i] = bflo(r1[i]); v[8 + 2 * i + 1] = bfhi(r1[i]); }
        float ss = 0.f;
#pragma unroll
        for (int j = 0; j < 16; ++j) ss += v[j] * v[j];
        ss += __shfl_xor(ss, 1); ss += __shfl_xor(ss, 2);
        const float rstd = __builtin_amdgcn_rsqf(ss * (1.0f / 64.0f) + EPS);
        unsigned pw[8];
#pragma unroll
        for (int i = 0; i < 8; ++i) pw[i] = pk2(v[2 * i] * rstd * gs[2 * i], v[2 * i + 1] * rstd * gs[2 * i + 1]);
#pragma unroll
        for (int i = 0; i < 4; ++i) {
            const unsigned snd = odd ? pw[i] : pw[4 + i], own = odd ? pw[4 + i] : pw[i], rcv = (unsigned)__shfl_xor((int)snd, 4);
            const unsigned first = odd ? rcv : own, second = odd ? own : rcv;
            const int d = 16 * part + 8 * odd + 2 * i;
            vhT[d * VP32 + ((token >> 1) ^ (4 * (d >> 4)))] = lo_pair(first, second);
            vhT[(d + 1) * VP32 + ((token >> 1) ^ (4 * (d >> 4)))] = hi_pair(first, second); }
        LDS_BARRIER();
        f32x4 acc[4];
#pragma unroll
        for (int dt = 0; dt < 4; ++dt) acc[dt] = (f32x4){0.f, 0.f, 0.f, 0.f};
#pragma unroll
        for (int ks = 0; ks < 4; ++ks) if (ks <= (wave >> 1)) {
#pragma unroll
            for (int dt = 0; dt < 4; ++dt) { const bf16x8 av = *(const LAS bf16x8*)(vhT + (16 * dt + (lane & 15)) * VP32 + ((16 * ks + 4 * (lane >> 4)) ^ (4 * dt))); acc[dt] = mfma16(av, wf[ks], acc[dt]); } }
        const size_t trow = (size_t)(tok0 + t);
#pragma unroll
        for (int dt = 0; dt < 4; ++dt) { const int d = 16 * dt + 4 * (lane >> 4);
            const float o0 = bflo(uu[dt][0]) * (acc[dt][0] + bias), o1 = bfhi(uu[dt][0]) * (acc[dt][1] + bias), o2 = bflo(uu[dt][1]) * (acc[dt][2] + bias), o3 = bfhi(uu[dt][1]) * (acc[dt][3] + bias);
            *(u32x2*)(MIXA + trow * 1024 + h * 64 + d) = (u32x2){pk2(o0, o1), pk2(o2, o3)}; }
    }
#undef SGU_LOAD
}

constexpr int GP32 = 36;
constexpr int GP = 72;
constexpr int GL_WG2 = 0  , GL_WT = 4096  , GL_A = 6144  , GL_B = GL_A + 9216  , GL_VT = GL_B + 9216  ,
              GL_PM = GL_VT + 18432  , GL_RS = GL_PM + 9216  ;
__device__ __forceinline__ void gla_decay(const LAS float* wg2, LAS float* WT, const float (&bgk)[8], f32x2 g2, int lane, int wave, float (&bc)[8], float (&tot)[8]) {
    const int a8 = (lane & 7) * 8, base = lane & ~7;
    f32x2 xp[4];
#pragma unroll
    for (int e = 0; e < 4; ++e) xp[e] = (f32x2){bgk[2 * e], bgk[2 * e + 1]};
#pragma unroll
    for (int j = 0; j < 8; ++j) { const float x0 = __shfl(g2[0], base + j), x1 = __shfl(g2[1], base + j);
        const f32x4 w00 = *(const LAS f32x4*)(wg2 + (2 * j) * 64 + a8), w01 = *(const LAS f32x4*)(wg2 + (2 * j) * 64 + a8 + 4);
        const f32x4 w10 = *(const LAS f32x4*)(wg2 + (2 * j + 1) * 64 + a8), w11 = *(const LAS f32x4*)(wg2 + (2 * j + 1) * 64 + a8 + 4);
        xp[0] += (f32x2){w00[0], w00[1]} * x0; xp[1] += (f32x2){w00[2], w00[3]} * x0; xp[2] += (f32x2){w01[0], w01[1]} * x0; xp[3] += (f32x2){w01[2], w01[3]} * x0;
        xp[0] += (f32x2){w10[0], w10[1]} * x1; xp[1] += (f32x2){w10[2], w10[3]} * x1; xp[2] += (f32x2){w11[0], w11[1]} * x1; xp[3] += (f32x2){w11[2], w11[3]} * x1; }
    float la[8];
#pragma unroll
    for (int e = 0; e < 8; ++e) { const float xx = xp[e >> 1][e & 1];
        la[e] = (fminf(xx, 0.f) - 0.6931471806f * __builtin_amdgcn_logf(1.0f + __builtin_amdgcn_exp2f(-1.4426950409f * fabsf(xx)))) * (1.0f / 16.0f); }
#pragma unroll
    for (int off = 8; off < 64; off <<= 1) {
#pragma unroll
        for (int e = 0; e < 8; ++e) { const float tv = __shfl_up(la[e], off); if (lane >= off) la[e] += tv; } }
    if (lane >= 56) { *(LAS f32x4*)(WT + wave * 64 + a8) = (f32x4){la[0], la[1], la[2], la[3]}; *(LAS f32x4*)(WT + wave * 64 + a8 + 4) = (f32x4){la[4], la[5], la[6], la[7]}; }
    LDS_BARRIER();
    float off8[8];
#pragma unroll
    for (int e = 0; e < 8; ++e) { off8[e] = 0.f; tot[e] = 0.f; }
#pragma unroll
    for (int w = 0; w < 8; ++w) { const f32x4 t0 = *(const LAS f32x4*)(WT + w * 64 + a8), t1 = *(const LAS f32x4*)(WT + w * 64 + a8 + 4);
#pragma unroll
        for (int e = 0; e < 4; ++e) { tot[e] += t0[e]; tot[4 + e] += t1[e]; if (w < wave) { off8[e] += t0[e]; off8[4 + e] += t1[e]; } } }
#pragma unroll
    for (int e = 0; e < 8; ++e) bc[e] = la[e] + off8[e];
}
__device__ __forceinline__ void gla_vt_write(LAS unsigned* VT, u32x4 v0, u32x4 v1, int lane, int wave) {
    const int cl = lane >> 3, a = lane & 7, odd = cl & 1, dcol = 4 * wave + (cl >> 1);
#pragma unroll
    for (int i = 0; i < 4; ++i) {
        const unsigned snd = odd ? v0[i] : v1[i], own = odd ? v1[i] : v0[i], rcv = (unsigned)__shfl_xor((int)snd, 8);
        const unsigned first = odd ? rcv : own, second = odd ? own : rcv;
        const int v = 16 * a + 8 * odd + 2 * i;
        VT[v * GP32 + (dcol ^ (4 * a))] = lo_pair(first, second);
        VT[(v + 1) * GP32 + (dcol ^ (4 * a))] = hi_pair(first, second); }
}

__device__ __forceinline__ void p3_gla_state(const Args& a, LAS unsigned char* lds, int G) {
    const int tid = threadIdx.x, lane = tid & 63, wave = __builtin_amdgcn_readfirstlane(tid >> 6);
    const bf16_t* PROJ = (const bf16_t*)(a.ws + WS_PROJ); bf16_t* ST = (bf16_t*)(a.ws + WS_ST); float* DEC = (float*)(a.ws + WS_DEC); const float* glow = (const float*)(a.ws + WS_GLOW); float* BCUM = (float*)(a.ws + WS_BCUM);
    LAS float* wg2 = (LAS float*)(lds + GL_WG2); LAS float* WT = (LAS float*)(lds + GL_WT);
    LAS unsigned* KDT = (LAS unsigned*)(lds + GL_A); LAS unsigned* VT = (LAS unsigned*)(lds + GL_VT);
    const int c = tid >> 3, a8 = (tid & 7) * 8, v16 = (tid & 7) * 16, cl = lane >> 3, odd = cl & 1;
    int cur_h = -1; float bgk[8];
    f32x2 ng2; u32x4 nkr, nv0, nv1;
#define ST_LOAD(idx_) do { const int bh_ = (idx_) & 15, n_ = (idx_) >> 4, tok0_ = (bh_ >> 2) * SEQ + n_ * 64, h_ = bh_ & 3; \
        ng2 = *(const f32x2*)(glow + (size_t)tok0_ * 16 + 2 * tid); nkr = *(const u32x4*)(PROJ + (size_t)(tok0_ + c) * NPROJ + C_K + h_ * 64 + a8); \
        const bf16_t* vs_ = PROJ + (size_t)(tok0_ + c) * NPROJ + C_V + h_ * 128 + v16; nv0 = *(const u32x4*)vs_; nv1 = *(const u32x4*)(vs_ + 8); } while (0)
    if ((int)blockIdx.x < 2048) ST_LOAD((int)blockIdx.x);
    for (int idx = blockIdx.x; idx < 2048; idx += G) {
        const int bh = idx & 15, n = idx >> 4, h = bh & 3, su = bh * 128 + n;
        if (h != cur_h) {
            LDS_BARRIER();
            for (int i = tid; i < 1024; i += 512) wg2[i] = a.in[I_WGK2][(i >> 6) * 256 + h * 64 + (i & 63)];
#pragma unroll
            for (int e = 0; e < 8; ++e) bgk[e] = a.in[I_BGK][h * 64 + a8 + e];
            cur_h = h; LDS_BARRIER(); }
        const f32x2 g2 = ng2; const u32x4 kr = nkr, v0 = nv0, v1 = nv1;
        { const int idn = (idx + G < 2048) ? idx + G : idx; ST_LOAD(idn); }
        float bc[8], tot[8];
        gla_decay(wg2, WT, bgk, g2, lane, wave, bc, tot);
        { float* bp = BCUM + (size_t)((bh >> 2) * SEQ + n * 64 + c) * 256 + h * 64 + a8; *(f32x4*)bp = (f32x4){bc[0], bc[1], bc[2], bc[3]}; *(f32x4*)(bp + 4) = (f32x4){bc[4], bc[5], bc[6], bc[7]}; }
        {
            unsigned pw[4];
#pragma unroll
            for (int i = 0; i < 4; ++i) pw[i] = pk2(bflo(kr[i]) * __expf(tot[2 * i] - bc[2 * i]), bfhi(kr[i]) * __expf(tot[2 * i + 1] - bc[2 * i + 1]));
            const int dcol = 4 * wave + (cl >> 1);
#pragma unroll
            for (int i = 0; i < 2; ++i) {
                const unsigned snd = odd ? pw[i] : pw[2 + i], own = odd ? pw[2 + i] : pw[i], rcv = (unsigned)__shfl_xor((int)snd, 8);
                const unsigned first = odd ? rcv : own, second = odd ? own : rcv;
                const int d = a8 + 4 * odd + 2 * i;
                KDT[d * GP32 + (dcol ^ (4 * (d >> 4)))] = lo_pair(first, second);
                KDT[(d + 1) * GP32 + (dcol ^ (4 * (d >> 4)))] = hi_pair(first, second); }
            gla_vt_write(VT, v0, v1, lane, wave);
            if (tid < 8) { float* dp = DEC + (size_t)su * 64 + a8; *(f32x4*)dp = (f32x4){__expf(tot[0]), __expf(tot[1]), __expf(tot[2]), __expf(tot[3])}; *(f32x4*)(dp + 4) = (f32x4){__expf(tot[4]), __expf(tot[5]), __expf(tot[6]), __expf(tot[7])}; }
        }
        LDS_BARRIER();
        {
            f32x4 acc[4];
#pragma unroll
            for (int dt = 0; dt < 4; ++dt) acc[dt] = (f32x4){0.f, 0.f, 0.f, 0.f};
#pragma unroll
            for (int ks = 0; ks < 2; ++ks) { const int dc = 16 * ks + 4 * (lane >> 4);
                const bf16x8 bv = *(const LAS bf16x8*)(VT + (16 * wave + (lane & 15)) * GP32 + (dc ^ (4 * wave)));
#pragma unroll
                for (int dt = 0; dt < 4; ++dt) { const bf16x8 av = *(const LAS bf16x8*)(KDT + (16 * dt + (lane & 15)) * GP32 + (dc ^ (4 * dt))); acc[dt] = mfma16(av, bv, acc[dt]); } }
            bf16_t* dst = ST + ((size_t)su * 128 + 16 * wave + (lane & 15)) * 64 + 4 * (lane >> 4);
#pragma unroll
            for (int dt = 0; dt < 4; ++dt) *(u32x2*)(dst + 16 * dt) = (u32x2){pk2(acc[dt][0], acc[dt][1]), pk2(acc[dt][2], acc[dt][3])};
        }
    }
#undef ST_LOAD
}

__device__ __forceinline__ void p4_scan(const Args& a, int G) {
    const bf16_t* ST = (const bf16_t*)(a.ws + WS_ST); const float* DEC = (const float*)(a.ws + WS_DEC); bf16_t* PREV = (bf16_t*)(a.ws + WS_PREV);
    for (int gid = blockIdx.x * 512 + threadIdx.x; gid < 131072; gid += G * 512) {
        const int bh = gid >> 13, rem = gid & 8191;
        float s0 = 0.f;
        for (int n0 = 0; n0 < 128; n0 += 16) {
            float st[16], dc[16];
#pragma unroll
            for (int j = 0; j < 16; ++j) { const size_t su = (size_t)bh * 128 + n0 + j; st[j] = bf2f(ST[su * 8192 + rem]); dc[j] = DEC[su * 64 + (rem & 63)]; }
#pragma unroll
            for (int j = 0; j < 16; ++j) { const size_t su = (size_t)bh * 128 + n0 + j; PREV[su * 8192 + rem] = (bf16_t)f2bf(s0); s0 = dc[j] * s0 + st[j]; }
        }
    }
}

__device__ __forceinline__ void p5_gla_out(const Args& a, LAS unsigned char* lds, int G) {
    const int tid = threadIdx.x, lane = tid & 63, wave = __builtin_amdgcn_readfirstlane(tid >> 6);
    const bf16_t* PROJ = (const bf16_t*)(a.ws + WS_PROJ); const bf16_t* PREV = (const bf16_t*)(a.ws + WS_PREV); bf16_t* MIXA = (bf16_t*)(a.ws + WS_XN); const float* glow = (const float*)(a.ws + WS_GLOW);
    const float* BCUM = (const float*)(a.ws + WS_BCUM);
    LAS bf16_t* QS = (LAS bf16_t*)(lds + GL_A); LAS bf16_t* KS = (LAS bf16_t*)(lds + GL_B); LAS unsigned* VT = (LAS unsigned*)(lds + GL_VT); LAS bf16_t* PM = (LAS bf16_t*)(lds + GL_PM);
    LAS float* RS = (LAS float*)(lds + GL_RS);
    const int c = tid >> 3, a8 = (tid & 7) * 8, v16 = (tid & 7) * 16;
    const int it = wave >> 1, vh = wave & 1;
    f32x4 nb0, nb1; u32x4 nqr, nkr, nv0, nv1;
#define GO_LOAD(idx_) do { const int bh_ = (idx_) & 15, n_ = (idx_) >> 4, tok0_ = (bh_ >> 2) * SEQ + n_ * 64, h_ = bh_ & 3; \
        { const float* bp_ = BCUM + (size_t)(tok0_ + c) * 256 + h_ * 64 + a8; nb0 = *(const f32x4*)bp_; nb1 = *(const f32x4*)(bp_ + 4); } \
        nqr = *(const u32x4*)(PROJ + (size_t)(tok0_ + c) * NPROJ + C_Q + h_ * 64 + a8); nkr = *(const u32x4*)(PROJ + (size_t)(tok0_ + c) * NPROJ + C_K + h_ * 64 + a8); \
        const bf16_t* vs_ = PROJ + (size_t)(tok0_ + c) * NPROJ + C_V + h_ * 128 + v16; nv0 = *(const u32x4*)vs_; nv1 = *(const u32x4*)(vs_ + 8); } while (0)
#define GO_LOAD2(idx_) do { const int bh_ = (idx_) & 15, n_ = (idx_) >> 4, tok0_ = (bh_ >> 2) * SEQ + n_ * 64, h_ = bh_ & 3, su_ = bh_ * 128 + n_; \
        _Pragma("unroll") for (int vt = 0; vt < 4; ++vt) { const int vrow_ = 16 * (4 * vh + vt) + (lane & 15); \
            _Pragma("unroll") for (int ks = 0; ks < 2; ++ks) pv[vt][ks] = *(const bf16x8*)(PREV + ((size_t)su_ * 128 + vrow_) * 64 + 32 * ks + 8 * (lane >> 4)); \
            rr[vt] = *(const u32x2*)(PROJ + (size_t)(tok0_ + 16 * it + (lane & 15)) * NPROJ + C_R + h_ * 128 + 16 * (4 * vh + vt) + 4 * (lane >> 4)); } } while (0)
    if ((int)blockIdx.x < 2048) GO_LOAD((int)blockIdx.x);
    for (int idx = blockIdx.x; idx < 2048; idx += G) {
        const int bh = idx & 15, n = idx >> 4, b = bh >> 2, h = bh & 3, tok0 = b * SEQ + n * 64;
        const f32x4 b0 = nb0, b1 = nb1; const u32x4 qr = nqr, kr = nkr, v0 = nv0, v1 = nv1; bf16x8 pv[4][2]; u32x2 rr[4];
        { const int idn = (idx + G < 2048) ? idx + G : idx; GO_LOAD(idn); }
        GO_LOAD2(idx);
        const float bc[8] = {b0[0], b0[1], b0[2], b0[3], b1[0], b1[1], b1[2], b1[3]};
        {
            u32x4 qo, ko;
#pragma unroll
            for (int i = 0; i < 4; ++i) { const float e0 = __expf(bc[2 * i]), e1 = __expf(bc[2 * i + 1]);
                qo[i] = pk2(bflo(qr[i]) * e0, bfhi(qr[i]) * e1); ko[i] = pk2(bflo(kr[i]) * __builtin_amdgcn_rcpf(e0), bfhi(kr[i]) * __builtin_amdgcn_rcpf(e1)); }
            *(LAS u32x4*)(QS + c * GP + a8) = qo; *(LAS u32x4*)(KS + c * GP + a8) = ko;
            gla_vt_write(VT, v0, v1, lane, wave);
        }
        LDS_BARRIER();
        {
#pragma unroll
            for (int q = 0; q < 2; ++q) { const int jt = 2 * (wave & 1) + q; f32x4 s = (f32x4){0.f, 0.f, 0.f, 0.f};
                if (jt <= it) {
#pragma unroll
                    for (int ks = 0; ks < 2; ++ks) { const bf16x8 av = *(const LAS bf16x8*)(KS + (16 * jt + (lane & 15)) * GP + 32 * ks + 8 * (lane >> 4));
                        const bf16x8 bv = *(const LAS bf16x8*)(QS + (16 * it + (lane & 15)) * GP + 32 * ks + 8 * (lane >> 4)); s = mfma16(av, bv, s); } }
                const int i = 16 * it + (lane & 15), j0 = 16 * jt + 4 * (lane >> 4);
                const float p0 = (j0 <= i) ? s[0] : 0.f, p1 = (j0 + 1 <= i) ? s[1] : 0.f, p2 = (j0 + 2 <= i) ? s[2] : 0.f, p3 = (j0 + 3 <= i) ? s[3] : 0.f;
                *(LAS u32x2*)(PM + i * GP + j0) = (u32x2){pk2(p0, p1), pk2(p2, p3)}; }
        }
        LDS_BARRIER();
        f32x4 acc[4];
#pragma unroll
        for (int vt = 0; vt < 4; ++vt) { acc[vt] = (f32x4){0.f, 0.f, 0.f, 0.f}; const int vrow = 16 * (4 * vh + vt) + (lane & 15), vsw = 4 * (4 * vh + vt);
#pragma unroll
            for (int ks = 0; ks < 2; ++ks) { const bf16x8 av = *(const LAS bf16x8*)(VT + vrow * GP32 + ((16 * ks + 4 * (lane >> 4)) ^ vsw));
                const bf16x8 bv = *(const LAS bf16x8*)(PM + (16 * it + (lane & 15)) * GP + 32 * ks + 8 * (lane >> 4)); acc[vt] = mfma16(av, bv, acc[vt]); }
#pragma unroll
            for (int ks = 0; ks < 2; ++ks) { const bf16x8 bv = *(const LAS bf16x8*)(QS + (16 * it + (lane & 15)) * GP + 32 * ks + 8 * (lane >> 4)); acc[vt] = mfma16(pv[vt][ks], bv, acc[vt]); } }
        float ss = 0.f;
#pragma unroll
        for (int vt = 0; vt < 4; ++vt) ss += (acc[vt][0] * acc[vt][0] + acc[vt][1] * acc[vt][1]) + (acc[vt][2] * acc[vt][2] + acc[vt][3] * acc[vt][3]);
        ss += __shfl_xor(ss, 16); ss += __shfl_xor(ss, 32);
        if (lane < 16) RS[wave * 16 + lane] = ss;
        LDS_BARRIER();
        const float tsum = RS[wave * 16 + (lane & 15)] + RS[(wave ^ 1) * 16 + (lane & 15)];
        const float rstd = __builtin_amdgcn_rsqf(tsum * (1.0f / 128.0f) + EPS);
        const size_t trow = (size_t)(tok0 + 16 * it + (lane & 15));
#pragma unroll
        for (int vt = 0; vt < 4; ++vt) { const int v = 16 * (4 * vh + vt) + 4 * (lane >> 4);
            const f32x4 gg = *(const f32x4*)(a.in[I_GGLA] + v);
            const float o0 = acc[vt][0] * rstd * gg[0] * bflo(rr[vt][0]), o1 = acc[vt][1] * rstd * gg[1] * bfhi(rr[vt][0]), o2 = acc[vt][2] * rstd * gg[2] * bflo(rr[vt][1]), o3 = acc[vt][3] * rstd * gg[3] * bfhi(rr[vt][1]);
            *(u32x2*)(MIXA + trow * 1024 + 512 + h * 128 + v) = (u32x2){pk2(o0, o1), pk2(o2, o3)}; }
    }
#undef GO_LOAD
#undef GO_LOAD2
}

constexpr int NP = 1032;
constexpr int P7_NH = 0, P7_NL = 16 * NP * 2, P7_RP = 2 * 16 * NP * 2, P7_ENT = P7_RP + 16384, P7_CNT = P7_ENT + 3 * 2048, P7_BASE = P7_CNT + 128, P7_LG = P7_BASE + 128  ;
__device__ __forceinline__ void p7_router(const Args& a, LAS unsigned char* lds, int G) {
    const int tid = threadIdx.x, lane = tid & 63, wave = __builtin_amdgcn_readfirstlane(tid >> 6);
    const float* x = a.in[I_X]; const float* mods = (const float*)(a.ws + WS_MODS);
    const bf16_t* MIX = (const bf16_t*)(a.ws + WS_MIX); unsigned char* XN2 = a.ws + WS_XN; bf16_t* H1 = (bf16_t*)(a.ws + WS_H1);
    const bf16_t* WH = (const bf16_t*)(a.ws + WS_WR); const bf16_t* WL = WH + 32 * 1024;
    LAS bf16_t* NH = (LAS bf16_t*)(lds + P7_NH); LAS bf16_t* NL = (LAS bf16_t*)(lds + P7_NL); LAS float* RP = (LAS float*)(lds + P7_RP);
    LAS int* ENT_E = (LAS int*)(lds + P7_ENT); LAS int* ENT_POS = ENT_E + 512; LAS float* ENT_P = (LAS float*)(ENT_POS + 512);
    LAS int* CNTL = (LAS int*)(lds + P7_CNT); LAS int* BASEL = (LAS int*)(lds + P7_BASE); LAS float* LG = (LAS float*)(lds + P7_LG);
    unsigned* gcnt = (unsigned*)(a.ws + WS_CTL) + CW_CNT;
    int* tok_e = (int*)(a.ws + WS_TOKE); int* tok_pos = (int*)(a.ws + WS_TOKPOS); float* tok_p = (float*)(a.ws + WS_TOKP); int* slot_tok = (int*)(a.ws + WS_SLOT);
    bf16x8 whi[4][2], wlo[4][2];
#pragma unroll
    for (int ks = 0; ks < 4; ++ks)
#pragma unroll
        for (int nt = 0; nt < 2; ++nt) { const size_t o = (size_t)(16 * nt + (lane & 15)) * 1024 + 128 * wave + 32 * ks + 8 * (lane >> 4);
            whi[ks][nt] = *(const bf16x8*)(WH + o); wlo[ks][nt] = *(const bf16x8*)(WL + o); }
    for (int blk = blockIdx.x; blk < T / 128; blk += G) {
        const int b = (blk * 128) / SEQ;
        if (tid < 32) CNTL[tid] = 0;
        f32x4 G1[4], A2[4], B2[4];
#pragma unroll
        for (int j = 0; j < 4; ++j) { const int k = 4 * lane + 256 * j;
            G1[j] = *(const f32x4*)(mods + b * 6144 + 2048 + k) * *(const f32x4*)(a.in[I_GPOST] + k);
            A2[j] = *(const f32x4*)(a.in[I_GPFFN] + k) * (*(const f32x4*)(mods + b * 6144 + 4096 + k) + 1.0f);
            B2[j] = *(const f32x4*)(mods + b * 6144 + 3072 + k); }
        LDS_BARRIER();
        u32x2 pm_[4]; f32x4 px_[4];
        { const size_t row = (size_t)(blk * 128 + 2 * wave);
#pragma unroll
          for (int j = 0; j < 4; ++j) { pm_[j] = *(const u32x2*)(MIX + row * 1024 + 4 * lane + 256 * j); px_[j] = __builtin_nontemporal_load((const f32x4*)(x + row * 1024 + 4 * lane + 256 * j)); } }
        for (int it = 0; it < 8; ++it) {
            const int r0 = blk * 128 + 16 * it;
#pragma unroll 1
            for (int rr = 0; rr < 2; ++rr) {
                const int r16 = 2 * wave + rr; const size_t row = (size_t)(r0 + r16);
                const int sn = 2 * it + rr + 1, snc = sn < 16 ? sn : 15; const size_t rown = (size_t)(blk * 128 + 16 * (snc >> 1) + 2 * wave + (snc & 1));
                f32x4 mv[4], hv[4]; float ss = 0.f;
#pragma unroll
                for (int j = 0; j < 4; ++j) { const u32x2 mm = pm_[j]; mv[j] = (f32x4){bflo(mm[0]), bfhi(mm[0]), bflo(mm[1]), bfhi(mm[1])};
                    hv[j] = px_[j]; ss += (mv[j][0] * mv[j][0] + mv[j][1] * mv[j][1]) + (mv[j][2] * mv[j][2] + mv[j][3] * mv[j][3]); }
#pragma unroll
                for (int j = 0; j < 4; ++j) { pm_[j] = *(const u32x2*)(MIX + rown * 1024 + 4 * lane + 256 * j); px_[j] = __builtin_nontemporal_load((const f32x4*)(x + rown * 1024 + 4 * lane + 256 * j)); }
                const float rstd1 = __builtin_amdgcn_rsqf(wave_sum(ss) * (1.0f / 1024.0f) + EPS);
                float ss2 = 0.f;
#pragma unroll
                for (int j = 0; j < 4; ++j) { hv[j] = hv[j] + G1[j] * mv[j] * rstd1; __builtin_nontemporal_store((u32x2){pk2(hv[j][0], hv[j][1]), pk2(hv[j][2], hv[j][3])}, (u32x2*)(H1 + row * 1024 + 4 * lane + 256 * j));
                    ss2 += (hv[j][0] * hv[j][0] + hv[j][1] * hv[j][1]) + (hv[j][2] * hv[j][2] + hv[j][3] * hv[j][3]); }
                const float rstd2 = __builtin_amdgcn_rsqf(wave_sum(ss2) * (1.0f / 1024.0f) + EPS);
#pragma unroll
                for (int j = 0; j < 4; ++j) { const f32x4 nv = hv[j] * rstd2 * A2[j] + B2[j];
                    const u32x2 hw = (u32x2){pk2(nv[0], nv[1]), pk2(nv[2], nv[3])};
                    const u32x2 lw = (u32x2){pk2(nv[0] - bflo(hw[0]), nv[1] - bfhi(hw[0])), pk2(nv[2] - bflo(hw[1]), nv[3] - bfhi(hw[1]))};
                    *(unsigned*)(XN2 + row * 1024 + 4 * lane + 256 * j) = pk4_fp8(nv[0], nv[1], nv[2], nv[3]);
                    *(LAS u32x2*)(NH + r16 * NP + 4 * lane + 256 * j) = hw; *(LAS u32x2*)(NL + r16 * NP + 4 * lane + 256 * j) = lw; }
            }
            LDS_BARRIER();
            {
                f32x4 acc[2] = {(f32x4){0.f, 0.f, 0.f, 0.f}, (f32x4){0.f, 0.f, 0.f, 0.f}};
#pragma unroll
                for (int ks = 0; ks < 4; ++ks) { const int o = (lane & 15) * NP + 128 * wave + 32 * ks + 8 * (lane >> 4);
                    const bf16x8 ah = *(const LAS bf16x8*)(NH + o), al = *(const LAS bf16x8*)(NL + o);
#pragma unroll
                    for (int nt = 0; nt < 2; ++nt) { acc[nt] = mfma16(ah, whi[ks][nt], acc[nt]); acc[nt] = mfma16(al, whi[ks][nt], acc[nt]); acc[nt] = mfma16(ah, wlo[ks][nt], acc[nt]); } }
#pragma unroll
                for (int nt = 0; nt < 2; ++nt)
#pragma unroll
                    for (int r = 0; r < 4; ++r) RP[wave * 512 + (4 * (lane >> 4) + r) * 32 + 16 * nt + (lane & 15)] = acc[nt][r];
            }
            LDS_BARRIER();
            {
                const int r16 = tid >> 5, e = tid & 31;
                float lg = a.in[I_BR][e];
#pragma unroll
                for (int w = 0; w < 8; ++w) lg += RP[w * 512 + r16 * 32 + e];
                LG[(16 * it + r16) * 33 + e] = lg;
            }
        }
        LDS_BARRIER();
        if (tid < 128) {
            float lg[32];
#pragma unroll
            for (int e = 0; e < 32; ++e) lg[e] = LG[tid * 33 + e];
            float tv[4]; int ti[4];
#pragma unroll
            for (int k = 0; k < 4; ++k) { float bv = -INFINITY; int bi = 0;
#pragma unroll
                for (int e = 0; e < 32; ++e) { bool ok = lg[e] > bv;
#pragma unroll
                    for (int q = 0; q < k; ++q) ok = ok && (e != ti[q]);
                    bv = ok ? lg[e] : bv; bi = ok ? e : bi; }
                tv[k] = bv; ti[k] = bi; }
            const float e1 = __expf(tv[1] - tv[0]), e2 = __expf(tv[2] - tv[0]), e3 = __expf(tv[3] - tv[0]);
            const float inv = 1.0f / (1.0f + e1 + e2 + e3);
            const float pr[4] = {inv, e1 * inv, e2 * inv, e3 * inv};
#pragma unroll
            for (int k = 0; k < 4; ++k) { const int pos = __hip_atomic_fetch_add(CNTL + ti[k], 1, __ATOMIC_RELAXED, __HIP_MEMORY_SCOPE_WORKGROUP); ENT_E[tid * 4 + k] = ti[k]; ENT_POS[tid * 4 + k] = pos; ENT_P[tid * 4 + k] = pr[k]; }
        }
        LDS_BARRIER();
        if (tid < 32) BASEL[tid] = (int)atomicAdd(gcnt + tid, (unsigned)CNTL[tid]);
        LDS_BARRIER();
        { const int e = ENT_E[tid], pos = BASEL[e] + ENT_POS[tid], token = blk * 128 + (tid >> 2);
            tok_e[(size_t)token * 4 + (tid & 3)] = e; tok_pos[(size_t)token * 4 + (tid & 3)] = pos; tok_p[(size_t)token * 4 + (tid & 3)] = ENT_P[tid];
            slot_tok[(size_t)e * T + pos] = token; }
        LDS_BARRIER();
    }
}

__device__ __forceinline__ int moe_tables(const Args& a, LAS unsigned char* lds) {
    LAS int* tp = (LAS int*)(lds + TP_OFF); LAS int* cn = tp + 40; LAS unsigned char* te = (LAS unsigned char*)(lds + TE_OFF);
    const unsigned* gcnt = (const unsigned*)(a.ws + WS_CTL) + CW_CNT;
    if (threadIdx.x == 0) { int s = 0; for (int e = 0; e < NE; ++e) { const int c = (int)gcnt[e]; tp[e] = s; cn[e] = c; s += (c + 255) >> 8; } tp[NE] = s; }
    __syncthreads();
    const int nM = tp[NE];
    for (int e = threadIdx.x >> 4; e < NE; e += 32) for (int p = tp[e] + (threadIdx.x & 15); p < tp[e + 1]; p += 16) te[p] = (unsigned char)e;
    __syncthreads();
    return nM;
}

__device__ __forceinline__ void p10_final(const Args& a, LAS unsigned char* lds, int G) {
    const int tid = threadIdx.x, lane = tid & 63, wave = __builtin_amdgcn_readfirstlane(tid >> 6);
    (void)moe_tables(a, lds);
    const LAS int* tp = (const LAS int*)(lds + TP_OFF);
    const float* mods = (const float*)(a.ws + WS_MODS); const unsigned char* OUT8 = a.ws + WS_OUT8; float* out = a.out; const bf16_t* H1 = (const bf16_t*)(a.ws + WS_H1);
    const int* tok_e = (const int*)(a.ws + WS_TOKE); const int* tok_pos = (const int*)(a.ws + WS_TOKPOS); const float* tok_p = (const float*)(a.ws + WS_TOKP);
    for (int rg = blockIdx.x * 8 + wave; rg < T / 16; rg += G * 8) {
        const int b = (rg * 16) / SEQ;
        f32x4 G2[4];
#pragma unroll
        for (int j = 0; j < 4; ++j) { const int k = 4 * lane + 256 * j; G2[j] = *(const f32x4*)(mods + b * 6144 + 5120 + k) * *(const f32x4*)(a.in[I_GPOSTF] + k); }
        const size_t mb = (size_t)rg * 64 + lane;
        const int me = tok_e[mb], mslot = tp[me] * 256 + tok_pos[mb]; const float mpr = tok_p[mb] * (1.0f / OSCALE);
        constexpr int P10D = 2;
        int nw[P10D][4][4]; u32x2 nh[P10D][4];
#define P10_LOADROW(d_, i_) do { const size_t m_ = (size_t)rg * 16 + (i_); \
            _Pragma("unroll") for (int k = 0; k < 4; ++k) { const size_t slot = (size_t)__builtin_amdgcn_readlane(mslot, 4 * (i_) + k); \
                _Pragma("unroll") for (int j = 0; j < 4; ++j) nw[d_][k][j] = *(const int*)(OUT8 + slot * 1024 + 4 * lane + 256 * j); } \
            _Pragma("unroll") for (int j = 0; j < 4; ++j) nh[d_][j] = __builtin_nontemporal_load((const u32x2*)(H1 + m_ * 1024 + 4 * lane + 256 * j)); } while (0)
#pragma unroll
        for (int d = 0; d < P10D; ++d) P10_LOADROW(d, d);
        for (int i0 = 0; i0 < 16; i0 += P10D) {
#pragma unroll
          for (int d = 0; d < P10D; ++d) {
            const int i = i0 + d; const size_t m = (size_t)rg * 16 + i;
            int cw[4][4]; u32x2 ch[4];
#pragma unroll
            for (int k = 0; k < 4; ++k)
#pragma unroll
                for (int j = 0; j < 4; ++j) cw[k][j] = nw[d][k][j];
#pragma unroll
            for (int j = 0; j < 4; ++j) ch[j] = nh[d][j];
            const int in_ = i + P10D < 16 ? i + P10D : 15;
            P10_LOADROW(d, in_);
            f32x4 f[4];
#pragma unroll
            for (int j = 0; j < 4; ++j) f[j] = (f32x4){0.f, 0.f, 0.f, 0.f};
#pragma unroll
            for (int k = 0; k < 4; ++k) {
                const float pk = __builtin_bit_cast(float, __builtin_amdgcn_readlane(__builtin_bit_cast(int, mpr), 4 * i + k));
#pragma unroll
                for (int j = 0; j < 4; ++j) { const int w = cw[k][j];
                    const f32x2 lo = __builtin_amdgcn_cvt_pk_f32_fp8(w, false), hi = __builtin_amdgcn_cvt_pk_f32_fp8(w, true);
                    f[j] += (f32x4){lo[0], lo[1], hi[0], hi[1]} * pk; }
            }
            float ss = 0.f;
#pragma unroll
            for (int j = 0; j < 4; ++j) ss += (f[j][0] * f[j][0] + f[j][1] * f[j][1]) + (f[j][2] * f[j][2] + f[j][3] * f[j][3]);
            const float rstd = __builtin_amdgcn_rsqf(wave_sum(ss) * (1.0f / 1024.0f) + EPS);
#pragma unroll
            for (int j = 0; j < 4; ++j) __builtin_nontemporal_store((f32x4){bflo(ch[j][0]), bfhi(ch[j][0]), bflo(ch[j][1]), bfhi(ch[j][1])} + G2[j] * f[j] * rstd, (f32x4*)(out + m * 1024 + 4 * lane + 256 * j));
          }
        }
#undef P10_LOADROW
    }
}

constexpr int N_PHASES = 11;
__global__ void __launch_bounds__(512, 2) mk_fwd(Args args) {
    extern __shared__ __attribute__((aligned(16))) unsigned char lds_raw[];
    LAS unsigned char* lds = (LAS unsigned char*)lds_raw;
    volatile LAS unsigned* MISC = (volatile LAS unsigned*)(lds + MISC_OFF);
    const int tid = threadIdx.x, G = gridDim.x;
    if (tid < 64) MISC[tid] = 0u;
    __syncthreads();
    unsigned* ctl = (unsigned*)(args.ws + WS_CTL);
    const int lo = args.ph_lo, hi = args.ph_hi;
    XcdBarrier bar; bar.bar = ctl + CW_BAR; bar.x = 0; bar.st = MISC + 8;
    if (hi - lo > 1) bar = xcd_barrier_post(ctl + CW_BAR, MISC + 8);
#define IN(k) (lo <= (k) && (k) < hi)
#define SEAM(k) do { if (IN((k) + 1)) xcd_barrier(bar); } while (0)
    const LAS unsigned short* TOK = (const LAS unsigned short*)(lds + TOK_OFF);
    if (IN(0)) { p0_prologue(args, lds, G); SEAM(0); }
    if (IN(1)) { p1_norm(args, lds, G); SEAM(1); }
    if (IN(2)) {
        pg8::Gemm g{args.ws + WS_XN, args.ws + WS_WIN, 2048}; pg8::StaticOrder S; S.init(T, NPROJ, G, (int)blockIdx.x);
        pg8::EpiProj E{(bf16_t*)(args.ws + WS_PROJ)};
        const int grp = (((int)blockIdx.x >> 3) * 6) >> 5, nun = (S.nwg + G - 1) / G, cut = grp < nun ? grp : nun;
        if (cut > 0) { S.base = 0; S.lim = cut; pg8::gemm_phase<pg8::EpiProj, pg8::StaticOrder, true, false, false>(lds, g, S, E, TOK); }
        __syncthreads(); moe_convert(args, lds, G, 0, MOE_ITEMS); __syncthreads();
        if (cut < nun) { S.base = cut; S.lim = nun - cut; pg8::gemm_phase<pg8::EpiProj, pg8::StaticOrder, true, false, false>(lds, g, S, E, TOK); }
        SEAM(2);
    }
    if (IN(3)) { p3_sgu(args, lds, G); __syncthreads(); p3_gla_state(args, lds, G); SEAM(3); }
    if (IN(4)) { p4_scan(args, G); SEAM(4); }
    if (IN(5)) { p5_gla_out(args, lds, G); SEAM(5); }
    if (IN(6)) {
        pg8::Gemm g{args.ws + WS_XN, args.ws + WS_WOUT, 2048}; pg8::StaticOrder S; S.init(T, 1024, G, (int)blockIdx.x);
        pg8::EpiPlain E{(bf16_t*)(args.ws + WS_MIX), 1024};
        pg8::gemm_phase<pg8::EpiPlain, pg8::StaticOrder, true, false, false>(lds, g, S, E, TOK);
        SEAM(6);
    }
    if (IN(7)) { p7_router(args, lds, G); SEAM(7); }
    if (IN(8)) {
        const int nM = moe_tables(args, lds);
        pg8::MoeOrder S; S.nM = nM; S.nN = 8; S.nwg = nM * 8; S.G = G; S.c = (int)blockIdx.x;
        S.tp = (const LAS int*)(lds + TP_OFF); S.cnt = S.tp + 40; S.te = (const LAS unsigned char*)(lds + TE_OFF);
        {
            LAS unsigned short* tokw = (LAS unsigned short*)(lds + TOK_OFF); const int* slot_tok = (const int*)(args.ws + WS_SLOT);
            pg8::Unit u;
            for (int i = 0; i < 18 && S.next(i, u); ++i) if (tid < 256) { const int p = u.prow + tid; tokw[i * 256 + tid] = (unsigned short)(p < u.cnt ? slot_tok[(size_t)u.e * T + p] : 0); }
            __syncthreads();
        }
        pg8::Gemm g{args.ws + WS_XN, args.ws + WS_W1, 1024};
        pg8::EpiSwiglu E{args.ws + WS_HDN, args.in[I_BG], args.in[I_BU]};
        pg8::gemm_phase<pg8::EpiSwiglu, pg8::MoeOrder, true, true, true>(lds, g, S, E, TOK);
        SEAM(8);
    }
    if (IN(9)) {
        const int nM = moe_tables(args, lds);
        pg8::MoeOrder S; S.nM = nM; S.nN = 4; S.nwg = nM * 4; S.G = G; S.c = (int)blockIdx.x;
        S.tp = (const LAS int*)(lds + TP_OFF); S.cnt = S.tp + 40; S.te = (const LAS unsigned char*)(lds + TE_OFF);
        pg8::Gemm g{args.ws + WS_HDN, args.ws + WS_WD, 1024};
        pg8::EpiOut8 E{args.ws + WS_OUT8, args.in[I_BDN]};
        pg8::gemm_phase<pg8::EpiOut8, pg8::MoeOrder, true, false, true>(lds, g, S, E, TOK);
        SEAM(9);
    }
    if (IN(10)) { p10_final(args, lds, G); }
#undef IN
#undef SEAM
}

#ifndef MK_SPLIT
#define MK_SPLIT 0
#endif
extern "C" void kernel_launch(void* const* d_in, const int* in_sizes, int n_in, void* d_out, int out_size, void* d_ws, size_t ws_size, hipStream_t stream) {
    static int grid = 0;
    if (grid == 0) {
        if (n_in != 24 || out_size != T * D || ws_size < WS_END) { fprintf(stderr, "kernel_launch: unexpected problem (n_in %d, out %d, ws %zu)\n", n_in, out_size, ws_size); grid = -1; return; }
        int dev = 0, cus = 0, per_cu = 0;
        if (hipGetDevice(&dev) != hipSuccess || hipDeviceGetAttribute(&cus, hipDeviceAttributeMultiprocessorCount, dev) != hipSuccess) { grid = -1; return; }
        if (hipFuncSetAttribute((const void*)mk_fwd, hipFuncAttributeMaxDynamicSharedMemorySize, LDS_BYTES) != hipSuccess) { grid = -1; return; }
        if (hipOccupancyMaxActiveBlocksPerMultiprocessor(&per_cu, (const void*)mk_fwd, 512, LDS_BYTES) != hipSuccess || per_cu < 1) { fprintf(stderr, "kernel_launch: occupancy query says %d\n", per_cu); (void)hipGetLastError(); grid = -1; return; }
        grid = cus;
    }
    if (grid < 0) return;
    (void)hipMemsetAsync((char*)d_ws + WS_CTL, 0, CTL_ZERO_BYTES, stream);
    Args a{};
    for (int i = 0; i < 24; ++i) a.in[i] = (const float*)d_in[i];
    a.out = (float*)d_out; a.ws = (unsigned char*)d_ws;
#if MK_SPLIT
    for (int p = 0; p < N_PHASES; ++p) { a.ph_lo = p; a.ph_hi = p + 1; hipLaunchKernelGGL(mk_fwd, dim3(grid), dim3(512), LDS_BYTES, stream, a); }
#else
    a.ph_lo = 0; a.ph_hi = N_PHASES;
    hipLaunchKernelGGL(mk_fwd, dim3(grid), dim3(512), LDS_BYTES, stream, a);
#endif
}
```

```cpp
#include <hip/hip_runtime.h>
#include <cstdio>
#include <cstdint>

#define LAS __attribute__((address_space(3)))
typedef unsigned short bf16_t;
typedef short bf16x8 __attribute__((ext_vector_type(8)));
typedef float f32x4 __attribute__((ext_vector_type(4)));
typedef float f32x2 __attribute__((ext_vector_type(2)));
typedef unsigned u32x4 __attribute__((ext_vector_type(4)));
typedef unsigned u32x2 __attribute__((ext_vector_type(2)));

constexpr int T = 32768, D = 1024, SEQ = 8192;
constexpr int D_IN = 2576, NPROJ = 2560;
constexpr int NE = 32;
constexpr float EPS = 1e-6f;
#define PROJ_IDX(t_, c_) (((size_t)((c_) >> 6) * T + (size_t)(t_)) * 64 + (size_t)((c_) & 63))
#define GLA_TOKP(t_) (((t_) & ~8191) | (((((t_) >> 6) & 7) << 4 | (((t_) >> 9) & 15)) << 6) | ((t_) & 63))
constexpr int C_US = 0, C_VS = 512, C_Q = 1024, C_K = 1280, C_V = 1536, C_R = 2048, C_GL = 2560;
constexpr float OSCALE = 8.0f;
constexpr float W8_SCALE = 32.0f;
#define W8_SCALE_E8M0 0x7A7A7A7A

constexpr size_t MiB = 1u << 20;
constexpr size_t WS_CTL = 0, CTL_ZERO_BYTES = 32 * 1024;
constexpr int CW_TMO = 0, CW_CNT = 1024, CW_BAR = 4096;
constexpr size_t WS_MODS = 256 * 1024;
constexpr size_t WS_GLOW = 2 * MiB;
constexpr size_t WS_TOKE = 4 * MiB, WS_TOKPOS = WS_TOKE + 512 * 1024, WS_TOKP = WS_TOKE + 1024 * 1024;
constexpr size_t WS_DEC = 5 * MiB + 512 * 1024;
constexpr size_t WS_SLOT = 6 * MiB;
constexpr size_t WS_WR = 10 * MiB;
constexpr size_t WS_WIN = 11 * MiB;
constexpr size_t WS_WOUT = 16 * MiB;
constexpr size_t WS_WD = 18 * MiB;
constexpr size_t WS_W1 = 50 * MiB;
constexpr size_t WS_XN = 114 * MiB;
constexpr size_t WS_PROJ = 178 * MiB;
constexpr size_t WS_ST = 338 * MiB;
constexpr size_t WS_PREV = 402 * MiB;
constexpr size_t WS_MIX = 178 * MiB;
constexpr size_t WS_HDN = 178 * MiB;
constexpr size_t WS_OUT8 = 338 * MiB;
constexpr size_t WS_BCUM = 434 * MiB;
constexpr size_t WS_H1 = 474 * MiB;
constexpr size_t WS_END = 538 * MiB;
constexpr int MAX_TILES = 543;

constexpr int RING_BYTES = 131072;
constexpr int MISC_OFF = RING_BYTES;
constexpr int TP_OFF = MISC_OFF + 256;
constexpr int TE_OFF = TP_OFF + 512;
constexpr int TOK_OFF = TE_OFF + 1024;
constexpr int BIAS_OFF = TOK_OFF + 18 * 512;
constexpr int LDS_BYTES = 147456;
static_assert(BIAS_OFF + 2048 <= LDS_BYTES && BIAS_OFF % 16 == 0, "LDS map");

__device__ __forceinline__ unsigned f2bf(float f) { unsigned u = __builtin_bit_cast(unsigned, f); return (u + 0x7fffu + ((u >> 16) & 1u)) >> 16; }
__device__ __forceinline__ float bf2f(unsigned h) { return __builtin_bit_cast(float, h << 16); }
__device__ __forceinline__ float bflo(unsigned w) { return __builtin_bit_cast(float, w << 16); }
__device__ __forceinline__ float bfhi(unsigned w) { return __builtin_bit_cast(float, w & 0xffff0000u); }
typedef __bf16 bf16x2_t __attribute__((ext_vector_type(2)));
__device__ __forceinline__ unsigned pk2(float lo, float hi) { const f32x2 v = {lo, hi}; return __builtin_bit_cast(unsigned, __builtin_convertvector(v, bf16x2_t)); }
__device__ __forceinline__ unsigned pk4_fp8(float a, float b, float c, float d) {
    int w = __builtin_amdgcn_cvt_pk_fp8_f32(a, b, 0, false); w = __builtin_amdgcn_cvt_pk_fp8_f32(c, d, w, true); return (unsigned)w; }
__device__ __forceinline__ float clamp448(float v) { return __builtin_amdgcn_fmed3f(v, -448.0f, 448.0f); }
#define LDS_BARRIER() do { asm volatile("s_waitcnt lgkmcnt(0)" ::: "memory"); __builtin_amdgcn_s_barrier(); asm volatile("" ::: "memory"); } while (0)
#define WS_DPP(v_, ctrl_) __builtin_bit_cast(float, __builtin_amdgcn_update_dpp(0, __builtin_bit_cast(int, (v_)), (ctrl_), 0xf, 0xf, true))
__device__ __forceinline__ float wave_sum(float v) {
    v += WS_DPP(v, 0xB1);
    v += WS_DPP(v, 0x4E);
    v += WS_DPP(v, 0x124);
    v += WS_DPP(v, 0x128);
    const int iv = __builtin_bit_cast(int, v);
    return (__builtin_bit_cast(float, __builtin_amdgcn_readlane(iv, 0)) + __builtin_bit_cast(float, __builtin_amdgcn_readlane(iv, 16)))
         + (__builtin_bit_cast(float, __builtin_amdgcn_readlane(iv, 32)) + __builtin_bit_cast(float, __builtin_amdgcn_readlane(iv, 48)));
}
__device__ __forceinline__ f32x4 mfma16(bf16x8 a, bf16x8 b, f32x4 c) { return __builtin_amdgcn_mfma_f32_16x16x32_bf16(a, b, c, 0, 0, 0); }
__device__ __forceinline__ float sigmoidf_(float x) { return __builtin_amdgcn_rcpf(1.0f + __builtin_amdgcn_exp2f(-1.4426950408889634f * x)); }
__device__ __forceinline__ float gelu_tanh(float x) { const float u = x + 0.044715f * x * x * x; return x * __builtin_amdgcn_rcpf(1.0f + __builtin_amdgcn_exp2f(-2.302208198f * u)); }
__device__ __forceinline__ float silu_(float x) { return x * sigmoidf_(x); }
__device__ __forceinline__ f32x2 rcp2(f32x2 v) { return (f32x2){__builtin_amdgcn_rcpf(v[0]), __builtin_amdgcn_rcpf(v[1])}; }
__device__ __forceinline__ f32x2 exp2_2(f32x2 v) { return (f32x2){__builtin_amdgcn_exp2f(v[0]), __builtin_amdgcn_exp2f(v[1])}; }
__device__ __forceinline__ f32x2 clamp2(f32x2 v, float lo, float hi) { return (f32x2){__builtin_amdgcn_fmed3f(v[0], lo, hi), __builtin_amdgcn_fmed3f(v[1], lo, hi)}; }
__device__ __forceinline__ f32x2 gelu_tanh2(f32x2 x) { const f32x2 u = x + (x * x) * (x * 0.044715f); return x * rcp2(exp2_2(u * -2.302208198f) + 1.0f); }
__device__ __forceinline__ f32x2 silu2(f32x2 x) { return x * rcp2(exp2_2(x * -1.4426950408889634f) + 1.0f); }

#define XB_TMO      128
#define XB_XCNT(j)  (256  + 64 * (j))
#define XB_XSUB(j)  (1280 + 64 * (j))
#define XB_XGEN(j)  (2304 + 64 * (j))
#define XB_TOP      3328
#define XB_TOPGEN   3392
#define XCD_BAR_WORDS 3456
static_assert((CW_BAR + XCD_BAR_WORDS) * 4 <= (int)CTL_ZERO_BYTES, "control words must lie inside the zeroed region");
#define XB_SPIN_CAP (1u << 20)
__device__ __forceinline__ unsigned xb_ld(unsigned* p)              { return __hip_atomic_load(p, __ATOMIC_RELAXED, __HIP_MEMORY_SCOPE_AGENT); }
__device__ __forceinline__ unsigned xb_add(unsigned* p, unsigned v) { return __hip_atomic_fetch_add(p, v, __ATOMIC_RELAXED, __HIP_MEMORY_SCOPE_AGENT); }
__device__ __forceinline__ unsigned xb_xcc_id() { return (unsigned)__builtin_amdgcn_s_getreg((3 << 11) | 20) & 0xFu; }
#define XB_SPIN(cond, bar) do { unsigned _sp = 0; while (cond) { __builtin_amdgcn_s_sleep(1); \
    if ((++_sp & 255u) == 0u) { if (xb_ld(&(bar)[XB_TMO])) break; if (_sp > XB_SPIN_CAP) { atomicAdd(&(bar)[XB_TMO], 1u); break; } } } } while (0)
struct XcdBarrier { unsigned* bar; unsigned x; volatile LAS unsigned* st; };
__device__ __forceinline__ XcdBarrier xcd_barrier_post(unsigned* bar, volatile LAS unsigned* st) {
    XcdBarrier b; b.bar = bar; b.x = xb_xcc_id(); b.st = st;
    if (threadIdx.x == 0) (void)xb_add(&bar[XB_XCNT(b.x)], 1u);
    return b;
}
__device__ __forceinline__ void xcd_barrier_complete(unsigned* bar, unsigned x, unsigned& nloc, unsigned& nx) {
    const unsigned G = gridDim.x * gridDim.y * gridDim.z;
    unsigned sum, cnt, mine, sp = 0u;
    for (;;) {
        sum = 0u; cnt = 0u; mine = 0u;
#pragma unroll
        for (unsigned j = 0; j < 16; ++j) { const unsigned c = xb_ld(&bar[XB_XCNT(j)]); sum += c; cnt += (c > 0u) ? 1u : 0u; mine = (j == x) ? c : mine; }
        if (sum == G) break;
        __builtin_amdgcn_s_sleep(1);
        if ((++sp & 255u) == 0u) { if (xb_ld(&bar[XB_TMO])) break; if (sp > XB_SPIN_CAP) { atomicAdd(&bar[XB_TMO], 1u); break; } }
    }
    nloc = mine > 0u ? mine : 1u; nx = cnt > 0u ? cnt : 1u;
}
__device__ __forceinline__ void xcd_barrier(const XcdBarrier& b) {
    asm volatile("s_waitcnt vmcnt(0)" ::: "memory");
    __syncthreads();
    if (threadIdx.x == 0) {
        unsigned* bar = b.bar;
        __builtin_amdgcn_s_waitcnt(0);
        unsigned nloc = b.st[0], nx = b.st[1];
        if (nloc == 0u) { xcd_barrier_complete(bar, b.x, nloc, nx); b.st[0] = nloc; b.st[1] = nx; }
        const unsigned old = xb_add(&bar[XB_XSUB(b.x)], 1u);
        const unsigned gen = old / nloc;
        if (old + 1u == (gen + 1u) * nloc) {
            __builtin_amdgcn_fence(__ATOMIC_RELEASE, "agent");
            asm volatile("s_waitcnt vmcnt(0)" ::: "memory");
            const unsigned og = xb_add(&bar[XB_TOP], 1u);
            const unsigned tg = og / nx;
            if (og + 1u == (tg + 1u) * nx) xb_add(&bar[XB_TOPGEN], 1u);
            else XB_SPIN(xb_ld(&bar[XB_TOPGEN]) == tg, bar);
            __builtin_amdgcn_fence(__ATOMIC_ACQUIRE, "agent");
            xb_add(&bar[XB_XGEN(b.x)], 1u);
            asm volatile("s_waitcnt vmcnt(0)" ::: "memory");
        } else {
            XB_SPIN(xb_ld(&bar[XB_XGEN(b.x)]) == gen, bar);
            __builtin_amdgcn_fence(__ATOMIC_ACQUIRE, "agent");
            asm volatile("s_waitcnt vmcnt(0)" ::: "memory");
        }
    }
    __syncthreads();
}

namespace pg8 {
constexpr int BM = 256, BK = 64, HALF = 128, HTB = HALF * BK * 2, STAGE_BYTES = 8 * HTB, NXCD = 8, WGM = 8;
template <int SH> __host__ __device__ __forceinline__ int lds_byte(int r, int cb) { const int st = (r >> 4) * 2 + (cb >> 6), rr = r & 15, ob = rr * 64 + (cb & 63); return st * 1024 + (ob ^ (((ob >> 9) & 1) << SH)); }
template <int SH> __host__ __device__ __forceinline__ void stage_rc(int b, int& R, int& CB) { const int st = b / 1024, sb = b % 1024, swz = sb ^ (((sb >> 9) & 1) << SH); R = (st >> 1) * 16 + swz / 64; CB = (st & 1) * 64 + (swz % 64); }
__host__ __device__ __forceinline__ int perm32(int rho) { const int n = rho >> 4, i = rho & 15; return 8 * (i >> 2) + 4 * n + (i & 3); }

struct Unit { int pm, pn, bt, e, prow, cnt, half; };
struct Gemm { const void* A; const void* Bt; int Kb; };

__device__ __forceinline__ void tile_of(int L, int nM, int nN, int nwg, int& pm, int& pn) {
    int wgid = L; { const int q = nwg / NXCD, r = nwg % NXCD, xcd = wgid % NXCD, off = wgid / NXCD; wgid = (xcd < r ? xcd * (q + 1) : r * (q + 1) + (xcd - r) * q) + off; }
    const int nig = WGM * nN, gid = wgid / nig, fm = gid * WGM, gsz = (nM - fm) < WGM ? (nM - fm) : WGM;
    pm = fm + ((wgid % nig) % gsz); pn = (wgid % nig) / gsz;
}
struct StaticOrder {
    int nM, nN, nwg, G, c, base, lim;
    __device__ void init(int M, int N, int G_, int c_) { nM = M / BM; nN = N / BM; nwg = nM * nN; G = G_; c = c_; base = 0; lim = 1 << 30; }
    __device__ __forceinline__ bool next(int i, Unit& u) const {
        if (i >= lim) return false;
        const long L = (long)(i + base) * G + c; if (L >= nwg) return false;
        tile_of((int)L, nM, nN, nwg, u.pm, u.pn); u.bt = u.pn; u.e = 0; u.prow = 0; u.cnt = 0; u.half = -1; return true;
    }
};
struct MoeOrder {
    int nM, nN, nwg, G, c; const LAS int* tp; const LAS unsigned char* te; const LAS int* cnt;
    __device__ __forceinline__ bool next(int i, Unit& u) const {
        const int Rf = nwg / G, Lo = nwg - Rf * G; const bool split = (Lo > 0) && (2 * Lo <= G);
        long L; u.half = -1;
        if (i < Rf) L = (long)i * G + c;
        else if (i == Rf && !split) { if (c >= Lo) return false; L = (long)Rf * G + c; }
        else if (i == Rf) { if (c >= 2 * Lo) return false; L = (long)Rf * G + (c >> 1); u.half = c & 1; }
        else return false;
        tile_of((int)L, nM, nN, nwg, u.pm, u.pn);
        const int e = __builtin_amdgcn_readfirstlane((int)te[u.pm]);
        u.e = e; u.bt = e * nN + u.pn; u.prow = (u.pm - __builtin_amdgcn_readfirstlane(tp[e])) * BM; u.cnt = __builtin_amdgcn_readfirstlane(cnt[e]); return true;
    }
};

struct EpiProj {
    static constexpr int PERMK = 1; static constexpr bool HAS_BIAS = false; static constexpr float BIAS_MUL = 1.0f; static constexpr int ACT_E8M0 = 0x7F7F7F7F;
    __device__ __forceinline__ const float* bias_src(const Unit&, int) const { return nullptr; }
    static __device__ __forceinline__ int bias_off(int, int, int, int) { return 0; }
    bf16_t* O;
    __device__ __forceinline__ void operator()(const f32x4 (&acc)[2][2][4][2], const Unit& u, int wr, int wc, int fr, int fq, const LAS float*) const {
        const int row0 = u.pm * BM + wr * 64 + fr, col0 = u.pn * BM + wc * 32 + 8 * fq;
        const int mode = (u.pn < 4) ? 1 : (u.pn >= 8 ? 2 : (u.pn == 4 ? 3 : 0));
#pragma unroll
        for (int ai = 0; ai < 2; ++ai)
#pragma unroll
            for (int m = 0; m < 4; ++m) { const int rown = row0 + ai * HALF + m * 16, rowt = (u.pn >= 4) ? GLA_TOKP(rown) : rown;
#pragma unroll
                for (int bj = 0; bj < 2; ++bj) { f32x2 v[4];
#pragma unroll
                    for (int n = 0; n < 2; ++n) { v[2 * n] = (f32x2){acc[ai][bj][m][n][0], acc[ai][bj][m][n][1]}; v[2 * n + 1] = (f32x2){acc[ai][bj][m][n][2], acc[ai][bj][m][n][3]}; }
                    if (mode == 1) {
#pragma unroll
                        for (int i = 0; i < 4; ++i) v[i] = gelu_tanh2(v[i]);
                    } else if (mode == 2) {
#pragma unroll
                        for (int i = 0; i < 4; ++i) v[i] = silu2(v[i]);
                    } else if (mode == 3) {
#pragma unroll
                        for (int i = 0; i < 4; ++i) v[i] = v[i] * 0.125f;
                    }
                    u32x4 w; w.x = pk2(v[0][0], v[0][1]); w.y = pk2(v[1][0], v[1][1]); w.z = pk2(v[2][0], v[2][1]); w.w = pk2(v[3][0], v[3][1]);
                    *(u32x4*)(O + PROJ_IDX(rowt, col0 + bj * HALF)) = w; } }
    }
};
struct EpiPlain {
    static constexpr int PERMK = 1; static constexpr bool HAS_BIAS = false; static constexpr float BIAS_MUL = 1.0f; static constexpr int ACT_E8M0 = 0x7F7F7F7F;
    __device__ __forceinline__ const float* bias_src(const Unit&, int) const { return nullptr; }
    static __device__ __forceinline__ int bias_off(int, int, int, int) { return 0; }
    bf16_t* O; int ldc;
    __device__ __forceinline__ void operator()(const f32x4 (&acc)[2][2][4][2], const Unit& u, int wr, int wc, int fr, int fq, const LAS float*) const {
        const int row0 = u.pm * BM + wr * 64 + fr, col0 = u.pn * BM + wc * 32 + 8 * fq;
#pragma unroll
        for (int ai = 0; ai < 2; ++ai)
#pragma unroll
            for (int m = 0; m < 4; ++m) { bf16_t* rowp = O + (size_t)(row0 + ai * HALF + m * 16) * ldc + col0;
#pragma unroll
                for (int bj = 0; bj < 2; ++bj) { const f32x4 v0 = acc[ai][bj][m][0], v1 = acc[ai][bj][m][1];
                    u32x4 w; w.x = pk2(v0[0], v0[1]); w.y = pk2(v0[2], v0[3]); w.z = pk2(v1[0], v1[1]); w.w = pk2(v1[2], v1[3]);
                    *(u32x4*)(rowp + bj * HALF) = w; } }
    }
};
struct EpiSwiglu {
    static constexpr int PERMK = 1; static constexpr bool HAS_BIAS = true; static constexpr float BIAS_MUL = 1.0f; static constexpr int ACT_E8M0 = 0x7F7F7F7F;
    static __device__ __forceinline__ int bias_off(int bj, int n, int wc, int fq) { return bj * HALF + wc * 32 + 8 * fq + 4 * n; }
    unsigned char* H; const float* bg; const float* bu;
    __device__ __forceinline__ const float* bias_src(const Unit& u, int j) const { return (j < 128 ? bg : bu) + (size_t)u.e * 1024 + u.pn * HALF + (j & 127); }
    __device__ __forceinline__ void operator()(const f32x4 (&acc)[2][2][4][2], const Unit& u, int wr, int wc, int fr, int fq, const LAS float* btab) const {
        const int row0 = u.pm * BM + (u.half > 0 ? HALF : 0) + wr * 64 + fr, hc0 = u.pn * HALF + wc * 32 + 8 * fq;
#pragma unroll
        for (int ai = 0; ai < 2; ++ai) if (ai == 0 || u.half < 0)
#pragma unroll
            for (int m = 0; m < 4; ++m) { f32x2 h[4];
#pragma unroll
                for (int n = 0; n < 2; ++n)
#pragma unroll
                    for (int q = 0; q < 2; ++q) {
                        const f32x2 g = clamp2((f32x2){acc[ai][0][m][n][2 * q], acc[ai][0][m][n][2 * q + 1]}, -3.0e38f, 7.0f);
                        const f32x2 uu = clamp2((f32x2){acc[ai][1][m][n][2 * q], acc[ai][1][m][n][2 * q + 1]}, -7.0f, 7.0f);
                        h[2 * n + q] = (uu * g + g) * rcp2(exp2_2(g * (-1.702f * 1.4426950408889634f)) + 1.0f); }
                *(u32x2*)(H + (size_t)(row0 + ai * HALF + m * 16) * 1024 + hc0) = (u32x2){pk4_fp8(h[0][0], h[0][1], h[1][0], h[1][1]), pk4_fp8(h[2][0], h[2][1], h[3][0], h[3][1])}; }
    }
};
struct EpiOut8 {
    static constexpr int PERMK = 2; static constexpr bool HAS_BIAS = true; static constexpr float BIAS_MUL = OSCALE; static constexpr int ACT_E8M0 = 0x82828282;
    static __device__ __forceinline__ int bias_off(int bj, int n, int wc, int fq) { return wc * 64 + 16 * fq + 8 * bj + 4 * n; }
    unsigned char* O; const float* bd;
    __device__ __forceinline__ const float* bias_src(const Unit& u, int j) const { return bd + (size_t)u.e * 1024 + u.pn * BM + j; }
    __device__ __forceinline__ void operator()(const f32x4 (&acc)[2][2][4][2], const Unit& u, int wr, int wc, int fr, int fq, const LAS float* btab) const {
        const int row0 = u.pm * BM + (u.half > 0 ? HALF : 0) + wr * 64 + fr, col0 = u.pn * BM + wc * 64 + 16 * fq;
#pragma unroll
        for (int ai = 0; ai < 2; ++ai) if (ai == 0 || u.half < 0)
#pragma unroll
            for (int m = 0; m < 4; ++m) { u32x4 w;
#pragma unroll
                for (int bj = 0; bj < 2; ++bj)
#pragma unroll
                    for (int n = 0; n < 2; ++n) { const f32x4 c = acc[ai][bj][m][n];
                        w[2 * bj + n] = pk4_fp8(__builtin_amdgcn_fmed3f(c[0], -440.0f, 440.0f), __builtin_amdgcn_fmed3f(c[1], -440.0f, 440.0f), __builtin_amdgcn_fmed3f(c[2], -440.0f, 440.0f), __builtin_amdgcn_fmed3f(c[3], -440.0f, 440.0f)); }
                *(u32x4*)(O + (size_t)(row0 + ai * HALF + m * 16) * 1024 + col0) = w; }
    }
};

typedef int i32x4 __attribute__((ext_vector_type(4)));
typedef int i32x8 __attribute__((ext_vector_type(8)));
template <bool FP8> struct Frag;
template <> struct Frag<false> { bf16x8 k0, k1; __device__ __forceinline__ void ld(const LAS unsigned char* p0, const LAS unsigned char* p1) { k0 = *(const LAS bf16x8*)p0; k1 = *(const LAS bf16x8*)p1; } };
template <> struct Frag<true> { i32x8 v; __device__ __forceinline__ void ld(const LAS unsigned char* p0, const LAS unsigned char* p1) { v = __builtin_shufflevector(*(const LAS i32x4*)p0, *(const LAS i32x4*)p1, 0, 1, 2, 3, 4, 5, 6, 7); } };
__device__ __forceinline__ f32x4 frag_mma(const Frag<false>& b, const Frag<false>& a, f32x4 c) { c = __builtin_amdgcn_mfma_f32_16x16x32_bf16(b.k0, a.k0, c, 0, 0, 0); return __builtin_amdgcn_mfma_f32_16x16x32_bf16(b.k1, a.k1, c, 0, 0, 0); }
__device__ __forceinline__ f32x4 frag_mma(const Frag<true>& b, const Frag<true>& a, f32x4 c, int sw, int s1) {
    asm volatile("s_nop 1\n\tv_mfma_scale_f32_16x16x128_f8f6f4 %0, %1, %2, %0, %3, %4 op_sel_hi:[0,0,0]" : "+v"(c) : "v"(b.v), "v"(a.v), "v"(sw), "v"(s1)); return c; }
__device__ __forceinline__ f32x4 frag_mma(const Frag<false>& b, const Frag<false>& a, f32x4 c, int, int) { return frag_mma(b, a, c); }
template <class Epi, class Sched, bool ALIGN_EPI, bool GATHER, bool FP8>
__device__ __forceinline__ void gemm_phase(LAS unsigned char* lds, const Gemm g, const Sched& S, const Epi& E, const LAS unsigned short* tok) {
    const int tid = threadIdx.x, wid = __builtin_amdgcn_readfirstlane(tid >> 6), lane = tid & 63, wr = wid >> 2, wc = wid & 3, fr = lane & 15, fq = lane >> 4;
    constexpr int SH = FP8 ? 4 : 5;
    const int K = g.Kb, nt = K / 128;
    unsigned voffB[2]; unsigned va[2][2], vn[2][2]; int RA[2], CA[2];
#pragma unroll
    for (int i = 0; i < 2; ++i) { int R, C; stage_rc<SH>(tid * 16 + i * 8192, R, C);
        const int Rb = Epi::PERMK == 2 ? (((R >> 5) & 3) * 64 + ((R >> 2) & 3) * 16 + ((R >> 4) & 1) * 4 + (R & 3)) : (Epi::PERMK == 1 ? ((R & ~31) + perm32(R & 31)) : R);
        RA[i] = R; CA[i] = C; voffB[i] = (unsigned)(Rb * K + C);
#pragma unroll
        for (int h = 0; h < 2; ++h) { va[h][i] = (unsigned)((R + h * HALF) * K + C); vn[h][i] = va[h][i]; } }
    unsigned vplain[2][2];
#pragma unroll
    for (int h = 0; h < 2; ++h)
#pragma unroll
        for (int i = 0; i < 2; ++i) vplain[h][i] = va[h][i];
    const size_t kstep = 128;
    const size_t hstep = (size_t)HALF * K;
    const size_t tstep = 2 * hstep;
    const size_t hstepB = Epi::PERMK == 2 ? (size_t)8 * K : hstep;
    const unsigned ldsw = (unsigned)wid * 1024u;
    const int aoff0 = FP8 ? lds_byte<SH>(wr * 64 + fr, fq * 32) : lds_byte<SH>(wr * 64 + fr, fq * 16), aoff1 = FP8 ? lds_byte<SH>(wr * 64 + fr, fq * 32 + 16) : aoff0 + 1024;
    const int boff0 = FP8 ? lds_byte<SH>(wc * 32 + fr, fq * 32) : lds_byte<SH>(wc * 32 + fr, fq * 16), boff1 = FP8 ? lds_byte<SH>(wc * 32 + fr, fq * 32 + 16) : boff0 + 1024;
#define PG8_SA(b, h) (((b) * 2 + (h)) * HTB)
#define PG8_SB(b, h) ((4 + (b) * 2 + (h)) * HTB)
#define PG8_STAGE(bufoff, gbase, voff) do { _Pragma("unroll") for (int _i = 0; _i < 2; ++_i) \
        __builtin_amdgcn_global_load_lds((const unsigned*)((const char*)(gbase) + (voff)[_i]), (LAS unsigned*)(lds + (bufoff) + ldsw + _i * 8192), 16, 0, 0); } while (0)
#define PG8_LDA(dst, b, h) do { _Pragma("unroll") for (int m = 0; m < 4; ++m) dst[m].ld(lds + PG8_SA(b, h) + aoff0 + m * 2048, lds + PG8_SA(b, h) + aoff1 + m * 2048); } while (0)
#define PG8_LDB(dst, b, h) do { _Pragma("unroll") for (int n = 0; n < 2; ++n) dst[n].ld(lds + PG8_SB(b, h) + boff0 + n * 2048, lds + PG8_SB(b, h) + boff1 + n * 2048); } while (0)
#define PG8_MMA(ai, bj, At, Bt) do { __builtin_amdgcn_s_setprio(1); _Pragma("unroll") for (int m = 0; m < 4; ++m) _Pragma("unroll") for (int n = 0; n < 2; ++n) \
        acc[ai][bj][m][n] = frag_mma(Bt[n], At[m], acc[ai][bj][m][n], sc_w, sc_1); __builtin_amdgcn_s_setprio(0); } while (0)
#define PG8_WAIT_V(n) asm volatile("s_waitcnt vmcnt(" #n ")" ::: "memory")
#define PG8_WAIT_L(n) asm volatile("s_waitcnt lgkmcnt(" #n ")" ::: "memory")
#define PG8_BAR __builtin_amdgcn_s_barrier()
#define PG8_SCHED __builtin_amdgcn_sched_barrier(0)
#define PG8_GATHER_OFFS(dst, ui_, half_) do { _Pragma("unroll") for (int _h = 0; _h < 2; ++_h) _Pragma("unroll") for (int _i = 0; _i < 2; ++_i) \
        dst[_h][_i] = (unsigned)tok[(ui_) * 256 + ((half_) >= 0 ? (half_) * HALF : _h * HALF) + RA[_i]] * (unsigned)K + (unsigned)CA[_i]; } while (0)
#define PG8_PLAIN_OFFS(dst, half_) do { _Pragma("unroll") for (int _i = 0; _i < 2; ++_i) { dst[0][_i] = vplain[0][_i]; dst[1][_i] = (half_) >= 0 ? vplain[0][_i] : vplain[1][_i]; } } while (0)
    Unit cur, nxt; int ui = 0;
    if (!S.next(0, cur)) return;
    f32x4 acc[2][2][4][2];
#define PG8_ACC_INIT(slot_) do { _Pragma("unroll") for (int b = 0; b < 2; ++b) _Pragma("unroll") for (int n = 0; n < 2; ++n) { f32x4 bi_ = (f32x4){0.f, 0.f, 0.f, 0.f}; \
        if constexpr (Epi::HAS_BIAS) bi_ = *(const LAS f32x4*)(lds + BIAS_OFF + (slot_) * 1024 + 4 * Epi::bias_off(b, n, wc, fq)) * Epi::BIAS_MUL; \
        _Pragma("unroll") for (int a = 0; a < 2; ++a) _Pragma("unroll") for (int m = 0; m < 4; ++m) acc[a][b][m][n] = bi_; } } while (0)
    Frag<FP8> At[4], B0[2], B1[2];
    int sc_w = W8_SCALE_E8M0, sc_1 = Epi::ACT_E8M0;
    if constexpr (FP8) { asm volatile("" : "+v"(sc_w), "+v"(sc_1)); }
    const char* cA = GATHER ? (const char*)g.A : (const char*)g.A + (size_t)cur.pm * tstep + (cur.half > 0 ? hstep : 0);
    const char* cB = (const char*)g.Bt + (size_t)cur.bt * tstep;
    if constexpr (GATHER) { PG8_GATHER_OFFS(va, 0, cur.half); } else { PG8_PLAIN_OFFS(va, cur.half); }
#define PG8_BIAS_DMA(unit_, slot_) do { if constexpr (Epi::HAS_BIAS) { if (wid < 4) \
        __builtin_amdgcn_global_load_lds((const unsigned*)E.bias_src(unit_, wid * 64 + lane), (LAS unsigned*)(lds + BIAS_OFF + (slot_) * 1024 + wid * 256), 4, 0, 0); } } while (0)
    PG8_BIAS_DMA(cur, 0);
    PG8_STAGE(PG8_SB(0, 0), cB, voffB); PG8_STAGE(PG8_SB(0, 1), cB + hstepB, voffB); PG8_STAGE(PG8_SA(0, 0), cA, va[0]); PG8_STAGE(PG8_SA(0, 1), cA, va[1]);
    if (wr == 1) PG8_BAR;
    PG8_WAIT_V(2); PG8_BAR;
    PG8_STAGE(PG8_SB(1, 0), cB + kstep, voffB); PG8_STAGE(PG8_SA(1, 0), cA + kstep, va[0]); PG8_STAGE(PG8_SB(1, 1), cB + hstepB + kstep, voffB);
    PG8_WAIT_V(6); PG8_BAR;
    PG8_ACC_INIT(0);
    for (;;) {
        const bool has_next = S.next(ui + 1, nxt);
        const char* nA = GATHER ? (const char*)g.A : (has_next ? (const char*)g.A + (size_t)nxt.pm * tstep + (nxt.half > 0 ? hstep : 0) : cA);
        const char* nB = has_next ? (const char*)g.Bt + (size_t)nxt.bt * tstep : cB;
        if (has_next) { if constexpr (GATHER) { PG8_GATHER_OFFS(vn, ui + 1, nxt.half); } else { PG8_PLAIN_OFFS(vn, nxt.half); } }
        else {
#pragma unroll
            for (int h = 0; h < 2; ++h)
#pragma unroll
                for (int i = 0; i < 2; ++i) vn[h][i] = va[h][i]; }
        const bool full = cur.half < 0;
#pragma nounroll
        for (int t = 0; t < nt; t += 2) {
            const bool last = (t == nt - 2);
            const char* a1 = cA + (size_t)(t + 1) * kstep;
            const char* a2 = last ? nA : cA + (size_t)(t + 2) * kstep; const char* b2 = last ? nB : cB + (size_t)(t + 2) * kstep;
            const char* a3 = a2 + kstep; const char* b3 = b2 + kstep;
            unsigned v0[2], v1[2];
            if (last && has_next) PG8_BIAS_DMA(nxt, (ui + 1) & 1);
#pragma unroll
            for (int i = 0; i < 2; ++i) { v0[i] = last ? vn[0][i] : va[0][i]; v1[i] = last ? vn[1][i] : va[1][i]; }
            PG8_STAGE(PG8_SA(1, 1), a1, va[1]); PG8_SCHED; PG8_LDA(At, 0, 0); PG8_SCHED; PG8_LDB(B0, 0, 0); PG8_LDB(B1, 0, 1);
            PG8_WAIT_V(8); PG8_WAIT_L(0); PG8_BAR; PG8_MMA(0, 0, At, B0); PG8_MMA(0, 1, At, B1); PG8_BAR; PG8_SCHED;
            PG8_LDA(At, 0, 1); PG8_STAGE(PG8_SB(0, 0), b2, voffB); PG8_STAGE(PG8_SB(0, 1), b2 + hstepB, voffB); PG8_STAGE(PG8_SA(0, 0), a2, v0);
            PG8_WAIT_V(8); PG8_WAIT_L(0); PG8_BAR; if (full) { PG8_MMA(1, 0, At, B0); PG8_MMA(1, 1, At, B1); } PG8_BAR; PG8_SCHED;
            PG8_STAGE(PG8_SA(0, 1), a2, v1); PG8_SCHED; PG8_LDA(At, 1, 0); PG8_SCHED; PG8_LDB(B0, 1, 0); PG8_LDB(B1, 1, 1);
            PG8_WAIT_V(8); PG8_WAIT_L(0); PG8_BAR; PG8_MMA(0, 0, At, B0); PG8_MMA(0, 1, At, B1); PG8_BAR; PG8_SCHED;
            PG8_LDA(At, 1, 1); PG8_STAGE(PG8_SB(1, 0), b3, voffB); PG8_STAGE(PG8_SB(1, 1), b3 + hstepB, voffB); PG8_STAGE(PG8_SA(1, 0), a3, v0);
            PG8_WAIT_V(8); PG8_WAIT_L(0); PG8_BAR; if (full) { PG8_MMA(1, 0, At, B0); PG8_MMA(1, 1, At, B1); } PG8_BAR; PG8_SCHED;
        }
        if constexpr (ALIGN_EPI) { if (wr == 0) PG8_BAR; }
        if constexpr (FP8) { asm volatile("s_nop 15\n\ts_nop 7"); PG8_SCHED; }
        E(acc, cur, wr, wc, fr, fq, (const LAS float*)(lds + BIAS_OFF + (ui & 1) * 1024));
        if (!has_next) break;
        PG8_ACC_INIT((ui + 1) & 1);
        cur = nxt; cA = nA; cB = nB; ++ui;
#pragma unroll
        for (int h = 0; h < 2; ++h)
#pragma unroll
            for (int i = 0; i < 2; ++i) va[h][i] = vn[h][i];
        if constexpr (ALIGN_EPI) { if (wr == 1) PG8_BAR; }
    }
    PG8_WAIT_V(0);
    if constexpr (!ALIGN_EPI) { if (wr == 0) PG8_BAR; }
    PG8_BAR;
#undef PG8_SA
#undef PG8_SB
#undef PG8_STAGE
#undef PG8_LDA
#undef PG8_LDB
#undef PG8_MMA
#undef PG8_WAIT_V
#undef PG8_WAIT_L
#undef PG8_BAR
#undef PG8_SCHED
#undef PG8_GATHER_OFFS
#undef PG8_PLAIN_OFFS
#undef PG8_BIAS_DMA
#undef PG8_ACC_INIT
}
}

struct Args { const float* in[24]; float* out; unsigned char* ws; int ph_lo, ph_hi; };
enum { I_X = 0, I_C, I_WADA, I_BADA, I_GPRE, I_WIN, I_GSGU, I_WS, I_BS, I_WGK2, I_BGK, I_GGLA, I_WOUT, I_GPOST, I_GPFFN, I_WR, I_BR, I_WG, I_BG, I_WU, I_BU, I_WDN, I_BDN, I_GPOSTF };

template <bool FP8>
__device__ __forceinline__ void transpose_item(const float* W, int ldw, int k0, int n0, void* WT, size_t dst_row0, LAS float* scr, int lane) {
    f32x4 v[8];
#pragma unroll
    for (int q = 0; q < 8; ++q) v[q] = *(const f32x4*)(W + (size_t)(k0 + 8 * q + (lane >> 3)) * ldw + n0 + 4 * (lane & 7));
#pragma unroll
    for (int q = 0; q < 8; ++q) { LAS float* d = scr + (8 * q + (lane >> 3)) * 33 + 4 * (lane & 7); d[0] = v[q][0]; d[1] = v[q][1]; d[2] = v[q][2]; d[3] = v[q][3]; }
    asm volatile("s_waitcnt lgkmcnt(0)" ::: "memory");
    const int c = lane & 7;
#pragma unroll
    for (int j = 0; j < 4; ++j) { const int n = (lane >> 3) + 8 * j; const LAS float* s = scr + (8 * c) * 33 + n;
        if constexpr (FP8) {
            const u32x2 o = (u32x2){pk4_fp8(s[0 * 33] * W8_SCALE, s[1 * 33] * W8_SCALE, s[2 * 33] * W8_SCALE, s[3 * 33] * W8_SCALE), pk4_fp8(s[4 * 33] * W8_SCALE, s[5 * 33] * W8_SCALE, s[6 * 33] * W8_SCALE, s[7 * 33] * W8_SCALE)};
            *(u32x2*)((unsigned char*)WT + (dst_row0 + n) * 1024 + k0 + 8 * c) = o;
        } else {
            u32x4 o; o.x = pk2(s[0 * 33], s[1 * 33]); o.y = pk2(s[2 * 33], s[3 * 33]); o.z = pk2(s[4 * 33], s[5 * 33]); o.w = pk2(s[6 * 33], s[7 * 33]);
            *(u32x4*)((bf16_t*)WT + (dst_row0 + n) * 1024 + k0 + 8 * c) = o; } }
    asm volatile("s_waitcnt lgkmcnt(0)" ::: "memory");
}
__device__ __forceinline__ void p0_prologue(const Args& a, LAS unsigned char* lds, int G) {
    const int tid = threadIdx.x, lane = tid & 63, wave = __builtin_amdgcn_readfirstlane(tid >> 6);
    const int gw = blockIdx.x * 8 + wave, NGW = G * 8;
    unsigned char* ws = a.ws;
    {
        float* mods = (float*)(ws + WS_MODS);
        const float* c = a.in[I_C]; const float* wa = a.in[I_WADA]; const float* ba = a.in[I_BADA];
        LAS float* sc = (LAS float*)lds;
        LAS float* part = (LAS float*)(lds + 16384);
        if ((int)blockIdx.x < 96) { for (int i = tid; i < 4096; i += 512) sc[i] = silu_(c[i]); __syncthreads(); }
        for (int it = blockIdx.x; it < 96; it += G) {
            const int r = lane >> 4, cq = lane & 15, k0 = wave * 128;
            const float* wp = wa + (size_t)(k0 + r) * 6144 + it * 64 + 4 * cq;
            f32x4 wv[32];
#pragma unroll
            for (int i = 0; i < 32; ++i) wv[i] = __builtin_nontemporal_load((const f32x4*)(wp + (size_t)(4 * i) * 6144));
            f32x4 acc[4];
#pragma unroll
            for (int b = 0; b < 4; ++b) acc[b] = (f32x4){0.f, 0.f, 0.f, 0.f};
#pragma unroll
            for (int i = 0; i < 32; ++i)
#pragma unroll
                for (int b = 0; b < 4; ++b) acc[b] += wv[i] * sc[b * 1024 + k0 + 4 * i + r];
#pragma unroll
            for (int b = 0; b < 4; ++b)
#pragma unroll
                for (int e2 = 0; e2 < 4; ++e2) { float t = acc[b][e2]; t += __shfl_xor(t, 16); t += __shfl_xor(t, 32); acc[b][e2] = t; }
            if (lane < 16) {
#pragma unroll
                for (int b = 0; b < 4; ++b) *(LAS f32x4*)(part + (wave * 4 + b) * 64 + 4 * cq) = acc[b]; }
            __syncthreads();
            if (tid < 256) { const int b = tid >> 6, cc = tid & 63; float sv = ba[it * 64 + cc];
#pragma unroll
                for (int w = 0; w < 8; ++w) sv += part[(w * 4 + b) * 64 + cc];
                mods[b * 6144 + it * 64 + cc] = sv; }
            __syncthreads();
        }
    }
    {
        const float* wr = a.in[I_WR]; bf16_t* wh = (bf16_t*)(ws + WS_WR); bf16_t* wl = wh + 32 * 1024;
        for (int idx = blockIdx.x * 512 + tid; idx < 32768; idx += G * 512) { const int k = idx >> 5, j = idx & 31; const float w = wr[idx];
            const unsigned h = f2bf(w); wh[j * 1024 + k] = (bf16_t)h; wl[j * 1024 + k] = (bf16_t)f2bf(w - bf2f(h)); }
    }
    {
        LAS float* scr = (LAS float*)(lds + wave * 16384);
        constexpr int I_IN = 16 * 80, I_OUT = 16 * 32, I_E = 16 * 32;
        constexpr int NITEMS = I_IN + I_OUT + 3 * NE * I_E;
        bf16_t* Win = (bf16_t*)(ws + WS_WIN); bf16_t* Wout = (bf16_t*)(ws + WS_WOUT);
        (void)NITEMS;
        for (int it = gw; it < I_IN + I_OUT; it += NGW) {
            int r = it;
            if (r < I_IN) { const int kb = r / 80, nb = r % 80; transpose_item<false>(a.in[I_WIN], D_IN, 64 * kb, 32 * nb, Win, (size_t)(32 * nb), scr, lane); continue; } r -= I_IN;
            { const int kb = r / 32, nb = r % 32; transpose_item<true>(a.in[I_WOUT], 1024, 64 * kb, 32 * nb, Wout, (size_t)(32 * nb), scr, lane); }
        }
    }
}

constexpr int MOE_ITEMS = 3 * NE * 256;
__device__ __forceinline__ void moe_convert(const Args& a, LAS unsigned char* lds, int G, int first, int last) {
    (void)lds;
    const int tid = threadIdx.x, lane = tid & 63, wave = __builtin_amdgcn_readfirstlane(tid >> 6);
    const int gw = blockIdx.x * 8 + wave, NGW = G * 8;
    unsigned char* Wd = a.ws + WS_WD; unsigned char* W1 = a.ws + WS_W1;
    constexpr int I_E8 = 8 * 32;
#define MC_DECODE(it_, src_, dst_) do { int r = (it_); const int mat = r / (NE * I_E8); r -= mat * (NE * I_E8); const int e = r / I_E8; r -= e * I_E8; \
        const int nb = 8 * (r >> 6) + (r & 7), kb = (r >> 3) & 7, n0 = 32 * nb, k0 = 128 * kb; \
        const float* Wm = (mat == 0 ? a.in[I_WG] : (mat == 1 ? a.in[I_WU] : a.in[I_WDN])) + (size_t)e * 1048576; \
        const size_t drow = (mat == 2) ? (size_t)e * 1024 + n0 : (size_t)e * 2048 + (size_t)(n0 >> 7) * 256 + (size_t)mat * 128 + (size_t)(n0 & 127); \
        dst_ = (mat == 2 ? Wd : W1) + (drow + 4 * (lane & 7)) * 1024 + k0 + 16 * (lane >> 3); src_ = Wm + (size_t)(k0 + 16 * (lane >> 3)) * 1024 + n0 + 4 * (lane & 7); } while (0)
#define MC_LOAD(vv, src_) do { _Pragma("unroll") for (int q = 0; q < 16; ++q) vv[q] = __builtin_nontemporal_load((const f32x4*)((src_) + (size_t)q * 1024)); } while (0)
#define MC_PROC(vv, dst_) do { u32x4 o_[4]; \
        _Pragma("unroll") for (int g4 = 0; g4 < 4; ++g4) { unsigned D_[4]; \
            _Pragma("unroll") for (int q = 0; q < 4; ++q) { const f32x4 t_ = vv[4 * g4 + q] * W8_SCALE; D_[q] = pk4_fp8(t_[0], t_[1], t_[2], t_[3]); } \
            const unsigned pa = __builtin_amdgcn_perm(D_[1], D_[0], 0x05010400u), pb = __builtin_amdgcn_perm(D_[1], D_[0], 0x07030602u); \
            const unsigned pc = __builtin_amdgcn_perm(D_[3], D_[2], 0x05010400u), pd = __builtin_amdgcn_perm(D_[3], D_[2], 0x07030602u); \
            o_[0][g4] = __builtin_amdgcn_perm(pc, pa, 0x05040100u); o_[1][g4] = __builtin_amdgcn_perm(pc, pa, 0x07060302u); \
            o_[2][g4] = __builtin_amdgcn_perm(pd, pb, 0x05040100u); o_[3][g4] = __builtin_amdgcn_perm(pd, pb, 0x07060302u); } \
        _Pragma("unroll") for (int j = 0; j < 4; ++j) __builtin_nontemporal_store(o_[j], (u32x4*)((dst_) + (size_t)j * 1024)); } while (0)
    int it = first + gw;
    if (it < last) {
        const int nmine = (last - 1 - it) / NGW;
        const int itlast = it + nmine * NGW;
        const float* sA; unsigned char* dA; const float* sB; unsigned char* dB; f32x4 v[16], w[16];
        MC_DECODE(it, sA, dA); MC_LOAD(v, sA);
        for (; it < last; it += 2 * NGW) {
            const int itb = (it + NGW <= itlast) ? it + NGW : itlast, ita = (it + 2 * NGW <= itlast) ? it + 2 * NGW : itlast;
            MC_DECODE(itb, sB, dB); MC_LOAD(w, sB);
            MC_PROC(v, dA);
            MC_DECODE(ita, sA, dA); MC_LOAD(v, sA);
            MC_PROC(w, dB);
        }
    }
#undef MC_DECODE
#undef MC_LOAD
#undef MC_PROC
}

__device__ __forceinline__ void p1_norm(const Args& a, LAS unsigned char* lds, int G) {
    const int tid = threadIdx.x, lane = tid & 63, wave = __builtin_amdgcn_readfirstlane(tid >> 6);
    const float* x = a.in[I_X]; const float* win = a.in[I_WIN]; const float* gpre = a.in[I_GPRE];
    const float* mods = (const float*)(a.ws + WS_MODS);
    bf16_t* XN = (bf16_t*)(a.ws + WS_XN); float* glow = (float*)(a.ws + WS_GLOW);
    constexpr int NP1 = 1032;
    LAS bf16_t* NT = (LAS bf16_t*)lds; LAS float* RP = (LAS float*)(lds + 16 * NP1 * 2);
    bf16x8 wg[4];
#pragma unroll
    for (int ks = 0; ks < 4; ++ks)
#pragma unroll
        for (int e = 0; e < 8; ++e) { const int k = 128 * wave + 32 * ks + 8 * (lane >> 4) + e; wg[ks][e] = (short)f2bf(win[(size_t)k * D_IN + C_GL + (lane & 15)]); }
    for (int blk = blockIdx.x; blk < T / 128; blk += G) {
        const int b = (blk * 128) / SEQ;
        f32x4 A1[4], B1[4];
#pragma unroll
        for (int j = 0; j < 4; ++j) { const int k = 4 * lane + 256 * j; const f32x4 gv = *(const f32x4*)(gpre + k), sc = *(const f32x4*)(mods + b * 6144 + 1024 + k);
            A1[j] = gv * (sc + 1.0f); B1[j] = *(const f32x4*)(mods + b * 6144 + k); }
        f32x4 nx[4][4];
#define P1_ROWOF(q_) ((size_t)(blk * 128 + 16 * ((q_) >> 1) + 2 * wave + ((q_) & 1)))
#pragma unroll
        for (int d = 0; d < 4; ++d) { const size_t row = P1_ROWOF(d);
#pragma unroll
          for (int j = 0; j < 4; ++j) nx[d][j] = __builtin_nontemporal_load((const f32x4*)(x + row * 1024 + 4 * lane + 256 * j)); }
        for (int it0 = 0; it0 < 8; it0 += 2) {
#pragma unroll
          for (int iu = 0; iu < 2; ++iu) {
            const int it = it0 + iu;
#pragma unroll
            for (int rr = 0; rr < 2; ++rr) {
                const int r16 = 2 * wave + rr, q = 2 * it + rr, sl = 2 * iu + rr; const size_t row = P1_ROWOF(q);
                const int qn = q + 4 < 16 ? q + 4 : 15; const size_t rown = P1_ROWOF(qn);
                f32x4 v[4]; float ss = 0.f;
#pragma unroll
                for (int j = 0; j < 4; ++j) { v[j] = nx[sl][j]; ss += (v[j][0] * v[j][0] + v[j][1] * v[j][1]) + (v[j][2] * v[j][2] + v[j][3] * v[j][3]); }
#pragma unroll
                for (int j = 0; j < 4; ++j) nx[sl][j] = __builtin_nontemporal_load((const f32x4*)(x + rown * 1024 + 4 * lane + 256 * j));
                const float rstd = __builtin_amdgcn_rsqf(wave_sum(ss) * (1.0f / 1024.0f) + EPS);
#pragma unroll
                for (int j = 0; j < 4; ++j) { v[j] = v[j] * rstd * A1[j] + B1[j];
                    const u32x2 w = (u32x2){pk2(v[j][0], v[j][1]), pk2(v[j][2], v[j][3])};
                    *(u32x2*)(XN + row * 1024 + 4 * lane + 256 * j) = w; *(LAS u32x2*)(NT + r16 * NP1 + 4 * lane + 256 * j) = w; }
            }
            LDS_BARRIER();
            {
                f32x4 acc = (f32x4){0.f, 0.f, 0.f, 0.f};
#pragma unroll
                for (int ks = 0; ks < 4; ++ks) { const bf16x8 av = *(const LAS bf16x8*)(NT + (lane & 15) * NP1 + 128 * wave + 32 * ks + 8 * (lane >> 4)); acc = mfma16(av, wg[ks], acc); }
#pragma unroll
                for (int r = 0; r < 4; ++r) RP[wave * 256 + (4 * (lane >> 4) + r) * 16 + (lane & 15)] = acc[r];
            }
            LDS_BARRIER();
            if (tid < 256) { float sv = 0.f;
#pragma unroll
                for (int w = 0; w < 8; ++w) sv += RP[w * 256 + tid];
                glow[((size_t)blk * 128 + 16 * it) * 16 + tid] = sv; }
          }
        }
#undef P1_ROWOF
        LDS_BARRIER();
    }
}

__device__ __forceinline__ unsigned lo_pair(unsigned a, unsigned b) { return (a & 0xffffu) | (b << 16); }
__device__ __forceinline__ unsigned hi_pair(unsigned a, unsigned b) { return (a >> 16) | (b & 0xffff0000u); }
constexpr int VP32 = 68;
__device__ __forceinline__ void p3_sgu(const Args& a, LAS unsigned char* lds, int G) {
    const int tid = threadIdx.x, lane = tid & 63, wave = __builtin_amdgcn_readfirstlane(tid >> 6);
    const bf16_t* PROJ = (const bf16_t*)(a.ws + WS_PROJ); bf16_t* MIXA = (bf16_t*)(a.ws + WS_XN);
    const int nper = G / 8;
    const int h = blockIdx.x & 7, sub = blockIdx.x >> 3;
    if (sub >= nper) return;
    const int t = 16 * wave + (lane & 15);
    bf16x8 wf[4];
#pragma unroll
    for (int ks = 0; ks < 4; ++ks) { const float* wrow = a.in[I_WS] + ((size_t)h * 128 + t) * 128 + 32 * ks + 8 * (lane >> 4);
#pragma unroll
        for (int e2 = 0; e2 < 8; ++e2) { const int s = 32 * ks + 8 * (lane >> 4) + e2; const float w = (s <= t) ? wrow[e2] : 0.f; wf[ks][e2] = (short)f2bf(w); } }
    const float bias = a.in[I_BS][h * 128 + t];
    const int token = tid >> 2, part = tid & 3, odd = token & 1;
    float gs[16];
#pragma unroll
    for (int j = 0; j < 16; ++j) gs[j] = a.in[I_GSGU][h * 64 + part * 16 + j];
    u32x4 nr0, nr1; u32x2 nu[4];
#define SGU_LOAD(idx_) do { const int tok0_ = ((idx_) >> 6) * SEQ + ((idx_) & 63) * 128; \
        const bf16_t* src_ = PROJ + PROJ_IDX(tok0_ + token, C_VS + h * 64 + part * 16); nr0 = *(const u32x4*)src_; nr1 = *(const u32x4*)(src_ + 8); \
        _Pragma("unroll") for (int dt = 0; dt < 4; ++dt) nu[dt] = *(const u32x2*)(PROJ + PROJ_IDX(tok0_ + t, C_US + h * 64 + 16 * dt + 4 * (lane >> 4))); } while (0)
    SGU_LOAD(sub);
    int buf = 0;
    u32x2 po[4]; size_t ptrow = 0; bool pend = false;
#pragma unroll
    for (int dt = 0; dt < 4; ++dt) po[dt] = (u32x2){0u, 0u};
    for (int idx = sub; idx < 256; idx += nper, buf ^= 1) {
        LAS unsigned* vhT = (LAS unsigned*)(lds + buf * (64 * VP32 * 4));
        const int tok0 = (idx >> 6) * SEQ + (idx & 63) * 128;
        const u32x4 r0 = nr0, r1 = nr1; u32x2 uu[4];
#pragma unroll
        for (int dt = 0; dt < 4; ++dt) uu[dt] = nu[dt];
        asm volatile("" :: "v"(r0), "v"(r1), "v"(uu[0]), "v"(uu[1]), "v"(uu[2]), "v"(uu[3]));
        if (pend) {
#pragma unroll
            for (int dt = 0; dt < 4; ++dt) *(unsigned*)((unsigned char*)MIXA + ptrow * 1024 + h * 64 + 16 * dt + 4 * (lane >> 4)) = po[dt][0]; }
        { const int idn = (idx + nper < 256) ? idx + nper : idx; SGU_LOAD(idn); }
        float v[16];
#pragma unroll
        for (int i = 0; i < 4; ++i) { v[2 * i] = bflo(r0[i]); v[2 * i + 1] = bfhi(r0[i]); v[8 + 2 * i] = bflo(r1[i]); v[8 + 2 * i + 1] = bfhi(r1[i]); }
        float ss = 0.f;
#pragma unroll
        for (int j = 0; j < 16; ++j) ss += v[j] * v[j];
        ss += WS_DPP(ss, 0xB1); ss += WS_DPP(ss, 0x4E);
        const float rstd = __builtin_amdgcn_rsqf(ss * (1.0f / 64.0f) + EPS);
        unsigned pw[8];
#pragma unroll
        for (int i = 0; i < 8; ++i) pw[i] = pk2(v[2 * i] * rstd * gs[2 * i], v[2 * i + 1] * rstd * gs[2 * i + 1]);
#pragma unroll
        for (int i = 0; i < 4; ++i) {
            const unsigned snd = odd ? pw[i] : pw[4 + i], own = odd ? pw[4 + i] : pw[i], rcv = (unsigned)__shfl_xor((int)snd, 4);
            const unsigned first = odd ? rcv : own, second = odd ? own : rcv;
            const int d = 16 * part + 8 * odd + 2 * i;
            vhT[d * VP32 + ((token >> 1) ^ (4 * (d >> 4)))] = lo_pair(first, second);
            vhT[(d + 1) * VP32 + ((token >> 1) ^ (4 * (d >> 4)))] = hi_pair(first, second); }
        LDS_BARRIER();
        f32x4 acc[4];
#pragma unroll
        for (int dt = 0; dt < 4; ++dt) acc[dt] = (f32x4){0.f, 0.f, 0.f, 0.f};
#pragma unroll
        for (int ks = 0; ks < 4; ++ks) if (ks <= (wave >> 1)) {
#pragma unroll
            for (int dt = 0; dt < 4; ++dt) { const bf16x8 av = *(const LAS bf16x8*)(vhT + (16 * dt + (lane & 15)) * VP32 + ((16 * ks + 4 * (lane >> 4)) ^ (4 * dt))); acc[dt] = mfma16(av, wf[ks], acc[dt]); } }
        const size_t trow = (size_t)(tok0 + t);
#pragma unroll
        for (int dt = 0; dt < 4; ++dt) { const int d = 16 * dt + 4 * (lane >> 4);
            const float o0 = bflo(uu[dt][0]) * (acc[dt][0] + bias), o1 = bfhi(uu[dt][0]) * (acc[dt][1] + bias), o2 = bflo(uu[dt][1]) * (acc[dt][2] + bias), o3 = bfhi(uu[dt][1]) * (acc[dt][3] + bias);
            po[dt] = (u32x2){pk4_fp8(clamp448(o0), clamp448(o1), clamp448(o2), clamp448(o3)), 0u}; }
        ptrow = trow; pend = true;
    }
    if (pend) {
#pragma unroll
        for (int dt = 0; dt < 4; ++dt) *(unsigned*)((unsigned char*)MIXA + ptrow * 1024 + h * 64 + 16 * dt + 4 * (lane >> 4)) = po[dt][0]; }
#undef SGU_LOAD
}

#define GLA_RUN(j_) ((int)blockIdx.x + ((j_) >> 3) * G)
#define GLA_OK(j_)  (GLA_RUN(j_) < 256)
#define GLA_BH(j_)  (GLA_RUN(j_) & 15)
#define GLA_N(j_)   (8 * (GLA_RUN(j_) >> 4) + ((j_) & 7))
#define GLA_NP(j_)  (16 * ((j_) & 7) + (GLA_RUN(j_) >> 4))
constexpr int GP32 = 36;
constexpr int GP = 72;
constexpr int GL_WG2 = 0  , GL_WT = 4096  , GL_A = 6144  , GL_B = GL_A + 9216  , GL_VT = GL_B + 9216  ,
              GL_PM = GL_VT + 18432  , GL_RS = GL_PM + 9216  , GL_QS2 = GL_RS + 512  ;
__device__ __forceinline__ void gla_decay(const LAS float* wg2, LAS float* WT, const float (&bgk)[8], const f32x4 (&gl)[4], int lane, int wave, float (&bc)[8], float (&tot)[8]) {
    const int a8 = (lane & 7) * 8;
    f32x2 xp[4];
#pragma unroll
    for (int e = 0; e < 4; ++e) xp[e] = (f32x2){bgk[2 * e], bgk[2 * e + 1]};
#pragma unroll
    for (int j = 0; j < 8; ++j) { const float x0 = gl[j >> 1][2 * (j & 1)], x1 = gl[j >> 1][2 * (j & 1) + 1];
        const f32x4 w00 = *(const LAS f32x4*)(wg2 + (2 * j) * 64 + a8), w01 = *(const LAS f32x4*)(wg2 + (2 * j) * 64 + a8 + 4);
        const f32x4 w10 = *(const LAS f32x4*)(wg2 + (2 * j + 1) * 64 + a8), w11 = *(const LAS f32x4*)(wg2 + (2 * j + 1) * 64 + a8 + 4);
        xp[0] += (f32x2){w00[0], w00[1]} * x0; xp[1] += (f32x2){w00[2], w00[3]} * x0; xp[2] += (f32x2){w01[0], w01[1]} * x0; xp[3] += (f32x2){w01[2], w01[3]} * x0;
        xp[0] += (f32x2){w10[0], w10[1]} * x1; xp[1] += (f32x2){w10[2], w10[3]} * x1; xp[2] += (f32x2){w11[0], w11[1]} * x1; xp[3] += (f32x2){w11[2], w11[3]} * x1; }
    float la[8];
#pragma unroll
    for (int e = 0; e < 8; ++e) { const float xx = xp[e >> 1][e & 1];
        la[e] = (fminf(xx, 0.f) - 0.6931471806f * __builtin_amdgcn_logf(1.0f + __builtin_amdgcn_exp2f(-1.4426950409f * fabsf(xx)))) * (1.0f / 16.0f); }
#pragma unroll
    for (int off = 8; off < 64; off <<= 1) {
#pragma unroll
        for (int e = 0; e < 8; ++e) { const float tv = __shfl_up(la[e], off); if (lane >= off) la[e] += tv; } }
    if (lane >= 56) { *(LAS f32x4*)(WT + wave * 64 + a8) = (f32x4){la[0], la[1], la[2], la[3]}; *(LAS f32x4*)(WT + wave * 64 + a8 + 4) = (f32x4){la[4], la[5], la[6], la[7]}; }
    LDS_BARRIER();
    float off8[8];
#pragma unroll
    for (int e = 0; e < 8; ++e) { off8[e] = 0.f; tot[e] = 0.f; }
#pragma unroll
    for (int w = 0; w < 8; ++w) { const f32x4 t0 = *(const LAS f32x4*)(WT + w * 64 + a8), t1 = *(const LAS f32x4*)(WT + w * 64 + a8 + 4);
#pragma unroll
        for (int e = 0; e < 4; ++e) { tot[e] += t0[e]; tot[4 + e] += t1[e]; if (w < wave) { off8[e] += t0[e]; off8[4 + e] += t1[e]; } } }
#pragma unroll
    for (int e = 0; e < 8; ++e) bc[e] = la[e] + off8[e];
}
__device__ __forceinline__ void gla_vt_write(LAS unsigned* VT, u32x4 v0, u32x4 v1, int lane, int wave) {
    const int cl = lane >> 3, a = lane & 7, odd = cl & 1, dcol = 4 * wave + (cl >> 1);
#pragma unroll
    for (int i = 0; i < 4; ++i) {
        const unsigned snd = odd ? v0[i] : v1[i], own = odd ? v1[i] : v0[i], rcv = (unsigned)__shfl_xor((int)snd, 8);
        const unsigned first = odd ? rcv : own, second = odd ? own : rcv;
        const int v = 16 * a + 8 * odd + 2 * i;
        VT[v * GP32 + (dcol ^ (4 * a))] = lo_pair(first, second);
        VT[(v + 1) * GP32 + (dcol ^ (4 * a))] = hi_pair(first, second); }
}
typedef short s16x4 __attribute__((ext_vector_type(4)));
__device__ __forceinline__ int vr_off(int row, int ch) { return 256 * row + 16 * (ch ^ (((row & 3) << 2) | ((row >> 2) & 3))); }
__device__ __forceinline__ void gla_vr_write(LAS unsigned char* VR, u32x4 v0, u32x4 v1, int tid) {
    const int c = tid >> 3, a = tid & 7; *(LAS u32x4*)(VR + vr_off(c, 2 * a)) = v0; *(LAS u32x4*)(VR + vr_off(c, 2 * a + 1)) = v1; }
__device__ __forceinline__ bf16x8 gla_vr_frag(const LAS unsigned char* VR, int vtile, int k0, int lane) {
    const int fr = lane & 15, fq = lane >> 4, q = fr >> 2, p = fr & 3, rA = k0 + 8 * fq + q, ch = 2 * vtile + (p >> 1);
    const s16x4 lo = __builtin_amdgcn_ds_read_tr16_b64_v4i16((LAS s16x4*)(VR + vr_off(rA, ch) + 8 * (p & 1)));
    const s16x4 hi = __builtin_amdgcn_ds_read_tr16_b64_v4i16((LAS s16x4*)(VR + vr_off(rA + 4, ch) + 8 * (p & 1)));
    return __builtin_shufflevector(lo, hi, 0, 1, 2, 3, 4, 5, 6, 7); }

__device__ __forceinline__ void p3_gla_state(const Args& a, LAS unsigned char* lds, int G) {
    const int tid = threadIdx.x, lane = tid & 63, wave = __builtin_amdgcn_readfirstlane(tid >> 6);
    const bf16_t* PROJ = (const bf16_t*)(a.ws + WS_PROJ); const float* glow = (const float*)(a.ws + WS_GLOW); float* BCUM = (float*)(a.ws + WS_BCUM);
    bf16_t* PREVL = (bf16_t*)(a.ws + WS_PREV); float* CD = (float*)(a.ws + WS_DEC); bf16_t* SRUN = (bf16_t*)(a.ws + WS_ST); float* LRD = (float*)(a.ws + WS_TOKE);
    LAS float* wg2 = (LAS float*)(lds + GL_WG2); LAS float* WT = (LAS float*)(lds + GL_WT); LAS float* DL = (LAS float*)(lds + GL_RS);
    f32x4 srun[4]; float lcd[8];
    LAS unsigned* KDT = (LAS unsigned*)(lds + GL_A); LAS unsigned* VT = (LAS unsigned*)(lds + GL_VT);
    const int c = tid >> 3, a8 = (tid & 7) * 8, v16 = (tid & 7) * 16, cl = lane >> 3, odd = cl & 1;
    int cur_h = -1; float bgk[8];
    f32x4 ngl[4]; u32x4 nkr, nv0, nv1;
#define ST_LOAD(idx_) do { const int bh_ = GLA_BH(idx_), n_ = GLA_N(idx_), tok0_ = (bh_ >> 2) * SEQ + n_ * 64, tp0_ = (bh_ >> 2) * SEQ + GLA_NP(idx_) * 64, h_ = bh_ & 3; \
        _Pragma("unroll") for (int q_ = 0; q_ < 4; ++q_) ngl[q_] = *(const f32x4*)(glow + (size_t)(tok0_ + c) * 16 + 4 * q_); nkr = *(const u32x4*)(PROJ + PROJ_IDX(tp0_ + c, C_K + h_ * 64 + a8)); \
        const bf16_t* vs_ = PROJ + PROJ_IDX(tp0_ + c, C_V + h_ * 128 + v16); nv0 = *(const u32x4*)vs_; nv1 = *(const u32x4*)(vs_ + 8); } while (0)
    if (GLA_OK(0)) ST_LOAD(0);
    for (int idx = 0; GLA_OK(idx); ++idx) {
        const int bh = GLA_BH(idx), h = bh & 3, su = bh * 128 + GLA_NP(idx);
        if (h != cur_h) {
            LDS_BARRIER();
            for (int i = tid; i < 1024; i += 512) wg2[i] = a.in[I_WGK2][(i >> 6) * 256 + h * 64 + (i & 63)];
#pragma unroll
            for (int e = 0; e < 8; ++e) bgk[e] = a.in[I_BGK][h * 64 + a8 + e];
            cur_h = h; LDS_BARRIER(); }
        const f32x4 gl[4] = {ngl[0], ngl[1], ngl[2], ngl[3]}; const u32x4 kr = nkr, v0 = nv0, v1 = nv1;
        { const int idn = GLA_OK(idx + 1) ? idx + 1 : idx; ST_LOAD(idn); }
        if ((idx & 7) == 0) {
#pragma unroll
            for (int dt = 0; dt < 4; ++dt) srun[dt] = (f32x4){0.f, 0.f, 0.f, 0.f};
#pragma unroll
            for (int e = 0; e < 8; ++e) lcd[e] = 0.f; }
        float bc[8], tot[8];
        gla_decay(wg2, WT, bgk, gl, lane, wave, bc, tot);
        { float* bp = BCUM + ((size_t)h * T + (size_t)((bh >> 2) * SEQ + GLA_NP(idx) * 64 + c)) * 64 + a8; *(f32x4*)bp = (f32x4){bc[0], bc[1], bc[2], bc[3]}; *(f32x4*)(bp + 4) = (f32x4){bc[4], bc[5], bc[6], bc[7]}; }
        {
            unsigned pw[4];
#pragma unroll
            for (int i = 0; i < 4; ++i) pw[i] = pk2(bflo(kr[i]) * __expf(tot[2 * i] - bc[2 * i]), bfhi(kr[i]) * __expf(tot[2 * i + 1] - bc[2 * i + 1]));
            const int dcol = 4 * wave + (cl >> 1);
#pragma unroll
            for (int i = 0; i < 2; ++i) {
                const unsigned snd = odd ? pw[i] : pw[2 + i], own = odd ? pw[2 + i] : pw[i], rcv = (unsigned)__shfl_xor((int)snd, 8);
                const unsigned first = odd ? rcv : own, second = odd ? own : rcv;
                const int d = a8 + 4 * odd + 2 * i;
                KDT[d * GP32 + (dcol ^ (4 * (d >> 4)))] = lo_pair(first, second);
                KDT[(d + 1) * GP32 + (dcol ^ (4 * (d >> 4)))] = hi_pair(first, second); }
            gla_vr_write(lds + GL_VT, v0, v1, tid);
            if (tid < 8) { float* dp = CD + (size_t)su * 64 + a8; *(f32x4*)dp = (f32x4){__expf(lcd[0]), __expf(lcd[1]), __expf(lcd[2]), __expf(lcd[3])}; *(f32x4*)(dp + 4) = (f32x4){__expf(lcd[4]), __expf(lcd[5]), __expf(lcd[6]), __expf(lcd[7])};
                *(LAS f32x4*)(DL + a8) = (f32x4){__expf(tot[0]), __expf(tot[1]), __expf(tot[2]), __expf(tot[3])}; *(LAS f32x4*)(DL + a8 + 4) = (f32x4){__expf(tot[4]), __expf(tot[5]), __expf(tot[6]), __expf(tot[7])}; }
        }
        LDS_BARRIER();
        {
            f32x4 acc[4];
#pragma unroll
            for (int dt = 0; dt < 4; ++dt) acc[dt] = (f32x4){0.f, 0.f, 0.f, 0.f};
#pragma unroll
            for (int ks = 0; ks < 2; ++ks) { const int dc = 16 * ks + 4 * (lane >> 4);
                const bf16x8 bv = gla_vr_frag(lds + GL_VT, wave, 32 * ks, lane);
#pragma unroll
                for (int dt = 0; dt < 4; ++dt) { const bf16x8 av = *(const LAS bf16x8*)(KDT + (16 * dt + (lane & 15)) * GP32 + (dc ^ (4 * dt))); acc[dt] = mfma16(av, bv, acc[dt]); } }
            bf16_t* dst = PREVL + ((size_t)su * 128 + 16 * wave + (lane & 15)) * 64 + 4 * (lane >> 4);
#pragma unroll
            for (int dt = 0; dt < 4; ++dt) { *(u32x2*)(dst + 16 * dt) = (u32x2){pk2(srun[dt][0], srun[dt][1]), pk2(srun[dt][2], srun[dt][3])};
                const f32x4 dl = *(const LAS f32x4*)(DL + 16 * dt + 4 * (lane >> 4)); srun[dt] = dl * srun[dt] + acc[dt]; }
#pragma unroll
            for (int e = 0; e < 8; ++e) lcd[e] += tot[e];
            if ((idx & 7) == 7) {
                const int run = GLA_RUN(idx);
                bf16_t* sd = SRUN + ((size_t)run * 128 + 16 * wave + (lane & 15)) * 64 + 4 * (lane >> 4);
#pragma unroll
                for (int dt = 0; dt < 4; ++dt) *(u32x2*)(sd + 16 * dt) = (u32x2){pk2(srun[dt][0], srun[dt][1]), pk2(srun[dt][2], srun[dt][3])};
                if (tid < 8) { float* lp = LRD + (size_t)run * 64 + a8; *(f32x4*)lp = (f32x4){lcd[0], lcd[1], lcd[2], lcd[3]}; *(f32x4*)(lp + 4) = (f32x4){lcd[4], lcd[5], lcd[6], lcd[7]}; } }
        }
    }
#undef ST_LOAD
}

__device__ __forceinline__ void p4_scan(const Args& a, int G) {
    const bf16_t* ST = (const bf16_t*)(a.ws + WS_ST); const float* DEC = (const float*)(a.ws + WS_DEC); bf16_t* PREV = (bf16_t*)(a.ws + WS_PREV);
    for (int gid = blockIdx.x * 512 + threadIdx.x; gid < 131072; gid += G * 512) {
        const int bh = gid >> 13, rem = gid & 8191;
        float s0 = 0.f;
        for (int n0 = 0; n0 < 128; n0 += 16) {
            float st[16], dc[16];
#pragma unroll
            for (int j = 0; j < 16; ++j) { const size_t su = (size_t)bh * 128 + n0 + j; st[j] = bf2f(ST[su * 8192 + rem]); dc[j] = DEC[su * 64 + (rem & 63)]; }
#pragma unroll
            for (int j = 0; j < 16; ++j) { const size_t su = (size_t)bh * 128 + n0 + j; PREV[su * 8192 + rem] = (bf16_t)f2bf(s0); s0 = dc[j] * s0 + st[j]; }
        }
    }
}

__device__ __forceinline__ void p5_gla_out(const Args& a, LAS unsigned char* lds, int G) {
    const int tid = threadIdx.x, lane = tid & 63, wave = __builtin_amdgcn_readfirstlane(tid >> 6);
    const bf16_t* PROJ = (const bf16_t*)(a.ws + WS_PROJ); const bf16_t* PREV = (const bf16_t*)(a.ws + WS_PREV); bf16_t* MIXA = (bf16_t*)(a.ws + WS_XN); const float* glow = (const float*)(a.ws + WS_GLOW);
    const float* BCUM = (const float*)(a.ws + WS_BCUM); const float* CD = (const float*)(a.ws + WS_DEC); const bf16_t* SRUN = (const bf16_t*)(a.ws + WS_ST); const float* LRD = (const float*)(a.ws + WS_TOKE);
    LAS bf16_t* QS2 = (LAS bf16_t*)(lds + GL_QS2); LAS float* WL = (LAS float*)(lds + GL_WG2); LAS bf16_t* RELDS = (LAS bf16_t*)(lds + GL_VT);
    LAS bf16_t* QS = (LAS bf16_t*)(lds + GL_A); LAS bf16_t* KS = (LAS bf16_t*)(lds + GL_B); LAS unsigned* VT = (LAS unsigned*)(lds + GL_VT); LAS bf16_t* PM = (LAS bf16_t*)(lds + GL_PM);
    LAS float* RS = (LAS float*)(lds + GL_RS);
    const int c = tid >> 3, a8 = (tid & 7) * 8, v16 = (tid & 7) * 16;
    const int it = wave >> 1, vh = wave & 1;
    f32x4 nb0, nb1, ncd0, ncd1; u32x4 nqr, nkr, nv0, nv1;
#define GO_LOAD(idx_) do { const int bh_ = GLA_BH(idx_), n_ = GLA_NP(idx_), tok0_ = (bh_ >> 2) * SEQ + n_ * 64, h_ = bh_ & 3; \
        { const float* bp_ = BCUM + ((size_t)h_ * T + (size_t)(tok0_ + c)) * 64 + a8; nb0 = *(const f32x4*)bp_; nb1 = *(const f32x4*)(bp_ + 4); } \
        { const float* cp_ = CD + (size_t)(bh_ * 128 + n_) * 64 + a8; ncd0 = *(const f32x4*)cp_; ncd1 = *(const f32x4*)(cp_ + 4); } \
        nqr = *(const u32x4*)(PROJ + PROJ_IDX(tok0_ + c, C_Q + h_ * 64 + a8)); nkr = *(const u32x4*)(PROJ + PROJ_IDX(tok0_ + c, C_K + h_ * 64 + a8)); \
        const bf16_t* vs_ = PROJ + PROJ_IDX(tok0_ + c, C_V + h_ * 128 + v16); nv0 = *(const u32x4*)vs_; nv1 = *(const u32x4*)(vs_ + 8); } while (0)
#define GO_LOAD2(idx_) do { const int bh_ = GLA_BH(idx_), n_ = GLA_NP(idx_), tok0_ = (bh_ >> 2) * SEQ + n_ * 64, h_ = bh_ & 3, su_ = bh_ * 128 + n_; \
        _Pragma("unroll") for (int vt = 0; vt < 4; ++vt) { const int vrow_ = 16 * (4 * vh + vt) + (lane & 15); \
            _Pragma("unroll") for (int ks = 0; ks < 2; ++ks) npv[vt][ks] = *(const bf16x8*)(PREV + ((size_t)su_ * 128 + vrow_) * 64 + 32 * ks + 8 * (lane >> 4)); \
            nrr[vt] = *(const u32x2*)(PROJ + PROJ_IDX(tok0_ + 16 * it + (lane & 15), C_R + h_ * 128 + 16 * (4 * vh + vt) + 4 * (lane >> 4))); } } while (0)
    bf16x8 npv[4][2]; u32x2 nrr[4];
    f32x4 ggv[4];
#pragma unroll
    for (int vt = 0; vt < 4; ++vt) ggv[vt] = *(const f32x4*)(a.in[I_GGLA] + 16 * (4 * vh + vt) + 4 * (lane >> 4));
    bf16x8 re[4][2];
    for (int jr = 0; GLA_OK(8 * jr); ++jr) {
      {
        const int idx = 8 * jr, bh = GLA_BH(idx);
        {
            const int run = GLA_RUN(idx), r = run >> 4;
#pragma unroll
            for (int vt = 0; vt < 4; ++vt) { re[vt][0] = (bf16x8){0, 0, 0, 0, 0, 0, 0, 0}; re[vt][1] = (bf16x8){0, 0, 0, 0, 0, 0, 0, 0}; }
            if (r > 0) {
                LDS_BARRIER();
                if (tid < 64) { float l[16];
#pragma unroll
                    for (int rp = 0; rp < 16; ++rp) l[rp] = LRD[(size_t)((rp < r ? rp : r - 1) * 16 + bh) * 64 + tid];
                    asm volatile("" :: "v"(l[0]), "v"(l[1]), "v"(l[2]), "v"(l[3]), "v"(l[4]), "v"(l[5]), "v"(l[6]), "v"(l[7]), "v"(l[8]), "v"(l[9]), "v"(l[10]), "v"(l[11]), "v"(l[12]), "v"(l[13]), "v"(l[14]), "v"(l[15]));
#pragma unroll
                    for (int rp = 0; rp < 16; ++rp) l[rp] = (rp < r) ? l[rp] : 0.f;
                    float sum = 0.f;
#pragma unroll
                    for (int rp = 15; rp >= 0; --rp) { WL[rp * 64 + tid] = (rp < r) ? __expf(sum) : 0.f; sum += l[rp]; } }
                LDS_BARRIER();
                const int v = tid >> 2, d0 = (tid & 3) * 16;
                float ref[16];
#pragma unroll
                for (int i = 0; i < 16; ++i) ref[i] = 0.f;
#pragma nounroll
                for (int pass = 0; pass * 4 < r; ++pass) {
                    u32x4 sl[4][2];
#pragma unroll
                    for (int q = 0; q < 4; ++q) { const int rp = pass * 4 + q, rc = rp < r ? rp : r - 1; const bf16_t* sp = SRUN + ((size_t)(rc * 16 + bh) * 128 + v) * 64 + d0;
                        sl[q][0] = *(const u32x4*)sp; sl[q][1] = *(const u32x4*)(sp + 8); }
#pragma unroll
                    for (int q = 0; q < 4; ++q) { const LAS float* wp = WL + (pass * 4 + q) * 64 + d0;
#pragma unroll
                        for (int g = 0; g < 4; ++g) { const f32x4 w = *(const LAS f32x4*)(wp + 4 * g); const unsigned s0 = sl[q][g >> 1][2 * (g & 1)], s1 = sl[q][g >> 1][2 * (g & 1) + 1];
                            ref[4 * g] += w[0] * bflo(s0); ref[4 * g + 1] += w[1] * bfhi(s0); ref[4 * g + 2] += w[2] * bflo(s1); ref[4 * g + 3] += w[3] * bfhi(s1); } } }
                { u32x4 o0, o1;
#pragma unroll
                  for (int i = 0; i < 4; ++i) { o0[i] = pk2(ref[2 * i], ref[2 * i + 1]); o1[i] = pk2(ref[8 + 2 * i], ref[8 + 2 * i + 1]); }
                  *(LAS u32x4*)(RELDS + v * GP + d0) = o0; *(LAS u32x4*)(RELDS + v * GP + d0 + 8) = o1; }
                LDS_BARRIER();
#pragma unroll
                for (int vt = 0; vt < 4; ++vt)
#pragma unroll
                    for (int ks = 0; ks < 2; ++ks) re[vt][ks] = *(const LAS bf16x8*)(RELDS + (16 * (4 * vh + vt) + (lane & 15)) * GP + 32 * ks + 8 * (lane >> 4));
                LDS_BARRIER();
            }
        }
        __builtin_amdgcn_sched_barrier(0);
        GO_LOAD(idx); GO_LOAD2(idx);
      }
      for (int k = 0; k < 8; ++k) {
        const int idx = 8 * jr + k;
        const int bh = GLA_BH(idx), n = GLA_N(idx), b = bh >> 2, h = bh & 3, tok0 = b * SEQ + n * 64;
        const f32x4 b0 = nb0, b1 = nb1, cd0 = ncd0, cd1 = ncd1; const u32x4 qr = nqr, kr = nkr, v0 = nv0, v1 = nv1; bf16x8 pv[4][2]; u32x2 rr[4];
#pragma unroll
        for (int vt = 0; vt < 4; ++vt) { pv[vt][0] = npv[vt][0]; pv[vt][1] = npv[vt][1]; rr[vt] = nrr[vt]; }
        { const int idn = (k < 7) ? idx + 1 : idx; GO_LOAD(idn); GO_LOAD2(idn); }
        const float bc[8] = {b0[0], b0[1], b0[2], b0[3], b1[0], b1[1], b1[2], b1[3]};
        const float cdv[8] = {cd0[0], cd0[1], cd0[2], cd0[3], cd1[0], cd1[1], cd1[2], cd1[3]};
        {
            u32x4 qo, ko, qo2;
#pragma unroll
            for (int i = 0; i < 4; ++i) { const float e0 = __expf(bc[2 * i]), e1 = __expf(bc[2 * i + 1]); const float q0 = bflo(qr[i]) * e0, q1 = bfhi(qr[i]) * e1;
                qo[i] = pk2(q0, q1); qo2[i] = pk2(q0 * cdv[2 * i], q1 * cdv[2 * i + 1]); ko[i] = pk2(bflo(kr[i]) * __builtin_amdgcn_rcpf(e0), bfhi(kr[i]) * __builtin_amdgcn_rcpf(e1)); }
            *(LAS u32x4*)(QS + c * GP + a8) = qo; *(LAS u32x4*)(KS + c * GP + a8) = ko; *(LAS u32x4*)(QS2 + c * GP + a8) = qo2;
            gla_vr_write(lds + GL_VT, v0, v1, tid);
        }
        LDS_BARRIER();
        {
#pragma unroll
            for (int q = 0; q < 2; ++q) { const int jt = 2 * (wave & 1) + q; f32x4 s = (f32x4){0.f, 0.f, 0.f, 0.f};
                if (jt <= it) {
#pragma unroll
                    for (int ks = 0; ks < 2; ++ks) { const bf16x8 av = *(const LAS bf16x8*)(KS + (16 * jt + (lane & 15)) * GP + 32 * ks + 8 * (lane >> 4));
                        const bf16x8 bv = *(const LAS bf16x8*)(QS + (16 * it + (lane & 15)) * GP + 32 * ks + 8 * (lane >> 4)); s = mfma16(av, bv, s); } }
                const int i = 16 * it + (lane & 15), j0 = 16 * jt + 4 * (lane >> 4);
                const float p0 = (j0 <= i) ? s[0] : 0.f, p1 = (j0 + 1 <= i) ? s[1] : 0.f, p2 = (j0 + 2 <= i) ? s[2] : 0.f, p3 = (j0 + 3 <= i) ? s[3] : 0.f;
                *(LAS u32x2*)(PM + i * GP + j0) = (u32x2){pk2(p0, p1), pk2(p2, p3)}; }
        }
        LDS_BARRIER();
        f32x4 acc[4];
#pragma unroll
        for (int vt = 0; vt < 4; ++vt) { acc[vt] = (f32x4){0.f, 0.f, 0.f, 0.f}; const int vrow = 16 * (4 * vh + vt) + (lane & 15), vsw = 4 * (4 * vh + vt);
#pragma unroll
            for (int ks = 0; ks < 2; ++ks) { const bf16x8 av = gla_vr_frag(lds + GL_VT, 4 * vh + vt, 32 * ks, lane);
                const bf16x8 bv = *(const LAS bf16x8*)(PM + (16 * it + (lane & 15)) * GP + 32 * ks + 8 * (lane >> 4)); acc[vt] = mfma16(av, bv, acc[vt]); }
#pragma unroll
            for (int ks = 0; ks < 2; ++ks) { const bf16x8 bv = *(const LAS bf16x8*)(QS + (16 * it + (lane & 15)) * GP + 32 * ks + 8 * (lane >> 4)); acc[vt] = mfma16(pv[vt][ks], bv, acc[vt]);
                const bf16x8 bv2 = *(const LAS bf16x8*)(QS2 + (16 * it + (lane & 15)) * GP + 32 * ks + 8 * (lane >> 4)); acc[vt] = mfma16(re[vt][ks], bv2, acc[vt]); } }
        float ss = 0.f;
#pragma unroll
        for (int vt = 0; vt < 4; ++vt) ss += (acc[vt][0] * acc[vt][0] + acc[vt][1] * acc[vt][1]) + (acc[vt][2] * acc[vt][2] + acc[vt][3] * acc[vt][3]);
        ss += __shfl_xor(ss, 16); ss += __shfl_xor(ss, 32);
        if (lane < 16) RS[wave * 16 + lane] = ss;
        LDS_BARRIER();
        const float tsum = RS[wave * 16 + (lane & 15)] + RS[(wave ^ 1) * 16 + (lane & 15)];
        const float rstd = __builtin_amdgcn_rsqf(tsum * (1.0f / 128.0f) + EPS);
        const size_t trow = (size_t)(tok0 + 16 * it + (lane & 15));
#pragma unroll
        for (int vt = 0; vt < 4; ++vt) { const int v = 16 * (4 * vh + vt) + 4 * (lane >> 4);
            const f32x4 gg = ggv[vt];
            const float o0 = acc[vt][0] * rstd * gg[0] * bflo(rr[vt][0]), o1 = acc[vt][1] * rstd * gg[1] * bfhi(rr[vt][0]), o2 = acc[vt][2] * rstd * gg[2] * bflo(rr[vt][1]), o3 = acc[vt][3] * rstd * gg[3] * bfhi(rr[vt][1]);
            *(unsigned*)((unsigned char*)MIXA + trow * 1024 + 512 + h * 128 + v) = pk4_fp8(clamp448(o0), clamp448(o1), clamp448(o2), clamp448(o3)); }
      }
    }
#undef GO_LOAD
#undef GO_LOAD2
}

constexpr int NP = 1032;
constexpr int P7_NH = 0, P7_NL = 16 * NP * 2, P7_RP = 2 * 16 * NP * 2, P7_ENT = P7_RP + 16384, P7_CNT = P7_ENT + 3 * 2048, P7_BASE = P7_CNT + 128, P7_LG = P7_BASE + 128  ;
__device__ __forceinline__ void p7_router(const Args& a, LAS unsigned char* lds, int G) {
    const int tid = threadIdx.x, lane = tid & 63, wave = __builtin_amdgcn_readfirstlane(tid >> 6);
    const float* x = a.in[I_X]; const float* mods = (const float*)(a.ws + WS_MODS);
    const bf16_t* MIX = (const bf16_t*)(a.ws + WS_MIX); unsigned char* XN2 = a.ws + WS_XN; bf16_t* H1 = (bf16_t*)(a.ws + WS_H1);
    const bf16_t* WH = (const bf16_t*)(a.ws + WS_WR); const bf16_t* WL = WH + 32 * 1024;
    LAS bf16_t* NH = (LAS bf16_t*)(lds + P7_NH); LAS bf16_t* NL = (LAS bf16_t*)(lds + P7_NL); LAS float* RP = (LAS float*)(lds + P7_RP);
    LAS int* ENT_E = (LAS int*)(lds + P7_ENT); LAS int* ENT_POS = ENT_E + 512; LAS float* ENT_P = (LAS float*)(ENT_POS + 512);
    LAS int* CNTL = (LAS int*)(lds + P7_CNT); LAS int* BASEL = (LAS int*)(lds + P7_BASE); LAS float* LG = (LAS float*)(lds + P7_LG);
    unsigned* gcnt = (unsigned*)(a.ws + WS_CTL) + CW_CNT;
    int* tok_e = (int*)(a.ws + WS_TOKE); int* tok_pos = (int*)(a.ws + WS_TOKPOS); float* tok_p = (float*)(a.ws + WS_TOKP); int* slot_tok = (int*)(a.ws + WS_SLOT);
    bf16x8 whi[4][2], wlo[4][2];
#pragma unroll
    for (int ks = 0; ks < 4; ++ks)
#pragma unroll
        for (int nt = 0; nt < 2; ++nt) { const size_t o = (size_t)(16 * nt + (lane & 15)) * 1024 + 128 * wave + 32 * ks + 8 * (lane >> 4);
            whi[ks][nt] = *(const bf16x8*)(WH + o); wlo[ks][nt] = *(const bf16x8*)(WL + o); }
    const float br = a.in[I_BR][tid & 31];
    for (int blk = blockIdx.x; blk < T / 128; blk += G) {
        const int b = (blk * 128) / SEQ;
        if (tid < 32) CNTL[tid] = 0;
        f32x4 G1[4], A2[4], B2[4];
#pragma unroll
        for (int j = 0; j < 4; ++j) { const int k = 4 * lane + 256 * j;
            G1[j] = *(const f32x4*)(mods + b * 6144 + 2048 + k) * *(const f32x4*)(a.in[I_GPOST] + k);
            A2[j] = *(const f32x4*)(a.in[I_GPFFN] + k) * (*(const f32x4*)(mods + b * 6144 + 4096 + k) + 1.0f);
            B2[j] = *(const f32x4*)(mods + b * 6144 + 3072 + k); }
        LDS_BARRIER();
        u32x2 pm_[4]; f32x4 px_[4];
        { const size_t row = (size_t)(blk * 128 + 2 * wave);
#pragma unroll
          for (int j = 0; j < 4; ++j) { pm_[j] = *(const u32x2*)(MIX + row * 1024 + 4 * lane + 256 * j); px_[j] = __builtin_nontemporal_load((const f32x4*)(x + row * 1024 + 4 * lane + 256 * j)); } }
        for (int it = 0; it < 8; ++it) {
            const int r0 = blk * 128 + 16 * it;
#pragma unroll 1
            for (int rr = 0; rr < 2; ++rr) {
                const int r16 = 2 * wave + rr; const size_t row = (size_t)(r0 + r16);
                const int sn = 2 * it + rr + 1, snc = sn < 16 ? sn : 15; const size_t rown = (size_t)(blk * 128 + 16 * (snc >> 1) + 2 * wave + (snc & 1));
                f32x4 mv[4], hv[4]; float ss = 0.f;
#pragma unroll
                for (int j = 0; j < 4; ++j) { const u32x2 mm = pm_[j]; mv[j] = (f32x4){bflo(mm[0]), bfhi(mm[0]), bflo(mm[1]), bfhi(mm[1])};
                    hv[j] = px_[j]; ss += (mv[j][0] * mv[j][0] + mv[j][1] * mv[j][1]) + (mv[j][2] * mv[j][2] + mv[j][3] * mv[j][3]); }
#pragma unroll
                for (int j = 0; j < 4; ++j) { pm_[j] = *(const u32x2*)(MIX + rown * 1024 + 4 * lane + 256 * j); px_[j] = __builtin_nontemporal_load((const f32x4*)(x + rown * 1024 + 4 * lane + 256 * j)); }
                const float rstd1 = __builtin_amdgcn_rsqf(wave_sum(ss) * (1.0f / 1024.0f) + EPS);
                float ss2 = 0.f;
#pragma unroll
                for (int j = 0; j < 4; ++j) { hv[j] = hv[j] + G1[j] * mv[j] * rstd1; __builtin_nontemporal_store((u32x2){pk2(hv[j][0], hv[j][1]), pk2(hv[j][2], hv[j][3])}, (u32x2*)(H1 + row * 1024 + 4 * lane + 256 * j));
                    ss2 += (hv[j][0] * hv[j][0] + hv[j][1] * hv[j][1]) + (hv[j][2] * hv[j][2] + hv[j][3] * hv[j][3]); }
                const float rstd2 = __builtin_amdgcn_rsqf(wave_sum(ss2) * (1.0f / 1024.0f) + EPS);
#pragma unroll
                for (int j = 0; j < 4; ++j) { const f32x4 nv = hv[j] * rstd2 * A2[j] + B2[j];
                    const u32x2 hw = (u32x2){pk2(nv[0], nv[1]), pk2(nv[2], nv[3])};
                    const u32x2 lw = (u32x2){pk2(nv[0] - bflo(hw[0]), nv[1] - bfhi(hw[0])), pk2(nv[2] - bflo(hw[1]), nv[3] - bfhi(hw[1]))};
                    *(unsigned*)(XN2 + row * 1024 + 4 * lane + 256 * j) = pk4_fp8(nv[0], nv[1], nv[2], nv[3]);
                    *(LAS u32x2*)(NH + r16 * NP + 4 * lane + 256 * j) = hw; *(LAS u32x2*)(NL + r16 * NP + 4 * lane + 256 * j) = lw; }
            }
            LDS_BARRIER();
            {
                f32x4 acc[2] = {(f32x4){0.f, 0.f, 0.f, 0.f}, (f32x4){0.f, 0.f, 0.f, 0.f}};
#pragma unroll
                for (int ks = 0; ks < 4; ++ks) { const int o = (lane & 15) * NP + 128 * wave + 32 * ks + 8 * (lane >> 4);
                    const bf16x8 ah = *(const LAS bf16x8*)(NH + o), al = *(const LAS bf16x8*)(NL + o);
#pragma unroll
                    for (int nt = 0; nt < 2; ++nt) { acc[nt] = mfma16(ah, whi[ks][nt], acc[nt]); acc[nt] = mfma16(al, whi[ks][nt], acc[nt]); acc[nt] = mfma16(ah, wlo[ks][nt], acc[nt]); } }
#pragma unroll
                for (int nt = 0; nt < 2; ++nt)
#pragma unroll
                    for (int r = 0; r < 4; ++r) RP[wave * 512 + (4 * (lane >> 4) + r) * 32 + 16 * nt + (lane & 15)] = acc[nt][r];
            }
            LDS_BARRIER();
            {
                const int r16 = tid >> 5, e = tid & 31;
                float lg = br;
#pragma unroll
                for (int w = 0; w < 8; ++w) lg += RP[w * 512 + r16 * 32 + e];
                LG[(16 * it + r16) * 33 + e] = lg;
            }
        }
        LDS_BARRIER();
        if (tid < 128) {
            float lg[32];
#pragma unroll
            for (int e = 0; e < 32; ++e) lg[e] = LG[tid * 33 + e];
            float tv[4]; int ti[4];
#pragma unroll
            for (int k = 0; k < 4; ++k) { float bv = -INFINITY; int bi = 0;
#pragma unroll
                for (int e = 0; e < 32; ++e) { bool ok = lg[e] > bv;
#pragma unroll
                    for (int q = 0; q < k; ++q) ok = ok && (e != ti[q]);
                    bv = ok ? lg[e] : bv; bi = ok ? e : bi; }
                tv[k] = bv; ti[k] = bi; }
            const float e1 = __expf(tv[1] - tv[0]), e2 = __expf(tv[2] - tv[0]), e3 = __expf(tv[3] - tv[0]);
            const float inv = 1.0f / (1.0f + e1 + e2 + e3);
            const float pr[4] = {inv, e1 * inv, e2 * inv, e3 * inv};
#pragma unroll
            for (int k = 0; k < 4; ++k) { const int pos = __hip_atomic_fetch_add(CNTL + ti[k], 1, __ATOMIC_RELAXED, __HIP_MEMORY_SCOPE_WORKGROUP); ENT_E[tid * 4 + k] = ti[k]; ENT_POS[tid * 4 + k] = pos; ENT_P[tid * 4 + k] = pr[k]; }
        }
        LDS_BARRIER();
        if (tid < 32) BASEL[tid] = (int)atomicAdd(gcnt + tid, (unsigned)CNTL[tid]);
        LDS_BARRIER();
        { const int e = ENT_E[tid], pos = BASEL[e] + ENT_POS[tid], token = blk * 128 + (tid >> 2);
            tok_e[(size_t)token * 4 + (tid & 3)] = e; tok_pos[(size_t)token * 4 + (tid & 3)] = pos; tok_p[(size_t)token * 4 + (tid & 3)] = ENT_P[tid];
            slot_tok[(size_t)e * T + pos] = token; }
        LDS_BARRIER();
    }
}

__device__ __forceinline__ int moe_tables(const Args& a, LAS unsigned char* lds) {
    LAS int* tp = (LAS int*)(lds + TP_OFF); LAS int* cn = tp + 40; LAS unsigned char* te = (LAS unsigned char*)(lds + TE_OFF);
    const unsigned* gcnt = (const unsigned*)(a.ws + WS_CTL) + CW_CNT;
    if (threadIdx.x == 0) { int s = 0; for (int e = 0; e < NE; ++e) { const int c = (int)gcnt[e]; tp[e] = s; cn[e] = c; s += (c + 255) >> 8; } tp[NE] = s; }
    __syncthreads();
    const int nM = tp[NE];
    for (int e = threadIdx.x >> 4; e < NE; e += 32) for (int p = tp[e] + (threadIdx.x & 15); p < tp[e + 1]; p += 16) te[p] = (unsigned char)e;
    __syncthreads();
    return nM;
}

__device__ __forceinline__ void p10_final(const Args& a, LAS unsigned char* lds, int G, bool have_tables) {
    const int tid = threadIdx.x, lane = tid & 63, wave = __builtin_amdgcn_readfirstlane(tid >> 6);
    if (!have_tables) (void)moe_tables(a, lds);
    const LAS int* tp = (const LAS int*)(lds + TP_OFF);
    const float* mods = (const float*)(a.ws + WS_MODS); const unsigned char* OUT8 = a.ws + WS_OUT8; float* out = a.out; const bf16_t* H1 = (const bf16_t*)(a.ws + WS_H1);
    const int* tok_e = (const int*)(a.ws + WS_TOKE); const int* tok_pos = (const int*)(a.ws + WS_TOKPOS); const float* tok_p = (const float*)(a.ws + WS_TOKP);
    for (int rg = blockIdx.x * 8 + wave; rg < T / 16; rg += G * 8) {
        const int b = (rg * 16) / SEQ;
        f32x4 G2[4];
#pragma unroll
        for (int j = 0; j < 4; ++j) { const int k = 4 * lane + 256 * j; G2[j] = *(const f32x4*)(mods + b * 6144 + 5120 + k) * *(const f32x4*)(a.in[I_GPOSTF] + k); }
        const size_t mb = (size_t)rg * 64 + lane;
        const int me = tok_e[mb], mslot = tp[me] * 256 + tok_pos[mb]; const float mpr = tok_p[mb] * (1.0f / OSCALE);
        constexpr int P10D = 2;
        int nw[P10D][4][4]; u32x2 nh[P10D][4];
#define P10_LOADROW(d_, i_) do { const size_t m_ = (size_t)rg * 16 + (i_); \
            _Pragma("unroll") for (int k = 0; k < 4; ++k) { const size_t slot = (size_t)__builtin_amdgcn_readlane(mslot, 4 * (i_) + k); \
                _Pragma("unroll") for (int j = 0; j < 4; ++j) nw[d_][k][j] = *(const int*)(OUT8 + slot * 1024 + 4 * lane + 256 * j); } \
            _Pragma("unroll") for (int j = 0; j < 4; ++j) nh[d_][j] = __builtin_nontemporal_load((const u32x2*)(H1 + m_ * 1024 + 4 * lane + 256 * j)); } while (0)
#pragma unroll
        for (int d = 0; d < P10D; ++d) P10_LOADROW(d, d);
        for (int i0 = 0; i0 < 16; i0 += P10D) {
#pragma unroll
          for (int d = 0; d < P10D; ++d) {
            const int i = i0 + d; const size_t m = (size_t)rg * 16 + i;
            int cw[4][4]; u32x2 ch[4];
#pragma unroll
            for (int k = 0; k < 4; ++k)
#pragma unroll
                for (int j = 0; j < 4; ++j) cw[k][j] = nw[d][k][j];
#pragma unroll
            for (int j = 0; j < 4; ++j) ch[j] = nh[d][j];
            const int in_ = i + P10D < 16 ? i + P10D : 15;
            P10_LOADROW(d, in_);
            f32x4 f[4];
#pragma unroll
            for (int j = 0; j < 4; ++j) f[j] = (f32x4){0.f, 0.f, 0.f, 0.f};
#pragma unroll
            for (int k = 0; k < 4; ++k) {
                const float pk = __builtin_bit_cast(float, __builtin_amdgcn_readlane(__builtin_bit_cast(int, mpr), 4 * i + k));
#pragma unroll
                for (int j = 0; j < 4; ++j) { const int w = cw[k][j];
                    const f32x2 lo = __builtin_amdgcn_cvt_pk_f32_fp8(w, false), hi = __builtin_amdgcn_cvt_pk_f32_fp8(w, true);
                    f[j] += (f32x4){lo[0], lo[1], hi[0], hi[1]} * pk; }
            }
            float ss = 0.f;
#pragma unroll
            for (int j = 0; j < 4; ++j) ss += (f[j][0] * f[j][0] + f[j][1] * f[j][1]) + (f[j][2] * f[j][2] + f[j][3] * f[j][3]);
            const float rstd = __builtin_amdgcn_rsqf(wave_sum(ss) * (1.0f / 1024.0f) + EPS);
#pragma unroll
            for (int j = 0; j < 4; ++j) __builtin_nontemporal_store((f32x4){bflo(ch[j][0]), bfhi(ch[j][0]), bflo(ch[j][1]), bfhi(ch[j][1])} + G2[j] * f[j] * rstd, (f32x4*)(out + m * 1024 + 4 * lane + 256 * j));
          }
        }
#undef P10_LOADROW
    }
}

constexpr int N_PHASES = 11;
__global__ void __launch_bounds__(512, 2) mk_fwd(Args args) {
    extern __shared__ __attribute__((aligned(16))) unsigned char lds_raw[];
    LAS unsigned char* lds = (LAS unsigned char*)lds_raw;
    volatile LAS unsigned* MISC = (volatile LAS unsigned*)(lds + MISC_OFF);
    const int tid = threadIdx.x, G = gridDim.x;
    if (tid < 64) MISC[tid] = 0u;
    __syncthreads();
    unsigned* ctl = (unsigned*)(args.ws + WS_CTL);
    const int lo = args.ph_lo, hi = args.ph_hi;
    XcdBarrier bar; bar.bar = ctl + CW_BAR; bar.x = 0; bar.st = MISC + 8;
    if (hi - lo > 1) bar = xcd_barrier_post(ctl + CW_BAR, MISC + 8);
#define IN(k) (lo <= (k) && (k) < hi)
#define SEAM(k) do { if (IN((k) + 1)) xcd_barrier(bar); } while (0)
    const LAS unsigned short* TOK = (const LAS unsigned short*)(lds + TOK_OFF);
    if (IN(0)) { p0_prologue(args, lds, G); SEAM(0); }
    if (IN(1)) { p1_norm(args, lds, G); SEAM(1); }
    if (IN(2)) {
        pg8::Gemm g{args.ws + WS_XN, args.ws + WS_WIN, 2048}; pg8::StaticOrder S; S.init(T, NPROJ, G, (int)blockIdx.x);
        pg8::EpiProj E{(bf16_t*)(args.ws + WS_PROJ)};
        const int grp = (((int)blockIdx.x >> 3) * 6) >> 5, nun = (S.nwg + G - 1) / G, cut = grp < nun ? grp : nun;
        if (cut > 0) { S.base = 0; S.lim = cut; pg8::gemm_phase<pg8::EpiProj, pg8::StaticOrder, true, false, false>(lds, g, S, E, TOK); }
        __syncthreads(); moe_convert(args, lds, G, 0, MOE_ITEMS); __syncthreads();
        if (cut < nun) { S.base = cut; S.lim = nun - cut; pg8::gemm_phase<pg8::EpiProj, pg8::StaticOrder, true, false, false>(lds, g, S, E, TOK); }
        SEAM(2);
    }
    if (IN(3)) { p3_sgu(args, lds, G); __syncthreads(); p3_gla_state(args, lds, G); SEAM(3); }
    if (IN(5)) { p5_gla_out(args, lds, G); SEAM(5); }
    if (IN(6)) {
        pg8::Gemm g{args.ws + WS_XN, args.ws + WS_WOUT, 1024}; pg8::StaticOrder S; S.init(T, 1024, G, (int)blockIdx.x);
        pg8::EpiPlain E{(bf16_t*)(args.ws + WS_MIX), 1024};
        pg8::gemm_phase<pg8::EpiPlain, pg8::StaticOrder, true, false, true>(lds, g, S, E, TOK);
        SEAM(6);
    }
    if (IN(7)) { p7_router(args, lds, G); SEAM(7); }
    int nM_p8 = -1;
    if (IN(8)) {
        const int nM = moe_tables(args, lds); nM_p8 = nM;
        pg8::MoeOrder S; S.nM = nM; S.nN = 8; S.nwg = nM * 8; S.G = G; S.c = (int)blockIdx.x;
        S.tp = (const LAS int*)(lds + TP_OFF); S.cnt = S.tp + 40; S.te = (const LAS unsigned char*)(lds + TE_OFF);
        {
            LAS unsigned short* tokw = (LAS unsigned short*)(lds + TOK_OFF); const int* slot_tok = (const int*)(args.ws + WS_SLOT);
            const int wv = __builtin_amdgcn_readfirstlane(tid >> 6), ln = tid & 63;
            int tv[3][4]; bool have[3];
#pragma unroll
            for (int k = 0; k < 3; ++k) { pg8::Unit u = {0, 0, 0, 0, 0, 0, -1}; have[k] = (wv + 8 * k < 18) && S.next(wv + 8 * k, u);
#pragma unroll
                for (int q = 0; q < 4; ++q) { const int p = u.prow + ln + 64 * q; tv[k][q] = (have[k] && p < u.cnt) ? slot_tok[(size_t)u.e * T + p] : 0; } }
#pragma unroll
            for (int k = 0; k < 3; ++k) if (have[k]) {
#pragma unroll
                for (int q = 0; q < 4; ++q) tokw[(wv + 8 * k) * 256 + ln + 64 * q] = (unsigned short)tv[k][q]; }
            __syncthreads();
        }
        pg8::Gemm g{args.ws + WS_XN, args.ws + WS_W1, 1024};
        pg8::EpiSwiglu E{args.ws + WS_HDN, args.in[I_BG], args.in[I_BU]};
        pg8::gemm_phase<pg8::EpiSwiglu, pg8::MoeOrder, true, true, true>(lds, g, S, E, TOK);
        SEAM(8);
    }
    if (IN(9)) {
        const int nM = nM_p8 >= 0 ? nM_p8 : moe_tables(args, lds);
        pg8::MoeOrder S; S.nM = nM; S.nN = 4; S.nwg = nM * 4; S.G = G; S.c = (int)blockIdx.x;
        S.tp = (const LAS int*)(lds + TP_OFF); S.cnt = S.tp + 40; S.te = (const LAS unsigned char*)(lds + TE_OFF);
        pg8::Gemm g{args.ws + WS_HDN, args.ws + WS_WD, 1024};
        pg8::EpiOut8 E{args.ws + WS_OUT8, args.in[I_BDN]};
        pg8::gemm_phase<pg8::EpiOut8, pg8::MoeOrder, true, false, true>(lds, g, S, E, TOK);
        SEAM(9);
    }
    if (IN(10)) { p10_final(args, lds, G, nM_p8 >= 0); }
#undef IN
#undef SEAM
}

#ifndef MK_SPLIT
#define MK_SPLIT 0
#endif
extern "C" void kernel_launch(void* const* d_in, const int* in_sizes, int n_in, void* d_out, int out_size, void* d_ws, size_t ws_size, hipStream_t stream) {
    static int grid = 0;
    if (grid == 0) {
        if (n_in != 24 || out_size != T * D || ws_size < WS_END) { fprintf(stderr, "kernel_launch: unexpected problem (n_in %d, out %d, ws %zu)\n", n_in, out_size, ws_size); grid = -1; return; }
        int dev = 0, cus = 0, per_cu = 0;
        if (hipGetDevice(&dev) != hipSuccess || hipDeviceGetAttribute(&cus, hipDeviceAttributeMultiprocessorCount, dev) != hipSuccess) { grid = -1; return; }
        if (hipFuncSetAttribute((const void*)mk_fwd, hipFuncAttributeMaxDynamicSharedMemorySize, LDS_BYTES) != hipSuccess) { grid = -1; return; }
        if (hipOccupancyMaxActiveBlocksPerMultiprocessor(&per_cu, (const void*)mk_fwd, 512, LDS_BYTES) != hipSuccess || per_cu < 1) { fprintf(stderr, "kernel_launch: occupancy query says %d\n", per_cu); (void)hipGetLastError(); grid = -1; return; }
        grid = cus;
    }
    if (grid < 0) return;
    (void)hipMemsetAsync((char*)d_ws + WS_CTL, 0, CTL_ZERO_BYTES, stream);
    Args a{};
    for (int i = 0; i < 24; ++i) a.in[i] = (const float*)d_in[i];
    a.out = (float*)d_out; a.ws = (unsigned char*)d_ws;
#if MK_SPLIT
    for (int p = 0; p < N_PHASES; ++p) { a.ph_lo = p; a.ph_hi = p + 1; hipLaunchKernelGGL(mk_fwd, dim3(grid), dim3(512), LDS_BYTES, stream, a); }
#else
    a.ph_lo = 0; a.ph_hi = N_PHASES;
    hipLaunchKernelGGL(mk_fwd, dim3(grid), dim3(512), LDS_BYTES, stream, a);
#endif
}
```
